# Optimizing an MI355X kernel written in HIP

```python
import math
import jax, jax.numpy as jnp
from jax import lax
import numpy as np

D_MODEL = 1024
BATCH = 8
SEQ = 2048
DEPTH = 2

HEAD_DIM = 64
H_SB = 6
H_MOBA = 5
H_DSA = 5
W_SB = H_SB * HEAD_DIM
W_MOBA = H_MOBA * HEAD_DIM
W_DSA = H_DSA * HEAD_DIM
MOBA_BLOCK = 256
MOBA_TOPK = 3
MOBA_Q_CHUNK = 64
DSA_TOPK_MAX = 256
IDX_HEADS = 8
IDX_DIM = 64
Q_BLOCK = 128
D_FF = -(-8 * D_MODEL // (3 * 256)) * 256
N_BRANCH = 3
D_IN = 3 * W_SB + 3 * W_MOBA + 3 * W_DSA + IDX_HEADS * IDX_DIM + IDX_DIM + IDX_HEADS + N_BRANCH * D_MODEL
RMS_EPS = 1e-6
NEG_BIG = -1e30
ALIBI_HEADS = H_MOBA + H_DSA

kernel_name = "hybrid_sb_moba_dsa_adaln_sandwich"


def _mixer_split_points():
    sizes = [W_SB] * 3 + [W_MOBA] * 3 + [W_DSA] * 3 + [IDX_HEADS * IDX_DIM, IDX_DIM, IDX_HEADS, N_BRANCH * D_MODEL]
    return [int(v) for v in np.cumsum(sizes)[:-1]]


def _alibi_slopes():
    return jnp.asarray(2.0 ** (-8.0 * np.arange(1, ALIBI_HEADS + 1) / ALIBI_HEADS), dtype=jnp.float32)


def rms_norm(x, g):
    xf = x.astype(jnp.float32)
    y = xf * lax.rsqrt(jnp.mean(xf * xf, axis=-1, keepdims=True) + RMS_EPS)
    return (y * g.astype(jnp.float32)).astype(x.dtype)


def stick_breaking_attention(q, k, v):
    B, S, H, dh = q.shape
    scale = dh ** -0.5
    kpos = jnp.arange(S)

    def block(i):
        start = i * Q_BLOCK
        qb = lax.dynamic_slice_in_dim(q, start, Q_BLOCK, axis=1)
        z = jnp.einsum('bqhd,bshd->bhqs', qb, k, preferred_element_type=jnp.float32) * scale
        qpos = start + jnp.arange(Q_BLOCK)
        past = kpos[None, :] < qpos[:, None]
        log_beta = jax.nn.log_sigmoid(z)
        log_one_minus = jnp.where(past, jax.nn.log_sigmoid(-z), 0.0)
        between = lax.cumsum(log_one_minus, axis=3, reverse=True) - log_one_minus
        a = jnp.where(past, jnp.exp(log_beta + between), 0.0)
        return jnp.einsum('bhqs,bshd->bqhd', a.astype(v.dtype), v)

    out = lax.map(block, jnp.arange(S // Q_BLOCK))
    return jnp.moveaxis(out, 0, 1).reshape(B, S, H * dh)


def moba_attention(q, k, v, slopes):
    B, S, H, dh = q.shape
    scale = dh ** -0.5
    nb = -(-S // MOBA_BLOCK)
    pad = nb * MOBA_BLOCK - S
    kp = jnp.pad(k, ((0, 0), (0, pad), (0, 0), (0, 0)))
    vp = jnp.pad(v, ((0, 0), (0, pad), (0, 0), (0, 0)))
    kb = kp.reshape(B, nb, MOBA_BLOCK, H, dh)
    vb = vp.reshape(B, nb, MOBA_BLOCK, H, dh)
    k_mean = jnp.mean(kb.astype(jnp.float32), axis=2)
    kb_h = jnp.moveaxis(kb, 3, 1)
    vb_h = jnp.moveaxis(vb, 3, 1)
    n_sel = min(MOBA_TOPK, nb - 1)
    b_ix = jnp.arange(B)[:, None, None, None]
    h_ix = jnp.arange(H)[None, :, None, None]
    blk_off = jnp.arange(MOBA_BLOCK)

    def chunk(i):
        start = i * MOBA_Q_CHUNK
        own = start // MOBA_BLOCK
        qc = lax.dynamic_slice_in_dim(q, start, MOBA_Q_CHUNK, axis=1)
        qpos = start + jnp.arange(MOBA_Q_CHUNK)
        k_own = lax.dynamic_slice_in_dim(kp, own * MOBA_BLOCK, MOBA_BLOCK, axis=1)
        v_own = lax.dynamic_slice_in_dim(vp, own * MOBA_BLOCK, MOBA_BLOCK, axis=1)
        own_pos = own * MOBA_BLOCK + blk_off
        dist_own = (qpos[:, None] - own_pos[None, :]).astype(jnp.float32)
        s_own = jnp.einsum('bqhd,bkhd->bhqk', qc, k_own, preferred_element_type=jnp.float32) * scale \
            - slopes[None, :, None, None] * dist_own[None, None]
        s_own = jnp.where((own_pos[None, :] <= qpos[:, None])[None, None], s_own, -jnp.inf)
        if n_sel > 0:
            gate = jnp.einsum('bqhd,bnhd->bhqn', qc.astype(jnp.float32), k_mean)
            gate = jnp.where(jnp.arange(nb) < own, gate, NEG_BIG)
            _, sel = lax.top_k(gate, n_sel)
            valid = sel < own
            k_sel = kb_h[b_ix, h_ix, sel]
            v_sel = vb_h[b_ix, h_ix, sel]
            sel_pos = sel[..., None] * MOBA_BLOCK + blk_off
            dist_sel = (qpos[None, None, :, None, None] - sel_pos).astype(jnp.float32)
            s_sel = jnp.einsum('bqhd,bhqnkd->bhqnk', qc, k_sel, preferred_element_type=jnp.float32) * scale \
                - slopes[None, :, None, None, None] * dist_sel
            s_sel = jnp.where(valid[..., None], s_sel, -jnp.inf).reshape(B, H, MOBA_Q_CHUNK, n_sel * MOBA_BLOCK)
            p = jax.nn.softmax(jnp.concatenate([s_sel, s_own], axis=-1), axis=-1).astype(v.dtype)
            p_sel = p[..., :n_sel * MOBA_BLOCK].reshape(B, H, MOBA_Q_CHUNK, n_sel, MOBA_BLOCK)
            p_own = p[..., n_sel * MOBA_BLOCK:]
            return jnp.einsum('bhqnk,bhqnkd->bqhd', p_sel, v_sel) + jnp.einsum('bhqk,bkhd->bqhd', p_own, v_own)
        p_own = jax.nn.softmax(s_own, axis=-1).astype(v.dtype)
        return jnp.einsum('bhqk,bkhd->bqhd', p_own, v_own)

    out = lax.map(chunk, jnp.arange(S // MOBA_Q_CHUNK))
    return jnp.moveaxis(out, 0, 1).reshape(B, S, H * dh)


def dsa_attention(q, k, v, q_idx, k_idx, w_idx, slopes):
    B, S, H, dh = q.shape
    scale = dh ** -0.5
    top = min(DSA_TOPK_MAX, S // 4)
    kpos = jnp.arange(S)
    b_ix = jnp.arange(B)[:, None, None]

    def block(i):
        start = i * Q_BLOCK
        qi = lax.dynamic_slice_in_dim(q_idx, start, Q_BLOCK, axis=1)
        wi = lax.dynamic_slice_in_dim(w_idx, start, Q_BLOCK, axis=1)
        qc = lax.dynamic_slice_in_dim(q, start, Q_BLOCK, axis=1)
        qpos = start + jnp.arange(Q_BLOCK)
        logits = jnp.einsum('bqhd,bsd->bqhs', qi, k_idx, preferred_element_type=jnp.float32)
        score = jnp.einsum('bqhs,bqh->bqs', jax.nn.relu(logits), wi.astype(jnp.float32))
        admissible = kpos[None, :] <= qpos[:, None]
        score = jnp.where(admissible[None], score, NEG_BIG)
        _, idx = lax.top_k(score, top)
        valid = idx <= qpos[None, :, None]
        k_sel = k[b_ix, idx]
        v_sel = v[b_ix, idx]
        dist = (qpos[None, :, None] - idx).astype(jnp.float32)
        s = jnp.einsum('bqhd,bqkhd->bhqk', qc, k_sel, preferred_element_type=jnp.float32) * scale \
            - slopes[None, :, None, None] * dist[:, None]
        s = jnp.where(valid[:, None], s, -jnp.inf)
        p = jax.nn.softmax(s, axis=-1).astype(v.dtype)
        return jnp.einsum('bhqk,bqkhd->bqhd', p, v_sel)

    out = lax.map(block, jnp.arange(S // Q_BLOCK))
    return jnp.moveaxis(out, 0, 1).reshape(B, S, H * dh)


def hybrid_mixer(h, w_in, b_gate, w_proj_sb, w_proj_moba, w_proj_dsa, w_o, slopes):
    B, S, _ = h.shape
    proj = h @ w_in
    (q_sb, k_sb, v_sb, q_mb, k_mb, v_mb, q_ds, k_ds, v_ds,
     q_ix, k_ix, w_ix, gate_logits) = jnp.split(proj, _mixer_split_points(), axis=-1)
    heads = lambda t: t.reshape(B, S, -1, HEAD_DIM)
    o_sb = stick_breaking_attention(heads(q_sb), heads(k_sb), heads(v_sb))
    o_mb = moba_attention(heads(q_mb), heads(k_mb), heads(v_mb), slopes[0::2])
    o_ds = dsa_attention(heads(q_ds), heads(k_ds), heads(v_ds),
                         q_ix.reshape(B, S, IDX_HEADS, IDX_DIM), k_ix, w_ix, slopes[1::2])
    g_sb, g_mb, g_ds = jnp.split(jax.nn.sigmoid(gate_logits + b_gate), N_BRANCH, axis=-1)
    merged = g_sb * (o_sb @ w_proj_sb) + g_mb * (o_mb @ w_proj_moba) + g_ds * (o_ds @ w_proj_dsa)
    return merged @ w_o


def swiglu(h, w_up, w_down):
    gate, up = jnp.split(h @ w_up, 2, axis=-1)
    return (jax.nn.silu(gate) * up) @ w_down


def setup_inputs(seed: int = 0) -> dict:
    key = jax.random.key(seed)
    ks = jax.random.split(key, 16)
    nrm = lambda k, shape, s: jax.random.normal(k, shape, jnp.float32) * s
    L, D = DEPTH, D_MODEL
    return {
        "x": nrm(ks[0], (BATCH, SEQ, D), 1.0),
        "c": nrm(ks[1], (BATCH, D), 1.0),
        "w_ada": nrm(ks[2], (L, D, 6 * D), 0.5 * D ** -0.5),
        "b_ada": nrm(ks[3], (L, 6 * D), 0.01),
        "g_pre_mix": 1.0 + nrm(ks[4], (L, D), 0.02),
        "g_post_mix": 1.0 + nrm(ks[5], (L, D), 0.02),
        "w_in": nrm(ks[6], (L, D, D_IN), D ** -0.5),
        "b_gate": nrm(ks[7], (L, N_BRANCH * D), 0.01),
        "w_proj_sb": nrm(ks[8], (L, W_SB, D), W_SB ** -0.5),
        "w_proj_moba": nrm(ks[9], (L, W_MOBA, D), W_MOBA ** -0.5),
        "w_proj_dsa": nrm(ks[10], (L, W_DSA, D), W_DSA ** -0.5),
        "w_o": nrm(ks[11], (L, D, D), D ** -0.5),
        "g_pre_ffn": 1.0 + nrm(ks[12], (L, D), 0.02),
        "g_post_ffn": 1.0 + nrm(ks[13], (L, D), 0.02),
        "w_up": nrm(ks[14], (L, D, 2 * D_FF), D ** -0.5),
        "w_down": nrm(ks[15], (L, D_FF, D), D_FF ** -0.5),
    }


def reference(x, c, w_ada, b_ada, g_pre_mix, g_post_mix, w_in, b_gate, w_proj_sb, w_proj_moba,
              w_proj_dsa, w_o, g_pre_ffn, g_post_ffn, w_up, w_down):
    slopes = _alibi_slopes()
    c_act = jax.nn.silu(c)
    for l in range(DEPTH):
        mod = c_act @ w_ada[l] + b_ada[l]
        sh1, sc1, g1, sh2, sc2, g2 = [m[:, None, :] for m in jnp.split(mod, 6, axis=-1)]
        h = rms_norm(x, g_pre_mix[l]) * (1.0 + sc1) + sh1
        y = hybrid_mixer(h, w_in[l], b_gate[l], w_proj_sb[l], w_proj_moba[l], w_proj_dsa[l], w_o[l], slopes)
        x = x + g1 * rms_norm(y, g_post_mix[l])
        h = rms_norm(x, g_pre_ffn[l]) * (1.0 + sc2) + sh2
        y = swiglu(h, w_up[l], w_down[l])
        x = x + g2 * rms_norm(y, g_post_ffn[l])
    return x
```

```cpp
#include <hip/hip_runtime.h>
#include <hip/hip_cooperative_groups.h>
#include <cstdio>
#include <cstdint>
namespace cg = cooperative_groups;

typedef unsigned short bf16_t;
typedef float f32x4 __attribute__((ext_vector_type(4)));
typedef unsigned u32x4 __attribute__((ext_vector_type(4)));
typedef unsigned u32x2 __attribute__((ext_vector_type(2)));

constexpr int BATCH = 8, SEQ = 2048, DM = 1024, T = BATCH * SEQ, DEPTH = 2;
constexpr int HD = 64, H_SB = 6, H_MB = 5, H_DS = 5;
constexpr int D_IN = 6728, NQ1 = 3656, QKV_PITCH = 3840, NGATE = 3072, DFF = 2816;
constexpr int OC_PITCH = 1152;
constexpr int CQ_SB = 0, CK_SB = 384, CV_SB = 768, CQ_MB = 1152, CK_MB = 1472, CV_MB = 1792, CQ_DS = 2112, CK_DS = 2432, CV_DS = 2752, CQ_IX = 3072, CK_IX = 3584, CW_IX = 3648;
constexpr int CO_SB = 0, CO_MB = 384, CO_DS = 768;
constexpr float RMS_EPS = 1e-6f;
constexpr int NTHREADS = 512, NWAVES = 8;

constexpr size_t MiB = 1u << 20;
constexpr size_t WS_MOD = 1 * MiB;
constexpr size_t WS_KMEAN = 1 * MiB + 512 * 1024;
constexpr size_t WS_MASK = 2 * MiB;
constexpr size_t WS_WT = 6 * MiB;
constexpr size_t WS_R3 = 42 * MiB;
constexpr size_t WS_R2 = 74 * MiB;
constexpr size_t WS_R1 = 110 * MiB;
constexpr size_t WS_END = 230 * MiB;

struct Params {
    const float* x; const float* c; const float* w_ada; const float* b_ada; const float* g_pre_mix; const float* g_post_mix;
    const float* w_in; const float* b_gate; const float* w_proj_sb; const float* w_proj_mb; const float* w_proj_ds; const float* w_o;
    const float* g_pre_ffn; const float* g_post_ffn; const float* w_up; const float* w_down;
    float* out; unsigned char* ws;
};

__device__ __forceinline__ float bf2f(unsigned short b) { return __uint_as_float((unsigned)b << 16); }
__device__ __forceinline__ float bflo(unsigned w) { return __uint_as_float(w << 16); }
__device__ __forceinline__ float bfhi(unsigned w) { return __uint_as_float(w & 0xffff0000u); }
__device__ __forceinline__ unsigned f2bf(float f) { unsigned u = __float_as_uint(f); return (u + 0x7fffu + ((u >> 16) & 1u)) >> 16; }
__device__ __forceinline__ unsigned pk2(float lo, float hi) { return f2bf(lo) | (f2bf(hi) << 16); }
__device__ __forceinline__ float wave_sum(float v) {
#pragma unroll
    for (int o = 1; o < 64; o <<= 1) v += __shfl_xor(v, o);
    return v;
}
__device__ __forceinline__ float sigmoidf_(float v) { return 1.f / (1.f + __expf(-v)); }

__device__ void phase_mod(const Params& p, float* lds) {
    float* MOD = (float*)(p.ws + WS_MOD);
    const int tid = threadIdx.x;
    float* cact = lds;
    float* red = lds + 8 * 1024;
    for (int i = tid; i < 8 * 1024; i += NTHREADS) { const float v = p.c[i]; cact[i] = v * sigmoidf_(v); }
    __syncthreads();
    for (int item = blockIdx.x; item < 2 * 96; item += gridDim.x) {
        const int l = item / 96, ct = item % 96, kg = tid >> 6, col = ct * 64 + (tid & 63);
        const float* W = p.w_ada + (size_t)l * 1024 * 6144 + col;
        float acc[8];
#pragma unroll
        for (int b = 0; b < 8; ++b) acc[b] = 0.f;
        for (int k = kg; k < 1024; k += 8) {
            const float w = W[(size_t)k * 6144];
#pragma unroll
            for (int b = 0; b < 8; ++b) acc[b] += cact[b * 1024 + k] * w;
        }
#pragma unroll
        for (int b = 0; b < 8; ++b) red[(kg * 8 + b) * 64 + (tid & 63)] = acc[b];
        __syncthreads();
        {
            const int b = tid >> 6, cc = tid & 63;
            float s = 0.f;
#pragma unroll
            for (int g = 0; g < 8; ++g) s += red[(g * 8 + b) * 64 + cc];
            MOD[((size_t)l * 8 + b) * 6144 + ct * 64 + cc] = s + p.b_ada[l * 6144 + ct * 64 + cc];
        }
        __syncthreads();
    }
}

__device__ __forceinline__ void normmod_row(const f32x4 (&v)[4], float rstd, const float* g, const float* sc, const float* sh, bf16_t* orow, int lane) {
#pragma unroll
    for (int j = 0; j < 4; ++j) {
        const int c0 = 4 * lane + 256 * j;
        const f32x4 gg = *(const f32x4*)(g + c0), s1 = *(const f32x4*)(sc + c0), s0 = *(const f32x4*)(sh + c0);
        f32x4 o;
#pragma unroll
        for (int e = 0; e < 4; ++e) o[e] = v[j][e] * rstd * gg[e] * (1.f + s1[e]) + s0[e];
        u32x2 w; w.x = pk2(o[0], o[1]); w.y = pk2(o[2], o[3]);
        *(u32x2*)(orow + c0) = w;
    }
}
__device__ void phase_prenorm(const Params& p, const float* xin, const float* g, int l, int which  ) {
    const float* MOD = (const float*)(p.ws + WS_MOD) + (size_t)l * 8 * 6144;
    bf16_t* XN = (bf16_t*)(p.ws + WS_R3);
    const int lane = threadIdx.x & 63, gw = blockIdx.x * NWAVES + (threadIdx.x >> 6), NGW = gridDim.x * NWAVES;
    for (int m = gw; m < T; m += NGW) {
        const int b = m / SEQ;
        const f32x4* xr = (const f32x4*)(xin + (size_t)m * DM) + lane;
        f32x4 v[4]; float s = 0.f;
#pragma unroll
        for (int j = 0; j < 4; ++j) { v[j] = xr[64 * j]; s += (v[j][0] * v[j][0] + v[j][1] * v[j][1]) + (v[j][2] * v[j][2] + v[j][3] * v[j][3]); }
        const float rstd = rsqrtf(wave_sum(s) * (1.f / DM) + RMS_EPS);
        const float* mb = MOD + (size_t)b * 6144 + which * 3072;
        normmod_row(v, rstd, g, mb + 1024, mb, XN + (size_t)m * DM, lane);
    }
}
__device__ void phase_postnorm(const Params& p, const float* xin, const float* gpost, int l, int which  ) {
    const float* MODl = (const float*)(p.ws + WS_MOD) + (size_t)l * 8 * 6144;
    const bf16_t* Y = (const bf16_t*)(p.ws + WS_R2);
    bf16_t* XN = (bf16_t*)(p.ws + WS_R3);
    const int lane = threadIdx.x & 63, gw = blockIdx.x * NWAVES + (threadIdx.x >> 6), NGW = gridDim.x * NWAVES;
    const float* gnext = which == 0 ? p.g_pre_ffn + l * DM : (l + 1 < DEPTH ? p.g_pre_mix + (l + 1) * DM : nullptr);
    for (int m = gw; m < T; m += NGW) {
        const int b = m / SEQ;
        const float* gate = MODl + (size_t)b * 6144 + (which == 0 ? 2048 : 5120);
        f32x4 y[4]; float s = 0.f;
#pragma unroll
        for (int j = 0; j < 4; ++j) {
            const u32x2 w = *(const u32x2*)(Y + (size_t)m * DM + 4 * lane + 256 * j);
            y[j] = (f32x4){bflo(w.x), bfhi(w.x), bflo(w.y), bfhi(w.y)};
            s += (y[j][0] * y[j][0] + y[j][1] * y[j][1]) + (y[j][2] * y[j][2] + y[j][3] * y[j][3]);
        }
        const float rstd = rsqrtf(wave_sum(s) * (1.f / DM) + RMS_EPS);
        f32x4 v[4]; float s2 = 0.f;
#pragma unroll
        for (int j = 0; j < 4; ++j) {
            const int c0 = 4 * lane + 256 * j;
            const f32x4 xi = *(const f32x4*)(xin + (size_t)m * DM + c0), gp = *(const f32x4*)(gpost + c0), gt = *(const f32x4*)(gate + c0);
#pragma unroll
            for (int e = 0; e < 4; ++e) v[j][e] = xi[e] + gt[e] * (y[j][e] * rstd * gp[e]);
            *(f32x4*)(p.out + (size_t)m * DM + c0) = v[j];
            s2 += (v[j][0] * v[j][0] + v[j][1] * v[j][1]) + (v[j][2] * v[j][2] + v[j][3] * v[j][3]);
        }
        if (gnext) {
            const float rstd2 = rsqrtf(wave_sum(s2) * (1.f / DM) + RMS_EPS);
            const float* mb = which == 0 ? MODl + (size_t)b * 6144 + 3072 : MODl + (size_t)8 * 6144 + (size_t)b * 6144;
            normmod_row(v, rstd2, gnext, mb + 1024, mb, XN + (size_t)m * DM, lane);
        }
    }
}

struct NSeg { const bf16_t* A; int lda; const float* W; int ldw; int K; };
template <int NSEG> struct NGemm { NSeg s[NSEG]; int M, N; };
struct NEpi { bf16_t* C; int ldc; const float* bias; const bf16_t* gates; };
template <int NSEG, int EPI> __device__ void naive_gemm(float* lds, const NGemm<NSEG>& g, const NEpi& e) {
    float* As = lds;
    float* Bs = lds + 16 * 68;
    const int tid = threadIdx.x, ty = tid >> 5, tx = tid & 31;
    const int tm = g.M / 64, tn = (g.N + 127) / 128;
    for (int item = blockIdx.x; item < tm * tn; item += gridDim.x) {
        const int m0 = (item / tn) * 64, n0 = (item % tn) * 128;
        float acc[NSEG][4][4];
#pragma unroll
        for (int s = 0; s < NSEG; ++s)
#pragma unroll
            for (int i = 0; i < 4; ++i)
#pragma unroll
                for (int j = 0; j < 4; ++j) acc[s][i][j] = 0.f;
#pragma unroll
        for (int s = 0; s < NSEG; ++s) {
            const NSeg sg = g.s[s];
#pragma unroll 1
            for (int k0 = 0; k0 < sg.K; k0 += 16) {
                __syncthreads();
                {
                    const int r = tid >> 3, kq = tid & 7;
                    const unsigned w = *(const unsigned*)(sg.A + (size_t)(m0 + r) * sg.lda + k0 + kq * 2);
                    As[(kq * 2 + 0) * 68 + r] = bflo(w); As[(kq * 2 + 1) * 68 + r] = bfhi(w);
                    const int k = tid >> 5, nq = tid & 31, n = n0 + nq * 4;
                    f32x4 bv = (f32x4){0.f, 0.f, 0.f, 0.f};
                    if (n < g.N) bv = *(const f32x4*)(sg.W + (size_t)(k0 + k) * sg.ldw + n);
                    *(f32x4*)(Bs + k * 132 + nq * 4) = bv;
                }
                __syncthreads();
#pragma unroll 4
                for (int k = 0; k < 16; ++k) {
                    const f32x4 a0 = *(const f32x4*)(As + k * 68 + ty * 4), b = *(const f32x4*)(Bs + k * 132 + tx * 4);
#pragma unroll
                    for (int i = 0; i < 4; ++i)
#pragma unroll
                        for (int j = 0; j < 4; ++j) acc[s][i][j] += a0[i] * b[j];
                }
            }
        }
        const int col = n0 + tx * 4;
        if (col < g.N) {
#pragma unroll
            for (int i = 0; i < 4; ++i) {
                const int row = m0 + ty * 4 + i;
                float o[4];
                if (EPI == 0) {
#pragma unroll
                    for (int j = 0; j < 4; ++j) o[j] = acc[0][i][j];
                } else if (EPI == 1) {
#pragma unroll
                    for (int j = 0; j < 4; ++j) o[j] = sigmoidf_(acc[0][i][j] + e.bias[col + j]);
                } else if (EPI == 2) {
#pragma unroll
                    for (int j = 0; j < 4; ++j) o[j] = 0.f;
#pragma unroll
                    for (int s = 0; s < NSEG; ++s) {
                        const u32x2 gw = *(const u32x2*)(e.gates + (size_t)row * NGATE + s * 1024 + col);
                        o[0] += bflo(gw.x) * acc[s][i][0]; o[1] += bfhi(gw.x) * acc[s][i][1]; o[2] += bflo(gw.y) * acc[s][i][2]; o[3] += bfhi(gw.y) * acc[s][i][3];
                    }
                } else {
#pragma unroll
                    for (int j = 0; j < 4; ++j) { const float gt = acc[0][i][j]; o[j] = gt * sigmoidf_(gt) * acc[NSEG - 1][i][j]; }
                }
                u32x2 w; w.x = pk2(o[0], o[1]); w.y = pk2(o[2], o[3]);
                *(u32x2*)(e.C + (size_t)row * e.ldc + col) = w;
            }
        }
    }
}

__device__ void phase_kmean(const Params& p) {
    const bf16_t* QKV = (const bf16_t*)(p.ws + WS_R1);
    float* KM = (float*)(p.ws + WS_KMEAN);
    const int gt = blockIdx.x * NTHREADS + threadIdx.x, NT = gridDim.x * NTHREADS;
    for (int o = gt; o < 8 * 8 * 320; o += NT) {
        const int c = o % 320, n = (o / 320) % 8, b = o / (320 * 8);
        const bf16_t* kp = QKV + (size_t)(b * SEQ + n * 256) * QKV_PITCH + CK_MB + c;
        float s = 0.f;
        for (int r = 0; r < 256; ++r) s += bf2f(kp[(size_t)r * QKV_PITCH]);
        KM[o] = s * (1.f / 256.f);
    }
}

__device__ __forceinline__ unsigned ordkey(float f) { const unsigned u = __float_as_uint(f); return u ^ ((u >> 31) ? 0xffffffffu : 0x80000000u); }
__device__ void phase_dsa_topk(const Params& p, float* lds) {
    const bf16_t* QKV = (const bf16_t*)(p.ws + WS_R1);
    unsigned* MASK = (unsigned*)(p.ws + WS_MASK);
    const int lane = threadIdx.x & 63, wave = threadIdx.x >> 6, gw = blockIdx.x * NWAVES + wave, NGW = gridDim.x * NWAVES;
    float* qs = lds + wave * 520;
    unsigned* skey = (unsigned*)(lds + 8 * 520) + wave * 2048;
    for (int m = gw; m < T; m += NGW) {
        const int b = m / SEQ, t = m % SEQ;
        const bf16_t* qrow = QKV + (size_t)m * QKV_PITCH;
        {
            const u32x4 w = *(const u32x4*)(qrow + CQ_IX + lane * 8);
            qs[lane * 8 + 0] = bflo(w.x); qs[lane * 8 + 1] = bfhi(w.x); qs[lane * 8 + 2] = bflo(w.y); qs[lane * 8 + 3] = bfhi(w.y);
            qs[lane * 8 + 4] = bflo(w.z); qs[lane * 8 + 5] = bfhi(w.z); qs[lane * 8 + 6] = bflo(w.w); qs[lane * 8 + 7] = bfhi(w.w);
            if (lane < 8) qs[512 + lane] = bf2f(qrow[CW_IX + lane]);
        }
        asm volatile("s_waitcnt lgkmcnt(0)" ::: "memory");
        __builtin_amdgcn_wave_barrier();
        const int ni = (t >> 6) + 1;
#pragma unroll 1
        for (int i = 0; i < ni; ++i) {
            const int s = i * 64 + lane;
            const u32x4* kp = (const u32x4*)(QKV + (size_t)(b * SEQ + s) * QKV_PITCH + CK_IX);
            u32x4 kw[8];
#pragma unroll
            for (int q = 0; q < 8; ++q) kw[q] = kp[q];
            float sc = 0.f;
#pragma unroll 1
            for (int h = 0; h < 8; ++h) {
                float lg = 0.f;
#pragma unroll
                for (int q = 0; q < 8; ++q) {
                    const f32x4 q0 = *(const f32x4*)(qs + h * 64 + q * 8), q1 = *(const f32x4*)(qs + h * 64 + q * 8 + 4);
                    lg += q0[0] * bflo(kw[q].x) + q0[1] * bfhi(kw[q].x) + q0[2] * bflo(kw[q].y) + q0[3] * bfhi(kw[q].y)
                        + q1[0] * bflo(kw[q].z) + q1[1] * bfhi(kw[q].z) + q1[2] * bflo(kw[q].w) + q1[3] * bfhi(kw[q].w);
                }
                sc += qs[512 + h] * fmaxf(lg, 0.f);
            }
            if (sc == 0.f) sc = 0.f;
            skey[s] = (s <= t) ? ordkey(sc) : 0u;
        }
        asm volatile("s_waitcnt lgkmcnt(0)" ::: "memory");
        __builtin_amdgcn_wave_barrier();
        unsigned key[32];
#pragma unroll
        for (int i = 0; i < 32; ++i) key[i] = (i < ni) ? skey[i * 64 + lane] : 0u;
        unsigned w = 0u;
        if (t + 1 <= 256) {
#pragma unroll
            for (int i = 0; i < 32; ++i) { const unsigned long long sb = __ballot(key[i] != 0u); if ((lane >> 1) == i) w = (lane & 1) ? (unsigned)(sb >> 32) : (unsigned)sb; }
        } else {
            unsigned Tk = 0u;
#pragma unroll 1
            for (int bit = 31; bit >= 0; --bit) {
                const unsigned cand = Tk | (1u << bit);
                int cnt = 0;
#pragma unroll
                for (int i = 0; i < 32; ++i) cnt += __popcll(__ballot(key[i] >= cand));
                if (cnt >= 256) Tk = cand;
            }
            int cgt = 0;
#pragma unroll
            for (int i = 0; i < 32; ++i) cgt += __popcll(__ballot(key[i] > Tk));
            int need = 256 - cgt;
#pragma unroll
            for (int i = 0; i < 32; ++i) {
                const unsigned long long gtb = __ballot(key[i] > Tk), eqb = __ballot(key[i] == Tk);
                unsigned long long take = 0ull;
                const int ne = __popcll(eqb);
                if (need > 0 && ne > 0) {
                    if (ne <= need) { take = eqb; need -= ne; }
                    else {
                        unsigned long long rem = eqb;
                        for (int q = 0; q < need; ++q) { const unsigned long long low = rem & (~rem + 1ull); take |= low; rem ^= low; }
                        need = 0;
                    }
                }
                const unsigned long long sb = gtb | take;
                if ((lane >> 1) == i) w = (lane & 1) ? (unsigned)(sb >> 32) : (unsigned)sb;
            }
        }
        MASK[(size_t)m * 64 + lane] = w;
        __builtin_amdgcn_wave_barrier();
    }
}

template <int MODE> __device__ void naive_attn_item(const Params& p, int b, int h, int qc, int lane) {
    const bf16_t* QKV = (const bf16_t*)(p.ws + WS_R1);
    bf16_t* OC = (bf16_t*)(p.ws + WS_R2);
    constexpr int cq = MODE == 0 ? CQ_SB : MODE == 1 ? CQ_MB : CQ_DS, ck = MODE == 0 ? CK_SB : MODE == 1 ? CK_MB : CK_DS, cv = MODE == 0 ? CV_SB : MODE == 1 ? CV_MB : CV_DS;
    constexpr int co = MODE == 0 ? CO_SB : MODE == 1 ? CO_MB : CO_DS;
    const int t = qc * 64 + lane; const size_t row = (size_t)b * SEQ + t;
    float q[64], acc[64];
    {
        const u32x4* qp = (const u32x4*)(QKV + row * QKV_PITCH + cq + h * 64);
#pragma unroll
        for (int i = 0; i < 8; ++i) { const u32x4 w = qp[i];
            q[i * 8 + 0] = bflo(w.x); q[i * 8 + 1] = bfhi(w.x); q[i * 8 + 2] = bflo(w.y); q[i * 8 + 3] = bfhi(w.y);
            q[i * 8 + 4] = bflo(w.z); q[i * 8 + 5] = bfhi(w.z); q[i * 8 + 6] = bflo(w.w); q[i * 8 + 7] = bfhi(w.w); }
    }
#pragma unroll
    for (int d = 0; d < 64; ++d) acc[d] = 0.f;
    const bf16_t* Kb = QKV + (size_t)b * SEQ * QKV_PITCH + ck + h * 64;
    const bf16_t* Vb = QKV + (size_t)b * SEQ * QKV_PITCH + cv + h * 64;
    const int tmax = qc * 64 + 63;
    float outscale = 1.f;
    if (MODE == 0) {
        float R = 0.f;
        for (int s = tmax - 1; s >= 0; --s) {
            const u32x4* kp = (const u32x4*)(Kb + (size_t)s * QKV_PITCH);
            float z = 0.f;
#pragma unroll
            for (int i = 0; i < 8; ++i) { const u32x4 w = kp[i];
                z += q[i * 8 + 0] * bflo(w.x) + q[i * 8 + 1] * bfhi(w.x) + q[i * 8 + 2] * bflo(w.y) + q[i * 8 + 3] * bfhi(w.y)
                   + q[i * 8 + 4] * bflo(w.z) + q[i * 8 + 5] * bfhi(w.z) + q[i * 8 + 6] * bflo(w.w) + q[i * 8 + 7] * bfhi(w.w); }
            z *= 0.125f;
            const float u = -(fmaxf(z, 0.f) + log1pf(__expf(-fabsf(z))));
            const bool act = s < t;
            const float a = act ? __expf(z + u + R) : 0.f;
            if (act) R += u;
            const u32x4* vp = (const u32x4*)(Vb + (size_t)s * QKV_PITCH);
#pragma unroll
            for (int i = 0; i < 8; ++i) { const u32x4 w = vp[i];
                acc[i * 8 + 0] += a * bflo(w.x); acc[i * 8 + 1] += a * bfhi(w.x); acc[i * 8 + 2] += a * bflo(w.y); acc[i * 8 + 3] += a * bfhi(w.y);
                acc[i * 8 + 4] += a * bflo(w.z); acc[i * 8 + 5] += a * bfhi(w.z); acc[i * 8 + 6] += a * bflo(w.w); acc[i * 8 + 7] += a * bfhi(w.w); }
        }
    } else {
        const float slope = exp2f(-0.8f * (float)(MODE == 1 ? (2 * h + 1) : (2 * h + 2)));
        const int own = t >> 8;
        unsigned selm = 0u;
        if (MODE == 1) {
            const float* KM = (const float*)(p.ws + WS_KMEAN);
            float gate[8];
#pragma unroll
            for (int n = 0; n < 8; ++n) {
                gate[n] = -1e30f;
                if (n < own) {
                    const float* km = KM + (((size_t)b * 8 + n) * 5 + h) * 64;
                    float gsum = 0.f;
#pragma unroll
                    for (int d = 0; d < 64; ++d) gsum += q[d] * km[d];
                    gate[n] = gsum;
                }
            }
#pragma unroll
            for (int r = 0; r < 3; ++r) {
                float best = -3e38f; int bi = -1;
#pragma unroll
                for (int n = 0; n < 8; ++n) if (!((selm >> n) & 1u) && gate[n] > best) { best = gate[n]; bi = n; }
                if (bi >= 0) selm |= 1u << bi;
            }
            selm &= (1u << own) - 1u;
        }
        const unsigned* MASK = (const unsigned*)(p.ws + WS_MASK) + row * 64;
        float mx = -3e38f, l = 0.f;
        unsigned mw = 0u;
        for (int s = 0; s <= tmax; ++s) {
            bool allowed;
            if (MODE == 1) {
                const int n = s >> 8;
                allowed = (n < own) ? ((selm >> n) & 1u) : (s <= t);
            } else {
                if ((s & 31) == 0) mw = MASK[s >> 5];
                allowed = (mw >> (s & 31)) & 1u;
            }
            if (!__any(allowed)) continue;
            const u32x4* kp = (const u32x4*)(Kb + (size_t)s * QKV_PITCH);
            float z = 0.f;
#pragma unroll
            for (int i = 0; i < 8; ++i) { const u32x4 w = kp[i];
                z += q[i * 8 + 0] * bflo(w.x) + q[i * 8 + 1] * bfhi(w.x) + q[i * 8 + 2] * bflo(w.y) + q[i * 8 + 3] * bfhi(w.y)
                   + q[i * 8 + 4] * bflo(w.z) + q[i * 8 + 5] * bfhi(w.z) + q[i * 8 + 6] * bflo(w.w) + q[i * 8 + 7] * bfhi(w.w); }
            const float sc = z * 0.125f - slope * (float)(t - s);
            const float mn = allowed ? fmaxf(mx, sc) : mx;
            const float alpha = __expf(mx - mn);
            const float pp = allowed ? __expf(sc - mn) : 0.f;
            mx = mn; l = l * alpha + pp;
            const u32x4* vp = (const u32x4*)(Vb + (size_t)s * QKV_PITCH);
#pragma unroll
            for (int i = 0; i < 8; ++i) { const u32x4 w = vp[i];
                acc[i * 8 + 0] = acc[i * 8 + 0] * alpha + pp * bflo(w.x); acc[i * 8 + 1] = acc[i * 8 + 1] * alpha + pp * bfhi(w.x);
                acc[i * 8 + 2] = acc[i * 8 + 2] * alpha + pp * bflo(w.y); acc[i * 8 + 3] = acc[i * 8 + 3] * alpha + pp * bfhi(w.y);
                acc[i * 8 + 4] = acc[i * 8 + 4] * alpha + pp * bflo(w.z); acc[i * 8 + 5] = acc[i * 8 + 5] * alpha + pp * bfhi(w.z);
                acc[i * 8 + 6] = acc[i * 8 + 6] * alpha + pp * bflo(w.w); acc[i * 8 + 7] = acc[i * 8 + 7] * alpha + pp * bfhi(w.w); }
        }
        outscale = 1.f / l;
    }
    u32x4* op = (u32x4*)(OC + row * OC_PITCH + co + h * 64);
#pragma unroll
    for (int i = 0; i < 8; ++i) { u32x4 w;
        w.x = pk2(acc[i * 8 + 0] * outscale, acc[i * 8 + 1] * outscale); w.y = pk2(acc[i * 8 + 2] * outscale, acc[i * 8 + 3] * outscale);
        w.z = pk2(acc[i * 8 + 4] * outscale, acc[i * 8 + 5] * outscale); w.w = pk2(acc[i * 8 + 6] * outscale, acc[i * 8 + 7] * outscale);
        op[i] = w; }
}
template <int MODE> __device__ void phase_naive_attn(const Params& p) {
    constexpr int NH = MODE == 0 ? H_SB : 5;
    const int lane = threadIdx.x & 63, gw = blockIdx.x * NWAVES + (threadIdx.x >> 6), NGW = gridDim.x * NWAVES;
    const int nitems = BATCH * NH * 32;
    for (int it = gw; it < nitems; it += NGW) {
        const int qc = 31 - it / (BATCH * NH), bh = it % (BATCH * NH);
        naive_attn_item<MODE>(p, bh / NH, bh % NH, qc, lane);
    }
}
__device__ void phase_zero_pad(const Params& p) {
    bf16_t* OC = (bf16_t*)(p.ws + WS_R2);
    const int gt = blockIdx.x * NTHREADS + threadIdx.x, NT = gridDim.x * NTHREADS;
    for (int i = gt; i < T * 16; i += NT) {
        const int row = i >> 4, q = i & 15, col = (q < 8 ? 704 : 1088 - 64) + q * 8;
        *(u32x4*)(OC + (size_t)row * OC_PITCH + col) = (u32x4){0u, 0u, 0u, 0u};
    }
}

__global__ void __launch_bounds__(NTHREADS) mega_fwd(Params p) {
    cg::grid_group grid = cg::this_grid();
    __shared__ __attribute__((aligned(16))) float lds[24576];
    phase_mod(p, lds);
    grid.sync();
    bf16_t* R1 = (bf16_t*)(p.ws + WS_R1); bf16_t* R2 = (bf16_t*)(p.ws + WS_R2); bf16_t* R3 = (bf16_t*)(p.ws + WS_R3);
    phase_prenorm(p, p.x, p.g_pre_mix, 0, 0);
    grid.sync();
    for (int l = 0; l < DEPTH; ++l) {
        const float* xin = l == 0 ? p.x : p.out;
        const float* w_in = p.w_in + (size_t)l * DM * D_IN;
        {
            NGemm<1> g; g.s[0] = NSeg{R3, DM, w_in, D_IN, DM}; g.M = T; g.N = NQ1;
            NEpi e{R1, QKV_PITCH, nullptr, nullptr};
            naive_gemm<1, 0>(lds, g, e);
        }
        grid.sync();
        phase_kmean(p);
        phase_dsa_topk(p, lds);
        phase_naive_attn<0>(p);
        phase_zero_pad(p);
        grid.sync();
        phase_naive_attn<1>(p);
        phase_naive_attn<2>(p);
        grid.sync();
        {
            NGemm<1> g; g.s[0] = NSeg{R3, DM, w_in + NQ1, D_IN, DM}; g.M = T; g.N = NGATE;
            NEpi e{R1, NGATE, p.b_gate + l * NGATE, nullptr};
            naive_gemm<1, 1>(lds, g, e);
        }
        grid.sync();
        {
            NGemm<3> g;
            g.s[0] = NSeg{R2 + CO_SB, OC_PITCH, p.w_proj_sb + (size_t)l * 384 * DM, DM, 384};
            g.s[1] = NSeg{R2 + CO_MB, OC_PITCH, p.w_proj_mb + (size_t)l * 320 * DM, DM, 320};
            g.s[2] = NSeg{R2 + CO_DS, OC_PITCH, p.w_proj_ds + (size_t)l * 320 * DM, DM, 320};
            g.M = T; g.N = DM;
            NEpi e{R3, DM, nullptr, R1};
            naive_gemm<3, 2>(lds, g, e);
        }
        grid.sync();
        {
            NGemm<1> g; g.s[0] = NSeg{R3, DM, p.w_o + (size_t)l * DM * DM, DM, DM}; g.M = T; g.N = DM;
            NEpi e{R2, DM, nullptr, nullptr};
            naive_gemm<1, 0>(lds, g, e);
        }
        grid.sync();
        phase_postnorm(p, xin, p.g_post_mix + l * DM, l, 0);
        grid.sync();
        {
            const float* wu = p.w_up + (size_t)l * DM * 2 * DFF;
            NGemm<2> g; g.s[0] = NSeg{R3, DM, wu, 2 * DFF, DM}; g.s[1] = NSeg{R3, DM, wu + DFF, 2 * DFF, DM}; g.M = T; g.N = DFF;
            NEpi e{R1, DFF, nullptr, nullptr};
            naive_gemm<2, 3>(lds, g, e);
        }
        grid.sync();
        {
            NGemm<1> g; g.s[0] = NSeg{R1, DFF, p.w_down + (size_t)l * DFF * DM, DM, DFF}; g.M = T; g.N = DM;
            NEpi e{R2, DM, nullptr, nullptr};
            naive_gemm<1, 0>(lds, g, e);
        }
        grid.sync();
        phase_postnorm(p, p.out, p.g_post_ffn + l * DM, l, 1);
        grid.sync();
    }
}

extern "C" void kernel_launch(void* const* d_in, const int* in_sizes, int n_in, void* d_out, int out_size, void* d_ws, size_t ws_size, hipStream_t stream) {
    static int grid_blocks = 0;
    if (grid_blocks == 0) {
        if (n_in != 16 || out_size != T * DM || ws_size < WS_END) { fprintf(stderr, "kernel_launch: unexpected sizes n_in %d out %d ws %zu\n", n_in, out_size, ws_size); grid_blocks = -1; return; }
        int dev = 0, cus = 0, per_cu = 0;
        hipGetDevice(&dev);
        hipDeviceGetAttribute(&cus, hipDeviceAttributeMultiprocessorCount, dev);
        hipOccupancyMaxActiveBlocksPerMultiprocessor(&per_cu, (const void*)mega_fwd, NTHREADS, 0);
        if (per_cu < 1) per_cu = 1;
        if (per_cu > 1) per_cu = 1;
        grid_blocks = cus * per_cu;
        fprintf(stderr, "kernel_launch: cus %d per_cu %d grid %d ws %zu\n", cus, per_cu, grid_blocks, ws_size);
    }
    if (grid_blocks < 0) return;
    Params p{};
    p.x = (const float*)d_in[0]; p.c = (const float*)d_in[1]; p.w_ada = (const float*)d_in[2]; p.b_ada = (const float*)d_in[3];
    p.g_pre_mix = (const float*)d_in[4]; p.g_post_mix = (const float*)d_in[5]; p.w_in = (const float*)d_in[6]; p.b_gate = (const float*)d_in[7];
    p.w_proj_sb = (const float*)d_in[8]; p.w_proj_mb = (const float*)d_in[9]; p.w_proj_ds = (const float*)d_in[10]; p.w_o = (const float*)d_in[11];
    p.g_pre_ffn = (const float*)d_in[12]; p.g_post_ffn = (const float*)d_in[13]; p.w_up = (const float*)d_in[14]; p.w_down = (const float*)d_in[15];
    p.out = (float*)d_out; p.ws = (unsigned char*)d_ws;
    void* args[] = {&p};
    hipError_t e = hipLaunchCooperativeKernel((const void*)mega_fwd, dim3(grid_blocks), dim3(NTHREADS), args, 0, stream);
    if (e != hipSuccess) fprintf(stderr, "cooperative launch failed: %s (grid %d)\n", hipGetErrorString(e), grid_blocks);
}
```

```cpp
#include <hip/hip_runtime.h>
#include <hip/hip_cooperative_groups.h>
#include <cstdio>
#include <cstdint>
namespace cg = cooperative_groups;

typedef float f32x4 __attribute__((ext_vector_type(4)));
typedef unsigned u32x4 __attribute__((ext_vector_type(4)));
typedef unsigned u32x2 __attribute__((ext_vector_type(2)));
typedef unsigned short bf16_t;

constexpr int BATCH = 8, SEQ = 2048, DM = 1024, T = BATCH * SEQ, DEPTH = 2;
constexpr int HD = 64, H_SB = 6, H_MB = 5, H_DS = 5;
constexpr int D_IN = 6728, NQ1 = 3656, QKV_PITCH = 3840, NGATE = 3072, DFF = 2816;
constexpr int OC_PITCH = 1152;
constexpr int CQ_SB = 0, CK_SB = 384, CV_SB = 768, CQ_MB = 1152, CK_MB = 1472, CV_MB = 1792, CQ_DS = 2112, CK_DS = 2432, CV_DS = 2752, CQ_IX = 3072, CK_IX = 3584, CW_IX = 3648;
constexpr int CO_SB = 0, CO_MB = 384, CO_DS = 768;
constexpr float RMS_EPS = 1e-6f;
constexpr int NTHREADS = 512, NWAVES = 8;

constexpr size_t MiB = 1u << 20;
constexpr size_t WS_MOD = 1 * MiB;
constexpr size_t WS_KMEAN = 1 * MiB + 512 * 1024;
constexpr size_t WS_MASK = 2 * MiB;
constexpr size_t WS_WT = 6 * MiB;
constexpr size_t WS_R3 = 42 * MiB;
constexpr size_t WS_R2 = 74 * MiB;
constexpr size_t WS_R1 = 110 * MiB;
constexpr size_t WS_END = 230 * MiB;

struct Params {
    const float* x; const float* c; const float* w_ada; const float* b_ada; const float* g_pre_mix; const float* g_post_mix;
    const float* w_in; const float* b_gate; const float* w_proj_sb; const float* w_proj_mb; const float* w_proj_ds; const float* w_o;
    const float* g_pre_ffn; const float* g_post_ffn; const float* w_up; const float* w_down;
    float* out; unsigned char* ws; unsigned long long mask;
};

struct Ctx { int bid, nblk, wid; };
__device__ __forceinline__ float bf2f(unsigned short b) { return __uint_as_float((unsigned)b << 16); }
__device__ __forceinline__ float bflo(unsigned w) { return __uint_as_float(w << 16); }
__device__ __forceinline__ float bfhi(unsigned w) { return __uint_as_float(w & 0xffff0000u); }
__device__ __forceinline__ unsigned f2bf(float f) { unsigned u = __float_as_uint(f); return (u + 0x7fffu + ((u >> 16) & 1u)) >> 16; }
__device__ __forceinline__ unsigned pk2(float lo, float hi) { return f2bf(lo) | (f2bf(hi) << 16); }
__device__ __forceinline__ float wave_sum(float v) {
#pragma unroll
    for (int o = 1; o < 64; o <<= 1) v += __shfl_xor(v, o);
    return v;
}
__device__ __forceinline__ int lane_id_opaque() { int l; asm volatile("v_mbcnt_lo_u32_b32 %0, -1, 0\n\tv_mbcnt_hi_u32_b32 %0, -1, %0" : "=v"(l)); return l; }
#define TIDX (wid * 64 + lane_id_opaque())
__device__ __forceinline__ float sigmoidf_(float v) { return 1.f / (1.f + __expf(-v)); }

__device__ __forceinline__ void phase_mod(const Params& p, float* lds, Ctx cx) { const int wid = cx.wid, BID = cx.bid, NBLK = cx.nblk; (void)wid; (void)BID; (void)NBLK;
    float* MOD = (float*)(p.ws + WS_MOD);
    const int tid = TIDX;
    float* cact = lds;
    float* red = lds + 8 * 1024;
    for (int i = tid; i < 8 * 1024; i += NTHREADS) { const float v = p.c[i]; cact[i] = v * sigmoidf_(v); }
    __syncthreads();
    for (int item = BID; item < 2 * 96; item += NBLK) {
        const int l = item / 96, ct = item % 96, kg = tid >> 6, col = ct * 64 + (tid & 63);
        const float* W = p.w_ada + (size_t)l * 1024 * 6144 + col;
        float acc[8];
#pragma unroll
        for (int b = 0; b < 8; ++b) acc[b] = 0.f;
        for (int k = kg; k < 1024; k += 8) {
            const float w = W[(size_t)k * 6144];
#pragma unroll
            for (int b = 0; b < 8; ++b) acc[b] += cact[b * 1024 + k] * w;
        }
#pragma unroll
        for (int b = 0; b < 8; ++b) red[(kg * 8 + b) * 64 + (tid & 63)] = acc[b];
        __syncthreads();
        {
            const int b = tid >> 6, cc = tid & 63;
            float s = 0.f;
#pragma unroll
            for (int g = 0; g < 8; ++g) s += red[(g * 8 + b) * 64 + cc];
            MOD[((size_t)l * 8 + b) * 6144 + ct * 64 + cc] = s + p.b_ada[l * 6144 + ct * 64 + cc];
        }
        __syncthreads();
    }
}

__device__ __forceinline__ void normmod_row(const f32x4 (&v)[4], float rstd, const float* g, const float* sc, const float* sh, bf16_t* orow, int lane) {
#pragma unroll
    for (int j = 0; j < 4; ++j) {
        const int c0 = 4 * lane + 256 * j;
        const f32x4 gg = *(const f32x4*)(g + c0), s1 = *(const f32x4*)(sc + c0), s0 = *(const f32x4*)(sh + c0);
        f32x4 o;
#pragma unroll
        for (int e = 0; e < 4; ++e) o[e] = v[j][e] * rstd * gg[e] * (1.f + s1[e]) + s0[e];
        u32x2 w; w.x = pk2(o[0], o[1]); w.y = pk2(o[2], o[3]);
        *(u32x2*)(orow + c0) = w;
    }
}
__device__ __forceinline__ void phase_prenorm(const Params& p, const float* xin, const float* g, int l, int which, Ctx cx) { const int wid = cx.wid, BID = cx.bid, NBLK = cx.nblk; (void)wid; (void)BID; (void)NBLK;
    const float* MOD = (const float*)(p.ws + WS_MOD) + (size_t)l * 8 * 6144;
    bf16_t* XN = (bf16_t*)(p.ws + WS_R3);
    const int lane = lane_id_opaque(), gw = BID * NWAVES + wid, NGW = NBLK * NWAVES;
    for (int m = gw; m < T; m += NGW) {
        const int b = m / SEQ;
        const f32x4* xr = (const f32x4*)(xin + (size_t)m * DM) + lane;
        f32x4 v[4]; float s = 0.f;
#pragma unroll
        for (int j = 0; j < 4; ++j) { v[j] = xr[64 * j]; s += (v[j][0] * v[j][0] + v[j][1] * v[j][1]) + (v[j][2] * v[j][2] + v[j][3] * v[j][3]); }
        const float rstd = rsqrtf(wave_sum(s) * (1.f / DM) + RMS_EPS);
        const float* mb = MOD + (size_t)b * 6144 + which * 3072;
        normmod_row(v, rstd, g, mb + 1024, mb, XN + (size_t)m * DM, lane);
    }
}
__device__ __forceinline__ void phase_postnorm(const Params& p, const float* xin, const float* gpost, int l, int which, Ctx cx) { const int wid = cx.wid, BID = cx.bid, NBLK = cx.nblk; (void)wid; (void)BID; (void)NBLK;
    const float* MODl = (const float*)(p.ws + WS_MOD) + (size_t)l * 8 * 6144;
    const bf16_t* Y = (const bf16_t*)(p.ws + WS_R2);
    bf16_t* XN = (bf16_t*)(p.ws + WS_R3);
    const int lane = lane_id_opaque(), gw = BID * NWAVES + wid, NGW = NBLK * NWAVES;
    const float* gnext = which == 0 ? p.g_pre_ffn + l * DM : (l + 1 < DEPTH ? p.g_pre_mix + (l + 1) * DM : nullptr);
    for (int m = gw; m < T; m += NGW) {
        const int b = m / SEQ;
        const float* gate = MODl + (size_t)b * 6144 + (which == 0 ? 2048 : 5120);
        f32x4 y[4]; float s = 0.f;
#pragma unroll
        for (int j = 0; j < 4; ++j) {
            const u32x2 w = *(const u32x2*)(Y + (size_t)m * DM + 4 * lane + 256 * j);
            y[j] = (f32x4){bflo(w.x), bfhi(w.x), bflo(w.y), bfhi(w.y)};
            s += (y[j][0] * y[j][0] + y[j][1] * y[j][1]) + (y[j][2] * y[j][2] + y[j][3] * y[j][3]);
        }
        const float rstd = rsqrtf(wave_sum(s) * (1.f / DM) + RMS_EPS);
        f32x4 v[4]; float s2 = 0.f;
#pragma unroll
        for (int j = 0; j < 4; ++j) {
            const int c0 = 4 * lane + 256 * j;
            const f32x4 xi = *(const f32x4*)(xin + (size_t)m * DM + c0), gp = *(const f32x4*)(gpost + c0), gt = *(const f32x4*)(gate + c0);
#pragma unroll
            for (int e = 0; e < 4; ++e) v[j][e] = xi[e] + gt[e] * (y[j][e] * rstd * gp[e]);
            *(f32x4*)(p.out + (size_t)m * DM + c0) = v[j];
            s2 += (v[j][0] * v[j][0] + v[j][1] * v[j][1]) + (v[j][2] * v[j][2] + v[j][3] * v[j][3]);
        }
        if (gnext) {
            const float rstd2 = rsqrtf(wave_sum(s2) * (1.f / DM) + RMS_EPS);
            const float* mb = which == 0 ? MODl + (size_t)b * 6144 + 3072 : MODl + (size_t)8 * 6144 + (size_t)b * 6144;
            normmod_row(v, rstd2, gnext, mb + 1024, mb, XN + (size_t)m * DM, lane);
        }
    }
}

struct NSeg { const bf16_t* A; int lda; const float* W; int ldw; int K; };
template <int NSEG> struct NGemm { NSeg s[NSEG]; int M, N; };
struct NEpi { bf16_t* C; int ldc; const float* bias; const bf16_t* gates; };
template <int NSEG, int EPI> __device__ __forceinline__ void naive_gemm(float* lds, const NGemm<NSEG>& g, const NEpi& e, Ctx cx) { const int wid = cx.wid, BID = cx.bid, NBLK = cx.nblk; (void)wid; (void)BID; (void)NBLK;
    float* As = lds;
    float* Bs = lds + 16 * 68;
    const int tid = TIDX, ty = tid >> 5, tx = tid & 31;
    const int tm = g.M / 64, tn = (g.N + 127) / 128;
    for (int item = BID; item < tm * tn; item += NBLK) {
        const int m0 = (item / tn) * 64, n0 = (item % tn) * 128;
        float acc[NSEG][4][4];
#pragma unroll
        for (int s = 0; s < NSEG; ++s)
#pragma unroll
            for (int i = 0; i < 4; ++i)
#pragma unroll
                for (int j = 0; j < 4; ++j) acc[s][i][j] = 0.f;
#pragma unroll
        for (int s = 0; s < NSEG; ++s) {
            const NSeg sg = g.s[s];
#pragma unroll 1
            for (int k0 = 0; k0 < sg.K; k0 += 16) {
                __syncthreads();
                {
                    const int r = tid >> 3, kq = tid & 7;
                    const unsigned w = *(const unsigned*)(sg.A + (size_t)(m0 + r) * sg.lda + k0 + kq * 2);
                    As[(kq * 2 + 0) * 68 + r] = bflo(w); As[(kq * 2 + 1) * 68 + r] = bfhi(w);
                    const int k = tid >> 5, nq = tid & 31, n = n0 + nq * 4;
                    f32x4 bv = (f32x4){0.f, 0.f, 0.f, 0.f};
                    if (n < g.N) bv = *(const f32x4*)(sg.W + (size_t)(k0 + k) * sg.ldw + n);
                    *(f32x4*)(Bs + k * 132 + nq * 4) = bv;
                }
                __syncthreads();
#pragma unroll 4
                for (int k = 0; k < 16; ++k) {
                    const f32x4 a0 = *(const f32x4*)(As + k * 68 + ty * 4), b = *(const f32x4*)(Bs + k * 132 + tx * 4);
#pragma unroll
                    for (int i = 0; i < 4; ++i)
#pragma unroll
                        for (int j = 0; j < 4; ++j) acc[s][i][j] += a0[i] * b[j];
                }
            }
        }
        const int col = n0 + tx * 4;
        if (col < g.N) {
#pragma unroll
            for (int i = 0; i < 4; ++i) {
                const int row = m0 + ty * 4 + i;
                float o[4];
                if (EPI == 0) {
#pragma unroll
                    for (int j = 0; j < 4; ++j) o[j] = acc[0][i][j];
                } else if (EPI == 1) {
#pragma unroll
                    for (int j = 0; j < 4; ++j) o[j] = sigmoidf_(acc[0][i][j] + e.bias[col + j]);
                } else if (EPI == 2) {
#pragma unroll
                    for (int j = 0; j < 4; ++j) o[j] = 0.f;
#pragma unroll
                    for (int s = 0; s < NSEG; ++s) {
                        const u32x2 gw = *(const u32x2*)(e.gates + (size_t)row * NGATE + s * 1024 + col);
                        o[0] += bflo(gw.x) * acc[s][i][0]; o[1] += bfhi(gw.x) * acc[s][i][1]; o[2] += bflo(gw.y) * acc[s][i][2]; o[3] += bfhi(gw.y) * acc[s][i][3];
                    }
                } else {
#pragma unroll
                    for (int j = 0; j < 4; ++j) { const float gt = acc[0][i][j]; o[j] = gt * sigmoidf_(gt) * acc[NSEG - 1][i][j]; }
                }
                u32x2 w; w.x = pk2(o[0], o[1]); w.y = pk2(o[2], o[3]);
                *(u32x2*)(e.C + (size_t)row * e.ldc + col) = w;
            }
        }
    }
}

__device__ __forceinline__ void phase_kmean(const Params& p, Ctx cx) { const int wid = cx.wid, BID = cx.bid, NBLK = cx.nblk; (void)wid; (void)BID; (void)NBLK;
    const bf16_t* QKV = (const bf16_t*)(p.ws + WS_R1);
    float* KM = (float*)(p.ws + WS_KMEAN);
    const int gt = BID * NTHREADS + TIDX, NT = NBLK * NTHREADS;
    for (int o = gt; o < 8 * 8 * 320; o += NT) {
        const int c = o % 320, n = (o / 320) % 8, b = o / (320 * 8);
        const bf16_t* kp = QKV + (size_t)(b * SEQ + n * 256) * QKV_PITCH + CK_MB + c;
        float s = 0.f;
        for (int r = 0; r < 256; ++r) s += bf2f(kp[(size_t)r * QKV_PITCH]);
        KM[o] = s * (1.f / 256.f);
    }
}

__device__ __forceinline__ unsigned ordkey(float f) { const unsigned u = __float_as_uint(f); return u ^ ((u >> 31) ? 0xffffffffu : 0x80000000u); }
__device__ __forceinline__ void phase_dsa_topk(const Params& p, float* lds, Ctx cx) { const int wid = cx.wid, BID = cx.bid, NBLK = cx.nblk; (void)wid; (void)BID; (void)NBLK;
    const bf16_t* QKV = (const bf16_t*)(p.ws + WS_R1);
    unsigned* MASK = (unsigned*)(p.ws + WS_MASK);
    const int lane = lane_id_opaque(), wave = wid, gw = BID * NWAVES + wave, NGW = NBLK * NWAVES;
    float* qs = lds + wave * 520;
    unsigned* skey = (unsigned*)(lds + 8 * 520) + wave * 2048;
    for (int m = gw; m < T; m += NGW) {
        const int b = m / SEQ, t = m % SEQ;
        const bf16_t* qrow = QKV + (size_t)m * QKV_PITCH;
        {
            const u32x4 w = *(const u32x4*)(qrow + CQ_IX + lane * 8);
            qs[lane * 8 + 0] = bflo(w.x); qs[lane * 8 + 1] = bfhi(w.x); qs[lane * 8 + 2] = bflo(w.y); qs[lane * 8 + 3] = bfhi(w.y);
            qs[lane * 8 + 4] = bflo(w.z); qs[lane * 8 + 5] = bfhi(w.z); qs[lane * 8 + 6] = bflo(w.w); qs[lane * 8 + 7] = bfhi(w.w);
            if (lane < 8) qs[512 + lane] = bf2f(qrow[CW_IX + lane]);
        }
        asm volatile("s_waitcnt lgkmcnt(0)" ::: "memory");
        __builtin_amdgcn_wave_barrier();
        const int ni = (t >> 6) + 1;
#pragma unroll 1
        for (int i = 0; i < ni; ++i) {
            const int s = i * 64 + lane;
            const u32x4* kp = (const u32x4*)(QKV + (size_t)(b * SEQ + s) * QKV_PITCH + CK_IX);
            u32x4 kw[8];
#pragma unroll
            for (int q = 0; q < 8; ++q) kw[q] = kp[q];
            float sc = 0.f;
#pragma unroll 1
            for (int h = 0; h < 8; ++h) {
                float lg = 0.f;
#pragma unroll
                for (int q = 0; q < 8; ++q) {
                    const f32x4 q0 = *(const f32x4*)(qs + h * 64 + q * 8), q1 = *(const f32x4*)(qs + h * 64 + q * 8 + 4);
                    lg += q0[0] * bflo(kw[q].x) + q0[1] * bfhi(kw[q].x) + q0[2] * bflo(kw[q].y) + q0[3] * bfhi(kw[q].y)
                        + q1[0] * bflo(kw[q].z) + q1[1] * bfhi(kw[q].z) + q1[2] * bflo(kw[q].w) + q1[3] * bfhi(kw[q].w);
                }
                sc += qs[512 + h] * fmaxf(lg, 0.f);
            }
            if (sc == 0.f) sc = 0.f;
            skey[s] = (s <= t) ? ordkey(sc) : 0u;
        }
        asm volatile("s_waitcnt lgkmcnt(0)" ::: "memory");
        __builtin_amdgcn_wave_barrier();
        unsigned key[32];
#pragma unroll
        for (int i = 0; i < 32; ++i) key[i] = (i < ni) ? skey[i * 64 + lane] : 0u;
        unsigned w = 0u;
        if (t + 1 <= 256) {
#pragma unroll
            for (int i = 0; i < 32; ++i) { const unsigned long long sb = __ballot(key[i] != 0u); if ((lane >> 1) == i) w = (lane & 1) ? (unsigned)(sb >> 32) : (unsigned)sb; }
        } else {
            unsigned Tk = 0u;
#pragma unroll 1
            for (int bit = 31; bit >= 0; --bit) {
                const unsigned cand = Tk | (1u << bit);
                int cnt = 0;
#pragma unroll
                for (int i = 0; i < 32; ++i) cnt += __popcll(__ballot(key[i] >= cand));
                if (cnt >= 256) Tk = cand;
            }
            int cgt = 0;
#pragma unroll
            for (int i = 0; i < 32; ++i) cgt += __popcll(__ballot(key[i] > Tk));
            int need = 256 - cgt;
#pragma unroll
            for (int i = 0; i < 32; ++i) {
                const unsigned long long gtb = __ballot(key[i] > Tk), eqb = __ballot(key[i] == Tk);
                unsigned long long take = 0ull;
                const int ne = __popcll(eqb);
                if (need > 0 && ne > 0) {
                    if (ne <= need) { take = eqb; need -= ne; }
                    else {
                        unsigned long long rem = eqb;
                        for (int q = 0; q < need; ++q) { const unsigned long long low = rem & (~rem + 1ull); take |= low; rem ^= low; }
                        need = 0;
                    }
                }
                const unsigned long long sb = gtb | take;
                if ((lane >> 1) == i) w = (lane & 1) ? (unsigned)(sb >> 32) : (unsigned)sb;
            }
        }
        MASK[(size_t)m * 64 + lane] = w;
        __builtin_amdgcn_wave_barrier();
    }
}

template <int MODE> __device__ __forceinline__ void naive_attn_item(const Params& p, int b, int h, int qc, int lane) {
    const bf16_t* QKV = (const bf16_t*)(p.ws + WS_R1);
    bf16_t* OC = (bf16_t*)(p.ws + WS_R2);
    constexpr int cq = MODE == 0 ? CQ_SB : MODE == 1 ? CQ_MB : CQ_DS, ck = MODE == 0 ? CK_SB : MODE == 1 ? CK_MB : CK_DS, cv = MODE == 0 ? CV_SB : MODE == 1 ? CV_MB : CV_DS;
    constexpr int co = MODE == 0 ? CO_SB : MODE == 1 ? CO_MB : CO_DS;
    const int t = qc * 64 + lane; const size_t row = (size_t)b * SEQ + t;
    float q[64], acc[64];
    {
        const u32x4* qp = (const u32x4*)(QKV + row * QKV_PITCH + cq + h * 64);
#pragma unroll
        for (int i = 0; i < 8; ++i) { const u32x4 w = qp[i];
            q[i * 8 + 0] = bflo(w.x); q[i * 8 + 1] = bfhi(w.x); q[i * 8 + 2] = bflo(w.y); q[i * 8 + 3] = bfhi(w.y);
            q[i * 8 + 4] = bflo(w.z); q[i * 8 + 5] = bfhi(w.z); q[i * 8 + 6] = bflo(w.w); q[i * 8 + 7] = bfhi(w.w); }
    }
#pragma unroll
    for (int d = 0; d < 64; ++d) acc[d] = 0.f;
    const bf16_t* Kb = QKV + (size_t)b * SEQ * QKV_PITCH + ck + h * 64;
    const bf16_t* Vb = QKV + (size_t)b * SEQ * QKV_PITCH + cv + h * 64;
    const int tmax = qc * 64 + 63;
    float outscale = 1.f;
    if (MODE == 0) {
        float R = 0.f;
        for (int s = tmax - 1; s >= 0; --s) {
            const u32x4* kp = (const u32x4*)(Kb + (size_t)s * QKV_PITCH);
            float z = 0.f;
#pragma unroll
            for (int i = 0; i < 8; ++i) { const u32x4 w = kp[i];
                z += q[i * 8 + 0] * bflo(w.x) + q[i * 8 + 1] * bfhi(w.x) + q[i * 8 + 2] * bflo(w.y) + q[i * 8 + 3] * bfhi(w.y)
                   + q[i * 8 + 4] * bflo(w.z) + q[i * 8 + 5] * bfhi(w.z) + q[i * 8 + 6] * bflo(w.w) + q[i * 8 + 7] * bfhi(w.w); }
            z *= 0.125f;
            const float u = -(fmaxf(z, 0.f) + log1pf(__expf(-fabsf(z))));
            const bool act = s < t;
            const float a = act ? __expf(z + u + R) : 0.f;
            if (act) R += u;
            const u32x4* vp = (const u32x4*)(Vb + (size_t)s * QKV_PITCH);
#pragma unroll
            for (int i = 0; i < 8; ++i) { const u32x4 w = vp[i];
                acc[i * 8 + 0] += a * bflo(w.x); acc[i * 8 + 1] += a * bfhi(w.x); acc[i * 8 + 2] += a * bflo(w.y); acc[i * 8 + 3] += a * bfhi(w.y);
                acc[i * 8 + 4] += a * bflo(w.z); acc[i * 8 + 5] += a * bfhi(w.z); acc[i * 8 + 6] += a * bflo(w.w); acc[i * 8 + 7] += a * bfhi(w.w); }
        }
    } else {
        const float slope = exp2f(-0.8f * (float)(MODE == 1 ? (2 * h + 1) : (2 * h + 2)));
        const int own = t >> 8;
        unsigned selm = 0u;
        if (MODE == 1) {
            const float* KM = (const float*)(p.ws + WS_KMEAN);
            float gate[8];
#pragma unroll
            for (int n = 0; n < 8; ++n) {
                gate[n] = -1e30f;
                if (n < own) {
                    const float* km = KM + (((size_t)b * 8 + n) * 5 + h) * 64;
                    float gsum = 0.f;
#pragma unroll
                    for (int d = 0; d < 64; ++d) gsum += q[d] * km[d];
                    gate[n] = gsum;
                }
            }
#pragma unroll
            for (int r = 0; r < 3; ++r) {
                float best = -3e38f; int bi = -1;
#pragma unroll
                for (int n = 0; n < 8; ++n) if (!((selm >> n) & 1u) && gate[n] > best) { best = gate[n]; bi = n; }
                if (bi >= 0) selm |= 1u << bi;
            }
            selm &= (1u << own) - 1u;
        }
        const unsigned* MASK = (const unsigned*)(p.ws + WS_MASK) + row * 64;
        float mx = -3e38f, l = 0.f;
        unsigned mw = 0u;
        for (int s = 0; s <= tmax; ++s) {
            bool allowed;
            if (MODE == 1) {
                const int n = s >> 8;
                allowed = (n < own) ? ((selm >> n) & 1u) : (s <= t);
            } else {
                if ((s & 31) == 0) mw = MASK[s >> 5];
                allowed = (mw >> (s & 31)) & 1u;
            }
            if (!__any(allowed)) continue;
            const u32x4* kp = (const u32x4*)(Kb + (size_t)s * QKV_PITCH);
            float z = 0.f;
#pragma unroll
            for (int i = 0; i < 8; ++i) { const u32x4 w = kp[i];
                z += q[i * 8 + 0] * bflo(w.x) + q[i * 8 + 1] * bfhi(w.x) + q[i * 8 + 2] * bflo(w.y) + q[i * 8 + 3] * bfhi(w.y)
                   + q[i * 8 + 4] * bflo(w.z) + q[i * 8 + 5] * bfhi(w.z) + q[i * 8 + 6] * bflo(w.w) + q[i * 8 + 7] * bfhi(w.w); }
            const float sc = z * 0.125f - slope * (float)(t - s);
            const float mn = allowed ? fmaxf(mx, sc) : mx;
            const float alpha = __expf(mx - mn);
            const float pp = allowed ? __expf(sc - mn) : 0.f;
            mx = mn; l = l * alpha + pp;
            const u32x4* vp = (const u32x4*)(Vb + (size_t)s * QKV_PITCH);
#pragma unroll
            for (int i = 0; i < 8; ++i) { const u32x4 w = vp[i];
                acc[i * 8 + 0] = acc[i * 8 + 0] * alpha + pp * bflo(w.x); acc[i * 8 + 1] = acc[i * 8 + 1] * alpha + pp * bfhi(w.x);
                acc[i * 8 + 2] = acc[i * 8 + 2] * alpha + pp * bflo(w.y); acc[i * 8 + 3] = acc[i * 8 + 3] * alpha + pp * bfhi(w.y);
                acc[i * 8 + 4] = acc[i * 8 + 4] * alpha + pp * bflo(w.z); acc[i * 8 + 5] = acc[i * 8 + 5] * alpha + pp * bfhi(w.z);
                acc[i * 8 + 6] = acc[i * 8 + 6] * alpha + pp * bflo(w.w); acc[i * 8 + 7] = acc[i * 8 + 7] * alpha + pp * bfhi(w.w); }
        }
        outscale = 1.f / l;
    }
    u32x4* op = (u32x4*)(OC + row * OC_PITCH + co + h * 64);
#pragma unroll
    for (int i = 0; i < 8; ++i) { u32x4 w;
        w.x = pk2(acc[i * 8 + 0] * outscale, acc[i * 8 + 1] * outscale); w.y = pk2(acc[i * 8 + 2] * outscale, acc[i * 8 + 3] * outscale);
        w.z = pk2(acc[i * 8 + 4] * outscale, acc[i * 8 + 5] * outscale); w.w = pk2(acc[i * 8 + 6] * outscale, acc[i * 8 + 7] * outscale);
        op[i] = w; }
}
template <int MODE> __device__ __forceinline__ void phase_naive_attn(const Params& p, Ctx cx) { const int wid = cx.wid, BID = cx.bid, NBLK = cx.nblk; (void)wid; (void)BID; (void)NBLK;
    constexpr int NH = MODE == 0 ? H_SB : 5;
    const int lane = lane_id_opaque(), gw = BID * NWAVES + wid, NGW = NBLK * NWAVES;
    const int nitems = BATCH * NH * 32;
    for (int it = gw; it < nitems; it += NGW) {
        const int qc = 31 - it / (BATCH * NH), bh = it % (BATCH * NH);
        naive_attn_item<MODE>(p, bh / NH, bh % NH, qc, lane);
    }
}
__device__ __forceinline__ void phase_zero_pad(const Params& p, Ctx cx) { const int wid = cx.wid, BID = cx.bid, NBLK = cx.nblk; (void)wid; (void)BID; (void)NBLK;
    bf16_t* OC = (bf16_t*)(p.ws + WS_R2);
    const int gt = BID * NTHREADS + TIDX, NT = NBLK * NTHREADS;
    for (int i = gt; i < T * 16; i += NT) {
        const int row = i >> 4, q = i & 15, col = (q < 8 ? 704 : 1088 - 64) + q * 8;
        *(u32x4*)(OC + (size_t)row * OC_PITCH + col) = (u32x4){0u, 0u, 0u, 0u};
    }
}

namespace pg8 {
#define PG8_LAS __attribute__((address_space(3)))
typedef unsigned short bf16_t;
typedef short bf16x8 __attribute__((ext_vector_type(8)));
typedef float f32x4 __attribute__((ext_vector_type(4)));
typedef unsigned u32x4 __attribute__((ext_vector_type(4)));
constexpr int BM = 256, BK = 64, HALF = 128, HTB = HALF * BK * 2  , STAGE_BYTES = 8 * HTB, NXCD = 8, WGM = 8;

__host__ __device__ __forceinline__ int lds_byte(int r, int c) { const int st = (r >> 4) * 2 + (c >> 5), rr = r & 15, cc = c & 31, ob = rr * 64 + cc * 2; return st * 1024 + (ob ^ (((ob >> 9) & 1) << 5)); }
__host__ __device__ __forceinline__ void stage_rc(int b, int& R, int& C) { const int st = b / 1024, sb = b % 1024, swz = sb ^ (((sb >> 9) & 1) << 5); R = (st >> 1) * 16 + swz / 64; C = (st & 1) * 32 + (swz % 64) / 2; }
__host__ __device__ __forceinline__ int perm32(int rho) { const int n = rho >> 4, i = rho & 15; return 8 * (i >> 2) + 4 * n + (i & 3); }

struct Unit { int pm, pn; };
struct Gemm { const bf16_t* A; const bf16_t* Bt; int M, N, K, lda; };

struct StaticOrder {
    int nM, nN, nwg, G, c;
    __host__ __device__ void init(int M, int N, int G_, int c_) { nM = M / BM; nN = N / BM; nwg = nM * nN; G = G_; c = c_; }
    __host__ __device__ bool next(int i, Unit& u) const {
        const long L = (long)i * G + c; if (L >= nwg) return false;
        int wgid = (int)L; { const int q = nwg / NXCD, r = nwg % NXCD, xcd = wgid % NXCD, off = wgid / NXCD; wgid = (xcd < r ? xcd * (q + 1) : r * (q + 1) + (xcd - r) * q) + off; }
        const int nig = WGM * nN, gid = wgid / nig, fm = gid * WGM, gsz = (nM - fm) < WGM ? (nM - fm) : WGM;
        u.pm = fm + ((wgid % nig) % gsz); u.pn = (wgid % nig) / gsz; return true;
    }
    __device__ __forceinline__ void a_ready(const Unit&) const {}
    __device__ __forceinline__ void done(const Unit&) const {}
};


typedef float f32x2_t __attribute__((ext_vector_type(2))); typedef __bf16 bf16x2_t __attribute__((ext_vector_type(2)));
__device__ __forceinline__ unsigned cvt_pk_bf16(float lo, float hi) { f32x2_t v = {lo, hi}; bf16x2_t b = __builtin_convertvector(v, bf16x2_t); return __builtin_bit_cast(unsigned, b); }
struct EpiBf16 {
    static constexpr bool PERM = true, AFTER_DRAIN = false;
    bf16_t* O; int ldc;
    __device__ __forceinline__ void operator()(const f32x4 (&acc)[2][2][4][2], const Unit& u, int wr, int wc, int fr, int fq) const {
        const int row0 = u.pm * BM + wr * 64 + fr, col0 = u.pn * BM + wc * 32 + 8 * fq;
#pragma unroll
        for (int ai = 0; ai < 2; ++ai)
#pragma unroll
            for (int m = 0; m < 4; ++m) { bf16_t* rowp = O + (size_t)(row0 + ai * HALF + m * 16) * ldc + col0;
#pragma unroll
                for (int bj = 0; bj < 2; ++bj) { const f32x4 v0 = acc[ai][bj][m][0], v1 = acc[ai][bj][m][1];
                    u32x4 w; w.x = cvt_pk_bf16(v0[0], v0[1]); w.y = cvt_pk_bf16(v0[2], v0[3]); w.z = cvt_pk_bf16(v1[0], v1[1]); w.w = cvt_pk_bf16(v1[2], v1[3]);
                    *(u32x4*)(rowp + bj * HALF) = w; } }
    }
};

__device__ __forceinline__ float fast_sigmoid(float v) { return __builtin_amdgcn_rcpf(1.f + __builtin_amdgcn_exp2f(-1.4426950408889634f * v)); }
struct EpiSigmoid {
    static constexpr bool PERM = true, AFTER_DRAIN = false;
    bf16_t* O; int ldc; const float* bias;
    __device__ __forceinline__ void operator()(const f32x4 (&acc)[2][2][4][2], const Unit& u, int wr, int wc, int fr, int fq) const {
        const int row0 = u.pm * BM + wr * 64 + fr, col0 = u.pn * BM + wc * 32 + 8 * fq;
        f32x4 bv[2][2];
#pragma unroll
        for (int bj = 0; bj < 2; ++bj)
#pragma unroll
            for (int n = 0; n < 2; ++n) bv[bj][n] = *(const f32x4*)(bias + col0 + bj * HALF + 4 * n);
#pragma unroll
        for (int ai = 0; ai < 2; ++ai)
#pragma unroll
            for (int m = 0; m < 4; ++m) { bf16_t* rowp = O + (size_t)(row0 + ai * HALF + m * 16) * ldc + col0;
#pragma unroll
                for (int bj = 0; bj < 2; ++bj) { const f32x4 v0 = acc[ai][bj][m][0] + bv[bj][0], v1 = acc[ai][bj][m][1] + bv[bj][1];
                    u32x4 w; w.x = cvt_pk_bf16(fast_sigmoid(v0[0]), fast_sigmoid(v0[1])); w.y = cvt_pk_bf16(fast_sigmoid(v0[2]), fast_sigmoid(v0[3]));
                    w.z = cvt_pk_bf16(fast_sigmoid(v1[0]), fast_sigmoid(v1[1])); w.w = cvt_pk_bf16(fast_sigmoid(v1[2]), fast_sigmoid(v1[3]));
                    *(u32x4*)(rowp + bj * HALF) = w; } }
    }
};
struct EpiGate {
    static constexpr bool PERM = true, AFTER_DRAIN = false;
    bf16_t* O; const bf16_t* gates; int br;
    __device__ __forceinline__ void operator()(const f32x4 (&acc)[2][2][4][2], const Unit& u, int wr, int wc, int fr, int fq) const {
        const int row0 = u.pm * BM + wr * 64 + fr, col0 = u.pn * BM + wc * 32 + 8 * fq;
#pragma unroll
        for (int ai = 0; ai < 2; ++ai)
#pragma unroll
            for (int m = 0; m < 4; ++m) { const size_t row = (size_t)(row0 + ai * HALF + m * 16);
#pragma unroll
                for (int bj = 0; bj < 2; ++bj) {
                    const u32x4 gw = *(const u32x4*)(gates + row * 3072 + br * 1024 + col0 + bj * HALF);
                    u32x4 ow = (u32x4){0u, 0u, 0u, 0u};
                    if (br > 0) ow = *(const u32x4*)(O + row * 1024 + col0 + bj * HALF);
                    const f32x4 v0 = acc[ai][bj][m][0], v1 = acc[ai][bj][m][1];
                    u32x4 w;
                    w.x = cvt_pk_bf16(__uint_as_float(ow.x << 16) + __uint_as_float(gw.x << 16) * v0[0], __uint_as_float(ow.x & 0xffff0000u) + __uint_as_float(gw.x & 0xffff0000u) * v0[1]);
                    w.y = cvt_pk_bf16(__uint_as_float(ow.y << 16) + __uint_as_float(gw.y << 16) * v0[2], __uint_as_float(ow.y & 0xffff0000u) + __uint_as_float(gw.y & 0xffff0000u) * v0[3]);
                    w.z = cvt_pk_bf16(__uint_as_float(ow.z << 16) + __uint_as_float(gw.z << 16) * v1[0], __uint_as_float(ow.z & 0xffff0000u) + __uint_as_float(gw.z & 0xffff0000u) * v1[1]);
                    w.w = cvt_pk_bf16(__uint_as_float(ow.w << 16) + __uint_as_float(gw.w << 16) * v1[2], __uint_as_float(ow.w & 0xffff0000u) + __uint_as_float(gw.w & 0xffff0000u) * v1[3]);
                    *(u32x4*)(O + row * 1024 + col0 + bj * HALF) = w; } }
    }
};
struct EpiSwiglu {
    static constexpr bool PERM = true, AFTER_DRAIN = false;
    bf16_t* O; int ldc;
    __device__ __forceinline__ void operator()(const f32x4 (&acc)[2][2][4][2], const Unit& u, int wr, int wc, int fr, int fq) const {
        const int row0 = u.pm * BM + wr * 64 + fr, col0 = u.pn * HALF + wc * 32 + 8 * fq;
#pragma unroll
        for (int ai = 0; ai < 2; ++ai)
#pragma unroll
            for (int m = 0; m < 4; ++m) { bf16_t* rowp = O + (size_t)(row0 + ai * HALF + m * 16) * ldc + col0;
                float o[8];
#pragma unroll
                for (int n = 0; n < 2; ++n)
#pragma unroll
                    for (int e = 0; e < 4; ++e) { const float gt = acc[ai][0][m][n][e]; o[n * 4 + e] = gt * fast_sigmoid(gt) * acc[ai][1][m][n][e]; }
                u32x4 w; w.x = cvt_pk_bf16(o[0], o[1]); w.y = cvt_pk_bf16(o[2], o[3]); w.z = cvt_pk_bf16(o[4], o[5]); w.w = cvt_pk_bf16(o[6], o[7]);
                *(u32x4*)rowp = w; }
    }
};

template <class Epi, class Sched, bool ALIGN_EPI = false, bool SP2 = false>
__device__ __forceinline__ void gemm_phase(PG8_LAS unsigned char* lds, const Gemm g, const Sched& S, const Epi& E, int wid_in) {
    const int wid = wid_in, lane = lane_id_opaque(), tid = wid * 64 + lane, wr = wid >> 2, wc = wid & 3, fr = lane & 15, fq = lane >> 4;
    const int K = g.K, nt = K / BK;
    unsigned voffA[2], voffB[2];
#pragma unroll
    for (int i = 0; i < 2; ++i) { int R, C; stage_rc(tid * 16 + i * 8192, R, C); const int Rb = Epi::PERM ? ((R & ~31) + perm32(R & 31)) : R;
        voffA[i] = (unsigned)(R * g.lda + C) * 2u; voffB[i] = (unsigned)(Rb * K + C) * 2u; }
    const size_t kstep = (size_t)(BK * 2);
    const size_t hstepA = (size_t)HALF * g.lda * 2, hstepB = (size_t)HALF * K * 2;
    const size_t tstepA = 2 * hstepA, tstepB = 2 * hstepB;
    const unsigned ldsw = (unsigned)wid * 1024u;
    const int aoff = lds_byte(wr * 64 + fr, fq * 8), boff = lds_byte(wc * 32 + fr, fq * 8);
#define PG8_SA(b, h) (((b) * 2 + (h)) * HTB)
#define PG8_SB(b, h) ((4 + (b) * 2 + (h)) * HTB)
#define PG8_STAGE(bufoff, gbase, voff) do { _Pragma("unroll") for (int _i = 0; _i < 2; ++_i) \
        __builtin_amdgcn_global_load_lds((const unsigned*)((const char*)(gbase) + (voff)[_i]), (PG8_LAS unsigned*)(lds + (bufoff) + ldsw + _i * 8192), 16, 0, 0); } while (0)
#define PG8_LDA(dst, b, h) do { _Pragma("unroll") for (int m = 0; m < 4; ++m) _Pragma("unroll") for (int k = 0; k < 2; ++k) dst[m][k] = *(const PG8_LAS bf16x8*)(lds + PG8_SA(b, h) + aoff + m * 2048 + k * 1024); } while (0)
#define PG8_LDB(dst, b, h) do { _Pragma("unroll") for (int n = 0; n < 2; ++n) _Pragma("unroll") for (int k = 0; k < 2; ++k) dst[n][k] = *(const PG8_LAS bf16x8*)(lds + PG8_SB(b, h) + boff + n * 2048 + k * 1024); } while (0)
#define PG8_MMA(ai, bj, At, Bt) do { __builtin_amdgcn_s_setprio(1); _Pragma("unroll") for (int m = 0; m < 4; ++m) _Pragma("unroll") for (int n = 0; n < 2; ++n) _Pragma("unroll") for (int k = 0; k < 2; ++k) \
        acc[ai][bj][m][n] = __builtin_amdgcn_mfma_f32_16x16x32_bf16(Bt[n][k], At[m][k], acc[ai][bj][m][n], 0, 0, 0); __builtin_amdgcn_s_setprio(0); } while (0)
#define PG8_WAIT_V(n) asm volatile("s_waitcnt vmcnt(" #n ")" ::: "memory")
#define PG8_WAIT_L(n) asm volatile("s_waitcnt lgkmcnt(" #n ")" ::: "memory")
#define PG8_BAR __builtin_amdgcn_s_barrier()
#define PG8_SCHED __builtin_amdgcn_sched_barrier(0)
    Unit cur, nxt; int ui = 0;
    if (!S.next(0, cur)) return;
    f32x4 acc[2][2][4][2];
#pragma unroll
    for (int a = 0; a < 2; ++a)
#pragma unroll
        for (int b = 0; b < 2; ++b)
#pragma unroll
            for (int m = 0; m < 4; ++m)
#pragma unroll
                for (int n = 0; n < 2; ++n) acc[a][b][m][n] = (f32x4){0.f, 0.f, 0.f, 0.f};
    bf16x8 At[4][2], B0[2][2], B1[2][2];
    const char* cA = (const char*)g.A + (size_t)cur.pm * tstepA; const char* cB = (const char*)g.Bt + (size_t)cur.pn * tstepB;
    S.a_ready(cur);
    if constexpr (SP2) {
        PG8_STAGE(PG8_SB(0, 0), cB, voffB); PG8_STAGE(PG8_SB(0, 1), cB + hstepB, voffB); PG8_STAGE(PG8_SA(0, 0), cA, voffA); PG8_STAGE(PG8_SA(0, 1), cA + hstepA, voffA);
        if (wr == 1) PG8_BAR;
        PG8_WAIT_V(2); PG8_BAR;
        PG8_STAGE(PG8_SB(1, 0), cB + kstep, voffB); PG8_STAGE(PG8_SA(1, 0), cA + kstep, voffA); PG8_STAGE(PG8_SB(1, 1), cB + hstepB + kstep, voffB);
        PG8_WAIT_V(6); PG8_BAR;
    } else {
        PG8_STAGE(PG8_SB(0, 0), cB, voffB); PG8_STAGE(PG8_SA(0, 0), cA, voffA); PG8_STAGE(PG8_SB(0, 1), cB + hstepB, voffB); PG8_STAGE(PG8_SA(0, 1), cA + hstepA, voffA);
        if (wr == 1) PG8_BAR;
        PG8_WAIT_V(4); PG8_BAR;
        PG8_STAGE(PG8_SB(1, 0), cB + kstep, voffB); PG8_STAGE(PG8_SA(1, 0), cA + kstep, voffA); PG8_STAGE(PG8_SB(1, 1), cB + hstepB + kstep, voffB);
        PG8_WAIT_V(6); PG8_BAR;
    }
    for (;;) {
        const bool has_next = S.next(ui + 1, nxt);
        const char* nA = has_next ? (const char*)g.A + (size_t)nxt.pm * tstepA : cA; const char* nB = has_next ? (const char*)g.Bt + (size_t)nxt.pn * tstepB : cB;
        for (int t = 0; t < nt; t += 2) {
            const bool last = (t == nt - 2);
            const char* a1 = cA + (size_t)(t + 1) * kstep;
            const char* a2 = last ? nA : cA + (size_t)(t + 2) * kstep; const char* b2 = last ? nB : cB + (size_t)(t + 2) * kstep;
            const char* a3 = a2 + kstep; const char* b3 = b2 + kstep;
            if (last && has_next) S.a_ready(nxt);
            if constexpr (SP2) {
            PG8_LDB(B0, 0, 0); PG8_LDB(B1, 0, 1); PG8_SCHED; PG8_LDA(At, 0, 0); PG8_STAGE(PG8_SA(1, 1), a1 + hstepA, voffA);
            PG8_WAIT_V(8); PG8_WAIT_L(0); PG8_BAR; PG8_MMA(0, 0, At, B0); PG8_MMA(0, 1, At, B1); PG8_BAR; PG8_SCHED;
            PG8_LDA(At, 0, 1); PG8_STAGE(PG8_SB(0, 0), b2, voffB); PG8_STAGE(PG8_SB(0, 1), b2 + hstepB, voffB); PG8_STAGE(PG8_SA(0, 0), a2, voffA);
            PG8_WAIT_V(8); PG8_WAIT_L(0); PG8_BAR; PG8_MMA(1, 0, At, B0); PG8_MMA(1, 1, At, B1); PG8_BAR; PG8_SCHED;
            PG8_LDB(B0, 1, 0); PG8_LDB(B1, 1, 1); PG8_SCHED; PG8_LDA(At, 1, 0); PG8_STAGE(PG8_SA(0, 1), a2 + hstepA, voffA);
            PG8_WAIT_V(8); PG8_WAIT_L(0); PG8_BAR; PG8_MMA(0, 0, At, B0); PG8_MMA(0, 1, At, B1); PG8_BAR; PG8_SCHED;
            PG8_LDA(At, 1, 1); PG8_STAGE(PG8_SB(1, 0), b3, voffB); PG8_STAGE(PG8_SB(1, 1), b3 + hstepB, voffB); PG8_STAGE(PG8_SA(1, 0), a3, voffA);
            PG8_WAIT_V(8); PG8_WAIT_L(0); PG8_BAR; PG8_MMA(1, 0, At, B0); PG8_MMA(1, 1, At, B1); PG8_BAR; PG8_SCHED;
            } else {
            PG8_LDB(B0, 0, 0); PG8_SCHED; PG8_LDA(At, 0, 0); PG8_STAGE(PG8_SA(1, 1), a1 + hstepA, voffA);
            PG8_WAIT_L(8); PG8_BAR; PG8_WAIT_L(0); PG8_MMA(0, 0, At, B0); PG8_BAR; PG8_SCHED;
            PG8_LDB(B1, 0, 1); PG8_STAGE(PG8_SB(0, 0), b2, voffB);
            PG8_BAR; PG8_WAIT_L(0); PG8_MMA(0, 1, At, B1); PG8_BAR;
            PG8_LDA(At, 0, 1); PG8_STAGE(PG8_SA(0, 0), a2, voffA);
            PG8_BAR; PG8_WAIT_L(0); PG8_MMA(1, 0, At, B0); PG8_BAR; PG8_SCHED;
            PG8_STAGE(PG8_SB(0, 1), b2 + hstepB, voffB);
            PG8_WAIT_V(6); PG8_BAR; PG8_MMA(1, 1, At, B1); PG8_BAR;
            PG8_LDB(B0, 1, 0); PG8_SCHED; PG8_LDA(At, 1, 0); PG8_STAGE(PG8_SA(0, 1), a2 + hstepA, voffA);
            PG8_WAIT_L(8); PG8_BAR; PG8_WAIT_L(0); PG8_MMA(0, 0, At, B0); PG8_BAR; PG8_SCHED;
            PG8_LDB(B1, 1, 1); PG8_STAGE(PG8_SB(1, 0), b3, voffB);
            PG8_BAR; PG8_WAIT_L(0); PG8_MMA(0, 1, At, B1); PG8_BAR;
            PG8_LDA(At, 1, 1); PG8_STAGE(PG8_SA(1, 0), a3, voffA);
            PG8_BAR; PG8_WAIT_L(0); PG8_MMA(1, 0, At, B0); PG8_BAR; PG8_SCHED;
            PG8_STAGE(PG8_SB(1, 1), b3 + hstepB, voffB);
            PG8_WAIT_V(6); PG8_BAR; PG8_MMA(1, 1, At, B1); PG8_BAR;
            }
        }
        if constexpr (ALIGN_EPI) { if (wr == 0) PG8_BAR; }
        if constexpr (!Epi::AFTER_DRAIN) { E(acc, cur, wr, wc, fr, fq); S.done(cur); }
        if (!has_next) break;
#pragma unroll
        for (int a = 0; a < 2; ++a)
#pragma unroll
            for (int b = 0; b < 2; ++b)
#pragma unroll
                for (int m = 0; m < 4; ++m)
#pragma unroll
                    for (int n = 0; n < 2; ++n) acc[a][b][m][n] = (f32x4){0.f, 0.f, 0.f, 0.f};
        cur = nxt; cA = nA; cB = nB; ++ui;
        if constexpr (ALIGN_EPI) { if (wr == 1) PG8_BAR; }
    }
    PG8_WAIT_V(0);
    if constexpr (!ALIGN_EPI) { if (wr == 0) PG8_BAR; }
    PG8_BAR;
    if constexpr (Epi::AFTER_DRAIN) { E.fused(acc, cur, wr, wc, fr, fq, lds, wid, lane); S.done(cur); }
#undef PG8_SA
#undef PG8_SB
#undef PG8_STAGE
#undef PG8_LDA
#undef PG8_LDB
#undef PG8_MMA
#undef PG8_WAIT_V
#undef PG8_WAIT_L
#undef PG8_BAR
#undef PG8_SCHED
}
}


constexpr size_t WT_IN1 = 0;
constexpr size_t WT_G = WT_IN1 + (size_t)3840 * 1024 * 2;
constexpr size_t WT_PROJ = WT_G + (size_t)3072 * 1024 * 2;
constexpr size_t WT_O = WT_PROJ + (size_t)3 * 1024 * 384 * 2;
constexpr size_t WT_UP = WT_O + (size_t)1024 * 1024 * 2;
constexpr size_t WT_DOWN = WT_UP + (size_t)5632 * 1024 * 2;
constexpr size_t WT_END = WT_DOWN + (size_t)1024 * 2816 * 2;
static_assert(WS_WT + WT_END <= WS_R3, "weight copies fit");

__device__ __forceinline__ void tr_item(const float* W, int ldw, int col0, int Kv, int Nv, bf16_t* WT, int ldk, int k0, int n0, int drow0, float* scr, int lane) {
    const int nn = lane & 31; const bool nok = (n0 + nn) < Nv;
#pragma unroll 8
    for (int i = 0; i < 32; ++i) { const int kk = 2 * i + (lane >> 5);
        float v = 0.f; if (nok && (k0 + kk) < Kv) v = W[(size_t)(k0 + kk) * ldw + col0 + n0 + nn];
        scr[kk * 33 + nn] = v; }
    asm volatile("s_waitcnt lgkmcnt(0)" ::: "memory");
    const int c = lane & 7;
#pragma unroll
    for (int j = 0; j < 4; ++j) { const int n = (lane >> 3) + 8 * j; const float* s = scr + (8 * c) * 33 + n;
        u32x4 o; o.x = pk2(s[0 * 33], s[1 * 33]); o.y = pk2(s[2 * 33], s[3 * 33]); o.z = pk2(s[4 * 33], s[5 * 33]); o.w = pk2(s[6 * 33], s[7 * 33]);
        *(u32x4*)(WT + (size_t)(drow0 + n) * ldk + k0 + 8 * c) = o; }
    asm volatile("s_waitcnt lgkmcnt(0)" ::: "memory");
}
__device__ __forceinline__ void phase_weights(const Params& p, int l, float* lds, Ctx cx) { const int wid = cx.wid, BID = cx.bid, NBLK = cx.nblk; (void)wid; (void)BID; (void)NBLK;
    const int lane = lane_id_opaque(), wave = wid, gw = BID * NWAVES + wave, NGW = NBLK * NWAVES;
    float* scr = lds + wave * (64 * 33);
    unsigned char* wt = p.ws + WS_WT;
    constexpr int I_IN1 = 16 * 120, I_G = 16 * 96, I_P = 6 * 32, I_O = 16 * 32, I_UP = 16 * 176, I_DN = 44 * 32;
    constexpr int NITEMS = I_IN1 + I_G + 3 * I_P + I_O + I_UP + I_DN;
    const float* w_in = p.w_in + (size_t)l * DM * D_IN;
    for (int it = gw; it < NITEMS; it += NGW) {
        int r = it;
        if (r < I_IN1) { const int kb = r / 120, nb = r % 120; tr_item(w_in, D_IN, 0, 1024, NQ1, (bf16_t*)(wt + WT_IN1), 1024, kb * 64, nb * 32, nb * 32, scr, lane); continue; } r -= I_IN1;
        if (r < I_G) { const int kb = r / 96, nb = r % 96; tr_item(w_in, D_IN, NQ1, 1024, NGATE, (bf16_t*)(wt + WT_G), 1024, kb * 64, nb * 32, nb * 32, scr, lane); continue; } r -= I_G;
        if (r < 3 * I_P) { const int br = r / I_P, q = r % I_P, kb = q / 32, nb = q % 32;
            const float* W = br == 0 ? p.w_proj_sb + (size_t)l * 384 * DM : br == 1 ? p.w_proj_mb + (size_t)l * 320 * DM : p.w_proj_ds + (size_t)l * 320 * DM;
            tr_item(W, DM, 0, br == 0 ? 384 : 320, DM, (bf16_t*)(wt + WT_PROJ) + (size_t)br * 1024 * 384, 384, kb * 64, nb * 32, nb * 32, scr, lane); continue; } r -= 3 * I_P;
        if (r < I_O) { const int kb = r / 32, nb = r % 32; tr_item(p.w_o + (size_t)l * DM * DM, DM, 0, 1024, DM, (bf16_t*)(wt + WT_O), 1024, kb * 64, nb * 32, nb * 32, scr, lane); continue; } r -= I_O;
        if (r < I_UP) { const int kb = r / 176, nb = r % 176, n0 = nb * 32, bj = n0 / DFF, rr = n0 % DFF, drow0 = 256 * (rr / 128) + 128 * bj + (rr % 128);
            tr_item(p.w_up + (size_t)l * DM * 2 * DFF, 2 * DFF, 0, 1024, 2 * DFF, (bf16_t*)(wt + WT_UP), 1024, kb * 64, n0, drow0, scr, lane); continue; } r -= I_UP;
        { const int kb = r / 32, nb = r % 32; tr_item(p.w_down + (size_t)l * DFF * DM, DM, 0, DFF, DM, (bf16_t*)(wt + WT_DOWN), DFF, kb * 64, nb * 32, nb * 32, scr, lane); }
    }
}

#ifndef FASTMASK
#define FASTMASK 63
#endif
#define GRID_SYNC() do { asm volatile("s_waitcnt vmcnt(0) lgkmcnt(0)" ::: "memory"); grid.sync(); __builtin_amdgcn_fence(__ATOMIC_ACQUIRE, "agent"); asm volatile("s_waitcnt vmcnt(0)" ::: "memory"); } while (0)
constexpr int RING_BYTES = 131072, LDS_BYTES = 147456;
typedef const __attribute__((address_space(4))) Params* kparams_t;
__device__ __forceinline__ Params load_params(kparams_t pp) {
    Params p; p.x = pp->x; p.c = pp->c; p.w_ada = pp->w_ada; p.b_ada = pp->b_ada; p.g_pre_mix = pp->g_pre_mix; p.g_post_mix = pp->g_post_mix; p.w_in = pp->w_in; p.b_gate = pp->b_gate;
    p.w_proj_sb = pp->w_proj_sb; p.w_proj_mb = pp->w_proj_mb; p.w_proj_ds = pp->w_proj_ds; p.w_o = pp->w_o; p.g_pre_ffn = pp->g_pre_ffn; p.g_post_ffn = pp->g_post_ffn; p.w_up = pp->w_up; p.w_down = pp->w_down;
    p.out = pp->out; p.ws = pp->ws; p.mask = pp->mask; return p;
}
__device__ __forceinline__ bool phase_on(int k) { kparams_t pp = (kparams_t)__builtin_amdgcn_kernarg_segment_ptr(); asm volatile("" : "+s"(pp)); unsigned long long m = pp->mask; asm volatile("" : "+s"(m)); return (m >> k) & 1ull; }
#define PHASE_BEGIN Ctx cx; { int b_ = blockIdx.x, g_ = gridDim.x, w_ = wid; asm volatile("" : "+s"(b_), "+s"(g_), "+s"(w_)); cx.bid = b_; cx.nblk = g_; cx.wid = w_; } kparams_t pp_ = (kparams_t)__builtin_amdgcn_kernarg_segment_ptr(); asm volatile("" : "+s"(pp_)); const Params p = load_params(pp_); \
    unsigned char* ws_ = p.ws; bf16_t* R1 = (bf16_t*)(ws_ + WS_R1); bf16_t* R2 = (bf16_t*)(ws_ + WS_R2); bf16_t* R3 = (bf16_t*)(ws_ + WS_R3); unsigned char* wt = ws_ + WS_WT; (void)R1; (void)R2; (void)R3; (void)wt;
#define PHX(k) phase_on(k)
#define PH(k) phase_on((k) + 16 * l)
template <int l> __device__ __forceinline__ void layer_body(cg::grid_group& grid, float* lds, PG8_LAS unsigned char* lds3, int wid) {
        if (PH(0)) {
            PHASE_BEGIN
            if constexpr ((FASTMASK >> 0) & 1) {
            pg8::Gemm g{R3, (const bf16_t*)(wt + WT_IN1), T, QKV_PITCH, DM, DM}; pg8::StaticOrder S; S.init(T, QKV_PITCH, cx.nblk, cx.bid);
            pg8::EpiBf16 E{R1, QKV_PITCH};
            pg8::gemm_phase<pg8::EpiBf16, pg8::StaticOrder, true, true>(lds3, g, S, E, cx.wid);
            } else {
                NGemm<1> g; g.s[0] = NSeg{R3, DM, p.w_in + (size_t)l * DM * D_IN, D_IN, DM}; g.M = T; g.N = NQ1;
                NEpi e{R1, QKV_PITCH, nullptr, nullptr};
                naive_gemm<1, 0>(lds, g, e, cx);
            }
        }
        GRID_SYNC();
        if (PH(1)) { PHASE_BEGIN phase_kmean(p, cx); phase_dsa_topk(p, lds, cx); }
        if (PH(2)) { PHASE_BEGIN phase_naive_attn<0>(p, cx); phase_zero_pad(p, cx); }
        GRID_SYNC();
        if (PH(3)) { PHASE_BEGIN phase_naive_attn<1>(p, cx); }
        if (PH(3)) { PHASE_BEGIN phase_naive_attn<2>(p, cx); }
        GRID_SYNC();
        if (PH(4)) {
            PHASE_BEGIN
            if constexpr ((FASTMASK >> 1) & 1) {
            pg8::Gemm g{R3, (const bf16_t*)(wt + WT_G), T, NGATE, DM, DM}; pg8::StaticOrder S; S.init(T, NGATE, cx.nblk, cx.bid);
            pg8::EpiSigmoid E{R1, NGATE, p.b_gate + l * NGATE};
            pg8::gemm_phase<pg8::EpiSigmoid, pg8::StaticOrder, true, true>(lds3, g, S, E, cx.wid);
            } else {
                NGemm<1> g; g.s[0] = NSeg{R3, DM, p.w_in + (size_t)l * DM * D_IN + NQ1, D_IN, DM}; g.M = T; g.N = NGATE;
                NEpi e{R1, NGATE, p.b_gate + l * NGATE, nullptr};
                naive_gemm<1, 1>(lds, g, e, cx);
            }
        }
        GRID_SYNC();
#pragma unroll
        for (int br = 0; br < 3; ++br) if (PH(5 + br)) {
            PHASE_BEGIN
            if constexpr ((FASTMASK >> 2) & 1) {
            pg8::Gemm g{R2 + br * 384, (const bf16_t*)(wt + WT_PROJ) + (size_t)br * 1024 * 384, T, DM, 384, OC_PITCH}; pg8::StaticOrder S; S.init(T, DM, cx.nblk, cx.bid);
            pg8::EpiGate E{R3, R1, br};
            pg8::gemm_phase<pg8::EpiGate, pg8::StaticOrder, true, true>(lds3, g, S, E, cx.wid);
            asm volatile("s_waitcnt vmcnt(0)" ::: "memory");
            __builtin_amdgcn_fence(__ATOMIC_ACQUIRE, "agent");
            asm volatile("s_waitcnt vmcnt(0)" ::: "memory");
            __syncthreads();
            } else {
                if (br == 0) {
                    NGemm<3> g;
                    g.s[0] = NSeg{R2 + CO_SB, OC_PITCH, p.w_proj_sb + (size_t)l * 384 * DM, DM, 384};
                    g.s[1] = NSeg{R2 + CO_MB, OC_PITCH, p.w_proj_mb + (size_t)l * 320 * DM, DM, 320};
                    g.s[2] = NSeg{R2 + CO_DS, OC_PITCH, p.w_proj_ds + (size_t)l * 320 * DM, DM, 320};
                    g.M = T; g.N = DM;
                    NEpi e{R3, DM, nullptr, R1};
                    naive_gemm<3, 2>(lds, g, e, cx);
                }
            }
        }
        GRID_SYNC();
        if (PH(8)) {
            PHASE_BEGIN
            if constexpr ((FASTMASK >> 3) & 1) {
            pg8::Gemm g{R3, (const bf16_t*)(wt + WT_O), T, DM, DM, DM}; pg8::StaticOrder S; S.init(T, DM, cx.nblk, cx.bid);
            pg8::EpiBf16 E{R2, DM};
            pg8::gemm_phase<pg8::EpiBf16, pg8::StaticOrder, true, true>(lds3, g, S, E, cx.wid);
            } else {
                NGemm<1> g; g.s[0] = NSeg{R3, DM, p.w_o + (size_t)l * DM * DM, DM, DM}; g.M = T; g.N = DM;
                NEpi e{R2, DM, nullptr, nullptr};
                naive_gemm<1, 0>(lds, g, e, cx);
            }
        }
        GRID_SYNC();
        if (PH(9)) { PHASE_BEGIN phase_postnorm(p, l == 0 ? p.x : p.out, p.g_post_mix + l * DM, l, 0, cx); }
        GRID_SYNC();
        if (PH(10)) {
            PHASE_BEGIN
            if constexpr ((FASTMASK >> 4) & 1) {
            pg8::Gemm g{R3, (const bf16_t*)(wt + WT_UP), T, 2 * DFF, DM, DM}; pg8::StaticOrder S; S.init(T, 2 * DFF, cx.nblk, cx.bid);
            pg8::EpiSwiglu E{R1, DFF};
            pg8::gemm_phase<pg8::EpiSwiglu, pg8::StaticOrder, true, true>(lds3, g, S, E, cx.wid);
            } else {
                const float* wu = p.w_up + (size_t)l * DM * 2 * DFF;
                NGemm<2> g; g.s[0] = NSeg{R3, DM, wu, 2 * DFF, DM}; g.s[1] = NSeg{R3, DM, wu + DFF, 2 * DFF, DM}; g.M = T; g.N = DFF;
                NEpi e{R1, DFF, nullptr, nullptr};
                naive_gemm<2, 3>(lds, g, e, cx);
            }
        }
        GRID_SYNC();
        if (PH(11)) {
            PHASE_BEGIN
            if constexpr ((FASTMASK >> 5) & 1) {
            pg8::Gemm g{R1, (const bf16_t*)(wt + WT_DOWN), T, DM, DFF, DFF}; pg8::StaticOrder S; S.init(T, DM, cx.nblk, cx.bid);
            pg8::EpiBf16 E{R2, DM};
            pg8::gemm_phase<pg8::EpiBf16, pg8::StaticOrder, true, true>(lds3, g, S, E, cx.wid);
            } else {
                NGemm<1> g; g.s[0] = NSeg{R1, DFF, p.w_down + (size_t)l * DFF * DM, DM, DFF}; g.M = T; g.N = DM;
                NEpi e{R2, DM, nullptr, nullptr};
                naive_gemm<1, 0>(lds, g, e, cx);
            }
        }
        GRID_SYNC();
        if (PH(12)) { PHASE_BEGIN phase_postnorm(p, p.out, p.g_post_ffn + l * DM, l, 1, cx); }
        if (l + 1 < DEPTH) { if (PH(13)) { PHASE_BEGIN __syncthreads(); phase_weights(p, l + 1, lds, cx); } }
        GRID_SYNC();
    }
__global__ void __launch_bounds__(NTHREADS, 2) mega_fwd(Params p_kernarg) {
    cg::grid_group grid = cg::this_grid();
    const int wid = __builtin_amdgcn_readfirstlane((int)threadIdx.x >> 6);
    extern __shared__ __attribute__((aligned(16))) unsigned char lds_raw[];
    float* lds = (float*)lds_raw;
    PG8_LAS unsigned char* lds3 = (PG8_LAS unsigned char*)lds_raw;
    if (PHX(60)) { PHASE_BEGIN phase_mod(p, lds, cx); __syncthreads(); }
    if (PHX(61)) { PHASE_BEGIN phase_weights(p, 0, lds, cx); }
    GRID_SYNC();
    if (PHX(62)) { PHASE_BEGIN phase_prenorm(p, p.x, p.g_pre_mix, 0, 0, cx); }
    GRID_SYNC();
    layer_body<0>(grid, lds, lds3, wid);
    layer_body<1>(grid, lds, lds3, wid);
}

extern "C" void kernel_launch(void* const* d_in, const int* in_sizes, int n_in, void* d_out, int out_size, void* d_ws, size_t ws_size, hipStream_t stream) {
    static int grid_blocks = 0;
    if (grid_blocks == 0) {
        if (n_in != 16 || out_size != T * DM || ws_size < WS_END) { fprintf(stderr, "kernel_launch: unexpected sizes n_in %d out %d ws %zu\n", n_in, out_size, ws_size); grid_blocks = -1; return; }
        int dev = 0, cus = 0, per_cu = 0;
        (void)hipGetDevice(&dev);
        (void)hipDeviceGetAttribute(&cus, hipDeviceAttributeMultiprocessorCount, dev);
        if (hipFuncSetAttribute((const void*)mega_fwd, hipFuncAttributeMaxDynamicSharedMemorySize, LDS_BYTES) != hipSuccess) { fprintf(stderr, "kernel_launch: hipFuncSetAttribute failed\n"); grid_blocks = -1; return; }
        (void)hipOccupancyMaxActiveBlocksPerMultiprocessor(&per_cu, (const void*)mega_fwd, NTHREADS, LDS_BYTES);
        if (per_cu < 1) { fprintf(stderr, "kernel_launch: occupancy query says %d blocks per CU\n", per_cu); per_cu = 1; }
        if (per_cu > 1) per_cu = 1;
        grid_blocks = cus * per_cu;
        fprintf(stderr, "kernel_launch: cus %d per_cu %d grid %d ws %zu\n", cus, per_cu, grid_blocks, ws_size);
    }
    if (grid_blocks < 0) return;
    Params p{};
    p.x = (const float*)d_in[0]; p.c = (const float*)d_in[1]; p.w_ada = (const float*)d_in[2]; p.b_ada = (const float*)d_in[3];
    p.g_pre_mix = (const float*)d_in[4]; p.g_post_mix = (const float*)d_in[5]; p.w_in = (const float*)d_in[6]; p.b_gate = (const float*)d_in[7];
    p.w_proj_sb = (const float*)d_in[8]; p.w_proj_mb = (const float*)d_in[9]; p.w_proj_ds = (const float*)d_in[10]; p.w_o = (const float*)d_in[11];
    p.g_pre_ffn = (const float*)d_in[12]; p.g_post_ffn = (const float*)d_in[13]; p.w_up = (const float*)d_in[14]; p.w_down = (const float*)d_in[15];
    p.out = (float*)d_out; p.ws = (unsigned char*)d_ws; p.mask = ~0ull;
    void* args[] = {&p};
    hipError_t e = hipLaunchCooperativeKernel((const void*)mega_fwd, dim3(grid_blocks), dim3(NTHREADS), args, LDS_BYTES, stream);
    if (e != hipSuccess) fprintf(stderr, "cooperative launch failed: %s (grid %d)\n", hipGetErrorString(e), grid_blocks);
}
```

```cpp
#include <hip/hip_runtime.h>
#include <hip/hip_cooperative_groups.h>
#include <cstdio>
#include <cstdint>
namespace cg = cooperative_groups;

typedef float f32x4 __attribute__((ext_vector_type(4)));
typedef unsigned u32x4 __attribute__((ext_vector_type(4)));
typedef unsigned u32x2 __attribute__((ext_vector_type(2)));
typedef unsigned short bf16_t;

constexpr int BATCH = 8, SEQ = 2048, DM = 1024, T = BATCH * SEQ, DEPTH = 2;
constexpr int HD = 64, H_SB = 6, H_MB = 5, H_DS = 5;
constexpr int D_IN = 6728, NQ1 = 3656, QKV_PITCH = 3840, NGATE = 3072, DFF = 2816;
constexpr int OC_PITCH = 1152;
constexpr int CQ_SB = 0, CK_SB = 384, CV_SB = 768, CQ_MB = 1152, CK_MB = 1472, CV_MB = 1792, CQ_DS = 2112, CK_DS = 2432, CV_DS = 2752, CQ_IX = 3072, CK_IX = 3584, CW_IX = 3648;
constexpr int CO_SB = 0, CO_MB = 384, CO_DS = 768;
constexpr float RMS_EPS = 1e-6f;
constexpr int NTHREADS = 512, NWAVES = 8;

constexpr size_t MiB = 1u << 20;
constexpr size_t WS_MOD = 1 * MiB;
constexpr size_t WS_KMEAN = 1 * MiB + 512 * 1024;
constexpr size_t WS_MASK = 2 * MiB;
constexpr size_t WS_WT = 6 * MiB;
constexpr size_t WS_R3 = 42 * MiB;
constexpr size_t WS_R2 = 74 * MiB;
constexpr size_t WS_R1 = 110 * MiB;
constexpr size_t WS_END = 230 * MiB;

struct Params {
    const float* x; const float* c; const float* w_ada; const float* b_ada; const float* g_pre_mix; const float* g_post_mix;
    const float* w_in; const float* b_gate; const float* w_proj_sb; const float* w_proj_mb; const float* w_proj_ds; const float* w_o;
    const float* g_pre_ffn; const float* g_post_ffn; const float* w_up; const float* w_down;
    float* out; unsigned char* ws; unsigned long long mask;
};

struct Ctx { int bid, nblk, wid; };
__device__ __forceinline__ float bf2f(unsigned short b) { return __uint_as_float((unsigned)b << 16); }
__device__ __forceinline__ float bflo(unsigned w) { return __uint_as_float(w << 16); }
__device__ __forceinline__ float bfhi(unsigned w) { return __uint_as_float(w & 0xffff0000u); }
__device__ __forceinline__ unsigned f2bf(float f) { unsigned u = __float_as_uint(f); return (u + 0x7fffu + ((u >> 16) & 1u)) >> 16; }
__device__ __forceinline__ unsigned pk2(float lo, float hi) { return f2bf(lo) | (f2bf(hi) << 16); }
__device__ __forceinline__ float wave_sum(float v) {
#pragma unroll
    for (int o = 1; o < 64; o <<= 1) v += __shfl_xor(v, o);
    return v;
}
__device__ __forceinline__ int lane_id_opaque() { int l; asm volatile("v_mbcnt_lo_u32_b32 %0, -1, 0\n\tv_mbcnt_hi_u32_b32 %0, -1, %0" : "=v"(l)); return l; }
#define TIDX (wid * 64 + lane_id_opaque())
__device__ __forceinline__ float sigmoidf_(float v) { return 1.f / (1.f + __expf(-v)); }

__device__ __forceinline__ void phase_mod(const Params& p, float* lds, Ctx cx) { const int wid = cx.wid, BID = cx.bid, NBLK = cx.nblk; (void)wid; (void)BID; (void)NBLK;
    float* MOD = (float*)(p.ws + WS_MOD);
    const int tid = TIDX;
    float* cact = lds;
    float* red = lds + 8 * 1024;
    for (int i = tid; i < 8 * 1024; i += NTHREADS) { const float v = p.c[i]; cact[i] = v * sigmoidf_(v); }
    __syncthreads();
    for (int item = BID; item < 2 * 96; item += NBLK) {
        const int l = item / 96, ct = item % 96, kg = tid >> 6, col = ct * 64 + (tid & 63);
        const float* W = p.w_ada + (size_t)l * 1024 * 6144 + col;
        float acc[8];
#pragma unroll
        for (int b = 0; b < 8; ++b) acc[b] = 0.f;
        for (int k = kg; k < 1024; k += 8) {
            const float w = W[(size_t)k * 6144];
#pragma unroll
            for (int b = 0; b < 8; ++b) acc[b] += cact[b * 1024 + k] * w;
        }
#pragma unroll
        for (int b = 0; b < 8; ++b) red[(kg * 8 + b) * 64 + (tid & 63)] = acc[b];
        __syncthreads();
        {
            const int b = tid >> 6, cc = tid & 63;
            float s = 0.f;
#pragma unroll
            for (int g = 0; g < 8; ++g) s += red[(g * 8 + b) * 64 + cc];
            MOD[((size_t)l * 8 + b) * 6144 + ct * 64 + cc] = s + p.b_ada[l * 6144 + ct * 64 + cc];
        }
        __syncthreads();
    }
}

__device__ __forceinline__ void normmod_row(const f32x4 (&v)[4], float rstd, const float* g, const float* sc, const float* sh, bf16_t* orow, int lane) {
#pragma unroll
    for (int j = 0; j < 4; ++j) {
        const int c0 = 4 * lane + 256 * j;
        const f32x4 gg = *(const f32x4*)(g + c0), s1 = *(const f32x4*)(sc + c0), s0 = *(const f32x4*)(sh + c0);
        f32x4 o;
#pragma unroll
        for (int e = 0; e < 4; ++e) o[e] = v[j][e] * rstd * gg[e] * (1.f + s1[e]) + s0[e];
        u32x2 w; w.x = pk2(o[0], o[1]); w.y = pk2(o[2], o[3]);
        *(u32x2*)(orow + c0) = w;
    }
}
__device__ __forceinline__ void phase_prenorm(const Params& p, const float* xin, const float* g, int l, int which, Ctx cx) { const int wid = cx.wid, BID = cx.bid, NBLK = cx.nblk; (void)wid; (void)BID; (void)NBLK;
    const float* MOD = (const float*)(p.ws + WS_MOD) + (size_t)l * 8 * 6144;
    bf16_t* XN = (bf16_t*)(p.ws + WS_R3);
    const int lane = lane_id_opaque(), gw = BID * NWAVES + wid, NGW = NBLK * NWAVES;
    for (int m = gw; m < T; m += NGW) {
        const int b = m / SEQ;
        const f32x4* xr = (const f32x4*)(xin + (size_t)m * DM) + lane;
        f32x4 v[4]; float s = 0.f;
#pragma unroll
        for (int j = 0; j < 4; ++j) { v[j] = xr[64 * j]; s += (v[j][0] * v[j][0] + v[j][1] * v[j][1]) + (v[j][2] * v[j][2] + v[j][3] * v[j][3]); }
        const float rstd = rsqrtf(wave_sum(s) * (1.f / DM) + RMS_EPS);
        const float* mb = MOD + (size_t)b * 6144 + which * 3072;
        normmod_row(v, rstd, g, mb + 1024, mb, XN + (size_t)m * DM, lane);
    }
}
__device__ __forceinline__ void phase_postnorm(const Params& p, const float* xin, const float* gpost, int l, int which, Ctx cx) { const int wid = cx.wid, BID = cx.bid, NBLK = cx.nblk; (void)wid; (void)BID; (void)NBLK;
    const float* MODl = (const float*)(p.ws + WS_MOD) + (size_t)l * 8 * 6144;
    const bf16_t* Y = (const bf16_t*)(p.ws + WS_R2);
    bf16_t* XN = (bf16_t*)(p.ws + WS_R3);
    const int lane = lane_id_opaque(), gw = BID * NWAVES + wid, NGW = NBLK * NWAVES;
    const float* gnext = which == 0 ? p.g_pre_ffn + l * DM : (l + 1 < DEPTH ? p.g_pre_mix + (l + 1) * DM : nullptr);
    for (int m = gw; m < T; m += NGW) {
        const int b = m / SEQ;
        const float* gate = MODl + (size_t)b * 6144 + (which == 0 ? 2048 : 5120);
        f32x4 y[4]; float s = 0.f;
#pragma unroll
        for (int j = 0; j < 4; ++j) {
            const u32x2 w = *(const u32x2*)(Y + (size_t)m * DM + 4 * lane + 256 * j);
            y[j] = (f32x4){bflo(w.x), bfhi(w.x), bflo(w.y), bfhi(w.y)};
            s += (y[j][0] * y[j][0] + y[j][1] * y[j][1]) + (y[j][2] * y[j][2] + y[j][3] * y[j][3]);
        }
        const float rstd = rsqrtf(wave_sum(s) * (1.f / DM) + RMS_EPS);
        f32x4 v[4]; float s2 = 0.f;
#pragma unroll
        for (int j = 0; j < 4; ++j) {
            const int c0 = 4 * lane + 256 * j;
            const f32x4 xi = *(const f32x4*)(xin + (size_t)m * DM + c0), gp = *(const f32x4*)(gpost + c0), gt = *(const f32x4*)(gate + c0);
#pragma unroll
            for (int e = 0; e < 4; ++e) v[j][e] = xi[e] + gt[e] * (y[j][e] * rstd * gp[e]);
            *(f32x4*)(p.out + (size_t)m * DM + c0) = v[j];
            s2 += (v[j][0] * v[j][0] + v[j][1] * v[j][1]) + (v[j][2] * v[j][2] + v[j][3] * v[j][3]);
        }
        if (gnext) {
            const float rstd2 = rsqrtf(wave_sum(s2) * (1.f / DM) + RMS_EPS);
            const float* mb = which == 0 ? MODl + (size_t)b * 6144 + 3072 : MODl + (size_t)8 * 6144 + (size_t)b * 6144;
            normmod_row(v, rstd2, gnext, mb + 1024, mb, XN + (size_t)m * DM, lane);
        }
    }
}

struct NSeg { const bf16_t* A; int lda; const float* W; int ldw; int K; };
template <int NSEG> struct NGemm { NSeg s[NSEG]; int M, N; };
struct NEpi { bf16_t* C; int ldc; const float* bias; const bf16_t* gates; };
template <int NSEG, int EPI> __device__ __forceinline__ void naive_gemm(float* lds, const NGemm<NSEG>& g, const NEpi& e, Ctx cx) { const int wid = cx.wid, BID = cx.bid, NBLK = cx.nblk; (void)wid; (void)BID; (void)NBLK;
    float* As = lds;
    float* Bs = lds + 16 * 68;
    const int tid = TIDX, ty = tid >> 5, tx = tid & 31;
    const int tm = g.M / 64, tn = (g.N + 127) / 128;
    for (int item = BID; item < tm * tn; item += NBLK) {
        const int m0 = (item / tn) * 64, n0 = (item % tn) * 128;
        float acc[NSEG][4][4];
#pragma unroll
        for (int s = 0; s < NSEG; ++s)
#pragma unroll
            for (int i = 0; i < 4; ++i)
#pragma unroll
                for (int j = 0; j < 4; ++j) acc[s][i][j] = 0.f;
#pragma unroll
        for (int s = 0; s < NSEG; ++s) {
            const NSeg sg = g.s[s];
#pragma unroll 1
            for (int k0 = 0; k0 < sg.K; k0 += 16) {
                __syncthreads();
                {
                    const int r = tid >> 3, kq = tid & 7;
                    const unsigned w = *(const unsigned*)(sg.A + (size_t)(m0 + r) * sg.lda + k0 + kq * 2);
                    As[(kq * 2 + 0) * 68 + r] = bflo(w); As[(kq * 2 + 1) * 68 + r] = bfhi(w);
                    const int k = tid >> 5, nq = tid & 31, n = n0 + nq * 4;
                    f32x4 bv = (f32x4){0.f, 0.f, 0.f, 0.f};
                    if (n < g.N) bv = *(const f32x4*)(sg.W + (size_t)(k0 + k) * sg.ldw + n);
                    *(f32x4*)(Bs + k * 132 + nq * 4) = bv;
                }
                __syncthreads();
#pragma unroll 4
                for (int k = 0; k < 16; ++k) {
                    const f32x4 a0 = *(const f32x4*)(As + k * 68 + ty * 4), b = *(const f32x4*)(Bs + k * 132 + tx * 4);
#pragma unroll
                    for (int i = 0; i < 4; ++i)
#pragma unroll
                        for (int j = 0; j < 4; ++j) acc[s][i][j] += a0[i] * b[j];
                }
            }
        }
        const int col = n0 + tx * 4;
        if (col < g.N) {
#pragma unroll
            for (int i = 0; i < 4; ++i) {
                const int row = m0 + ty * 4 + i;
                float o[4];
                if (EPI == 0) {
#pragma unroll
                    for (int j = 0; j < 4; ++j) o[j] = acc[0][i][j];
                } else if (EPI == 1) {
#pragma unroll
                    for (int j = 0; j < 4; ++j) o[j] = sigmoidf_(acc[0][i][j] + e.bias[col + j]);
                } else if (EPI == 2) {
#pragma unroll
                    for (int j = 0; j < 4; ++j) o[j] = 0.f;
#pragma unroll
                    for (int s = 0; s < NSEG; ++s) {
                        const u32x2 gw = *(const u32x2*)(e.gates + (size_t)row * NGATE + s * 1024 + col);
                        o[0] += bflo(gw.x) * acc[s][i][0]; o[1] += bfhi(gw.x) * acc[s][i][1]; o[2] += bflo(gw.y) * acc[s][i][2]; o[3] += bfhi(gw.y) * acc[s][i][3];
                    }
                } else {
#pragma unroll
                    for (int j = 0; j < 4; ++j) { const float gt = acc[0][i][j]; o[j] = gt * sigmoidf_(gt) * acc[NSEG - 1][i][j]; }
                }
                u32x2 w; w.x = pk2(o[0], o[1]); w.y = pk2(o[2], o[3]);
                *(u32x2*)(e.C + (size_t)row * e.ldc + col) = w;
            }
        }
    }
}

__device__ __forceinline__ void phase_kmean(const Params& p, Ctx cx) { const int wid = cx.wid, BID = cx.bid, NBLK = cx.nblk; (void)wid; (void)BID; (void)NBLK;
    const bf16_t* QKV = (const bf16_t*)(p.ws + WS_R1);
    float* KM = (float*)(p.ws + WS_KMEAN);
    const int gt = BID * NTHREADS + TIDX, NT = NBLK * NTHREADS;
    for (int o = gt; o < 8 * 8 * 320; o += NT) {
        const int c = o % 320, n = (o / 320) % 8, b = o / (320 * 8);
        const bf16_t* kp = QKV + (size_t)(b * SEQ + n * 256) * QKV_PITCH + CK_MB + c;
        float s = 0.f;
        for (int r = 0; r < 256; ++r) s += bf2f(kp[(size_t)r * QKV_PITCH]);
        KM[o] = s * (1.f / 256.f);
    }
}

__device__ __forceinline__ unsigned ordkey(float f) { const unsigned u = __float_as_uint(f); return u ^ ((u >> 31) ? 0xffffffffu : 0x80000000u); }
__device__ __forceinline__ void phase_dsa_topk(const Params& p, float* lds, Ctx cx) { const int wid = cx.wid, BID = cx.bid, NBLK = cx.nblk; (void)wid; (void)BID; (void)NBLK;
    const bf16_t* QKV = (const bf16_t*)(p.ws + WS_R1);
    unsigned* MASK = (unsigned*)(p.ws + WS_MASK);
    const int lane = lane_id_opaque(), wave = wid, gw = BID * NWAVES + wave, NGW = NBLK * NWAVES;
    float* qs = lds + wave * 520;
    unsigned* skey = (unsigned*)(lds + 8 * 520) + wave * 2048;
    for (int m = gw; m < T; m += NGW) {
        const int b = m / SEQ, t = m % SEQ;
        const bf16_t* qrow = QKV + (size_t)m * QKV_PITCH;
        {
            const u32x4 w = *(const u32x4*)(qrow + CQ_IX + lane * 8);
            qs[lane * 8 + 0] = bflo(w.x); qs[lane * 8 + 1] = bfhi(w.x); qs[lane * 8 + 2] = bflo(w.y); qs[lane * 8 + 3] = bfhi(w.y);
            qs[lane * 8 + 4] = bflo(w.z); qs[lane * 8 + 5] = bfhi(w.z); qs[lane * 8 + 6] = bflo(w.w); qs[lane * 8 + 7] = bfhi(w.w);
            if (lane < 8) qs[512 + lane] = bf2f(qrow[CW_IX + lane]);
        }
        asm volatile("s_waitcnt lgkmcnt(0)" ::: "memory");
        __builtin_amdgcn_wave_barrier();
        const int ni = (t >> 6) + 1;
#pragma unroll 1
        for (int i = 0; i < ni; ++i) {
            const int s = i * 64 + lane;
            const u32x4* kp = (const u32x4*)(QKV + (size_t)(b * SEQ + s) * QKV_PITCH + CK_IX);
            u32x4 kw[8];
#pragma unroll
            for (int q = 0; q < 8; ++q) kw[q] = kp[q];
            float sc = 0.f;
#pragma unroll 1
            for (int h = 0; h < 8; ++h) {
                float lg = 0.f;
#pragma unroll
                for (int q = 0; q < 8; ++q) {
                    const f32x4 q0 = *(const f32x4*)(qs + h * 64 + q * 8), q1 = *(const f32x4*)(qs + h * 64 + q * 8 + 4);
                    lg += q0[0] * bflo(kw[q].x) + q0[1] * bfhi(kw[q].x) + q0[2] * bflo(kw[q].y) + q0[3] * bfhi(kw[q].y)
                        + q1[0] * bflo(kw[q].z) + q1[1] * bfhi(kw[q].z) + q1[2] * bflo(kw[q].w) + q1[3] * bfhi(kw[q].w);
                }
                sc += qs[512 + h] * fmaxf(lg, 0.f);
            }
            if (sc == 0.f) sc = 0.f;
            skey[s] = (s <= t) ? ordkey(sc) : 0u;
        }
        asm volatile("s_waitcnt lgkmcnt(0)" ::: "memory");
        __builtin_amdgcn_wave_barrier();
        unsigned key[32];
#pragma unroll
        for (int i = 0; i < 32; ++i) key[i] = (i < ni) ? skey[i * 64 + lane] : 0u;
        unsigned w = 0u;
        if (t + 1 <= 256) {
#pragma unroll
            for (int i = 0; i < 32; ++i) { const unsigned long long sb = __ballot(key[i] != 0u); if ((lane >> 1) == i) w = (lane & 1) ? (unsigned)(sb >> 32) : (unsigned)sb; }
        } else {
            unsigned Tk = 0u;
#pragma unroll 1
            for (int bit = 31; bit >= 0; --bit) {
                const unsigned cand = Tk | (1u << bit);
                int cnt = 0;
#pragma unroll
                for (int i = 0; i < 32; ++i) cnt += __popcll(__ballot(key[i] >= cand));
                if (cnt >= 256) Tk = cand;
            }
            int cgt = 0;
#pragma unroll
            for (int i = 0; i < 32; ++i) cgt += __popcll(__ballot(key[i] > Tk));
            int need = 256 - cgt;
#pragma unroll
            for (int i = 0; i < 32; ++i) {
                const unsigned long long gtb = __ballot(key[i] > Tk), eqb = __ballot(key[i] == Tk);
                unsigned long long take = 0ull;
                const int ne = __popcll(eqb);
                if (need > 0 && ne > 0) {
                    if (ne <= need) { take = eqb; need -= ne; }
                    else {
                        unsigned long long rem = eqb;
                        for (int q = 0; q < need; ++q) { const unsigned long long low = rem & (~rem + 1ull); take |= low; rem ^= low; }
                        need = 0;
                    }
                }
                const unsigned long long sb = gtb | take;
                if ((lane >> 1) == i) w = (lane & 1) ? (unsigned)(sb >> 32) : (unsigned)sb;
            }
        }
        MASK[(size_t)m * 64 + lane] = w;
        __builtin_amdgcn_wave_barrier();
    }
}

template <int MODE> __device__ __forceinline__ void naive_attn_item(const Params& p, int b, int h, int qc, int lane) {
    const bf16_t* QKV = (const bf16_t*)(p.ws + WS_R1);
    bf16_t* OC = (bf16_t*)(p.ws + WS_R2);
    constexpr int cq = MODE == 0 ? CQ_SB : MODE == 1 ? CQ_MB : CQ_DS, ck = MODE == 0 ? CK_SB : MODE == 1 ? CK_MB : CK_DS, cv = MODE == 0 ? CV_SB : MODE == 1 ? CV_MB : CV_DS;
    constexpr int co = MODE == 0 ? CO_SB : MODE == 1 ? CO_MB : CO_DS;
    const int t = qc * 64 + lane; const size_t row = (size_t)b * SEQ + t;
    float q[64], acc[64];
    {
        const u32x4* qp = (const u32x4*)(QKV + row * QKV_PITCH + cq + h * 64);
#pragma unroll
        for (int i = 0; i < 8; ++i) { const u32x4 w = qp[i];
            q[i * 8 + 0] = bflo(w.x); q[i * 8 + 1] = bfhi(w.x); q[i * 8 + 2] = bflo(w.y); q[i * 8 + 3] = bfhi(w.y);
            q[i * 8 + 4] = bflo(w.z); q[i * 8 + 5] = bfhi(w.z); q[i * 8 + 6] = bflo(w.w); q[i * 8 + 7] = bfhi(w.w); }
    }
#pragma unroll
    for (int d = 0; d < 64; ++d) acc[d] = 0.f;
    const bf16_t* Kb = QKV + (size_t)b * SEQ * QKV_PITCH + ck + h * 64;
    const bf16_t* Vb = QKV + (size_t)b * SEQ * QKV_PITCH + cv + h * 64;
    const int tmax = qc * 64 + 63;
    float outscale = 1.f;
    if (MODE == 0) {
        float R = 0.f;
        for (int s = tmax - 1; s >= 0; --s) {
            const u32x4* kp = (const u32x4*)(Kb + (size_t)s * QKV_PITCH);
            float z = 0.f;
#pragma unroll
            for (int i = 0; i < 8; ++i) { const u32x4 w = kp[i];
                z += q[i * 8 + 0] * bflo(w.x) + q[i * 8 + 1] * bfhi(w.x) + q[i * 8 + 2] * bflo(w.y) + q[i * 8 + 3] * bfhi(w.y)
                   + q[i * 8 + 4] * bflo(w.z) + q[i * 8 + 5] * bfhi(w.z) + q[i * 8 + 6] * bflo(w.w) + q[i * 8 + 7] * bfhi(w.w); }
            z *= 0.125f;
            const float u = -(fmaxf(z, 0.f) + log1pf(__expf(-fabsf(z))));
            const bool act = s < t;
            const float a = act ? __expf(z + u + R) : 0.f;
            if (act) R += u;
            const u32x4* vp = (const u32x4*)(Vb + (size_t)s * QKV_PITCH);
#pragma unroll
            for (int i = 0; i < 8; ++i) { const u32x4 w = vp[i];
                acc[i * 8 + 0] += a * bflo(w.x); acc[i * 8 + 1] += a * bfhi(w.x); acc[i * 8 + 2] += a * bflo(w.y); acc[i * 8 + 3] += a * bfhi(w.y);
                acc[i * 8 + 4] += a * bflo(w.z); acc[i * 8 + 5] += a * bfhi(w.z); acc[i * 8 + 6] += a * bflo(w.w); acc[i * 8 + 7] += a * bfhi(w.w); }
        }
    } else {
        const float slope = exp2f(-0.8f * (float)(MODE == 1 ? (2 * h + 1) : (2 * h + 2)));
        const int own = t >> 8;
        unsigned selm = 0u;
        if (MODE == 1) {
            const float* KM = (const float*)(p.ws + WS_KMEAN);
            float gate[8];
#pragma unroll
            for (int n = 0; n < 8; ++n) {
                gate[n] = -1e30f;
                if (n < own) {
                    const float* km = KM + (((size_t)b * 8 + n) * 5 + h) * 64;
                    float gsum = 0.f;
#pragma unroll
                    for (int d = 0; d < 64; ++d) gsum += q[d] * km[d];
                    gate[n] = gsum;
                }
            }
#pragma unroll
            for (int r = 0; r < 3; ++r) {
                float best = -3e38f; int bi = -1;
#pragma unroll
                for (int n = 0; n < 8; ++n) if (!((selm >> n) & 1u) && gate[n] > best) { best = gate[n]; bi = n; }
                if (bi >= 0) selm |= 1u << bi;
            }
            selm &= (1u << own) - 1u;
        }
        const unsigned* MASK = (const unsigned*)(p.ws + WS_MASK) + row * 64;
        float mx = -3e38f, l = 0.f;
        unsigned mw = 0u;
        for (int s = 0; s <= tmax; ++s) {
            bool allowed;
            if (MODE == 1) {
                const int n = s >> 8;
                allowed = (n < own) ? ((selm >> n) & 1u) : (s <= t);
            } else {
                if ((s & 31) == 0) mw = MASK[s >> 5];
                allowed = (mw >> (s & 31)) & 1u;
            }
            if (!__any(allowed)) continue;
            const u32x4* kp = (const u32x4*)(Kb + (size_t)s * QKV_PITCH);
            float z = 0.f;
#pragma unroll
            for (int i = 0; i < 8; ++i) { const u32x4 w = kp[i];
                z += q[i * 8 + 0] * bflo(w.x) + q[i * 8 + 1] * bfhi(w.x) + q[i * 8 + 2] * bflo(w.y) + q[i * 8 + 3] * bfhi(w.y)
                   + q[i * 8 + 4] * bflo(w.z) + q[i * 8 + 5] * bfhi(w.z) + q[i * 8 + 6] * bflo(w.w) + q[i * 8 + 7] * bfhi(w.w); }
            const float sc = z * 0.125f - slope * (float)(t - s);
            const float mn = allowed ? fmaxf(mx, sc) : mx;
            const float alpha = __expf(mx - mn);
            const float pp = allowed ? __expf(sc - mn) : 0.f;
            mx = mn; l = l * alpha + pp;
            const u32x4* vp = (const u32x4*)(Vb + (size_t)s * QKV_PITCH);
#pragma unroll
            for (int i = 0; i < 8; ++i) { const u32x4 w = vp[i];
                acc[i * 8 + 0] = acc[i * 8 + 0] * alpha + pp * bflo(w.x); acc[i * 8 + 1] = acc[i * 8 + 1] * alpha + pp * bfhi(w.x);
                acc[i * 8 + 2] = acc[i * 8 + 2] * alpha + pp * bflo(w.y); acc[i * 8 + 3] = acc[i * 8 + 3] * alpha + pp * bfhi(w.y);
                acc[i * 8 + 4] = acc[i * 8 + 4] * alpha + pp * bflo(w.z); acc[i * 8 + 5] = acc[i * 8 + 5] * alpha + pp * bfhi(w.z);
                acc[i * 8 + 6] = acc[i * 8 + 6] * alpha + pp * bflo(w.w); acc[i * 8 + 7] = acc[i * 8 + 7] * alpha + pp * bfhi(w.w); }
        }
        outscale = 1.f / l;
    }
    u32x4* op = (u32x4*)(OC + row * OC_PITCH + co + h * 64);
#pragma unroll
    for (int i = 0; i < 8; ++i) { u32x4 w;
        w.x = pk2(acc[i * 8 + 0] * outscale, acc[i * 8 + 1] * outscale); w.y = pk2(acc[i * 8 + 2] * outscale, acc[i * 8 + 3] * outscale);
        w.z = pk2(acc[i * 8 + 4] * outscale, acc[i * 8 + 5] * outscale); w.w = pk2(acc[i * 8 + 6] * outscale, acc[i * 8 + 7] * outscale);
        op[i] = w; }
}
template <int MODE> __device__ __forceinline__ void phase_naive_attn(const Params& p, Ctx cx) { const int wid = cx.wid, BID = cx.bid, NBLK = cx.nblk; (void)wid; (void)BID; (void)NBLK;
    constexpr int NH = MODE == 0 ? H_SB : 5;
    const int lane = lane_id_opaque(), gw = BID * NWAVES + wid, NGW = NBLK * NWAVES;
    const int nitems = BATCH * NH * 32;
    for (int it = gw; it < nitems; it += NGW) {
        const int qc = 31 - it / (BATCH * NH), bh = it % (BATCH * NH);
        naive_attn_item<MODE>(p, bh / NH, bh % NH, qc, lane);
    }
}
typedef float f32x2g_t __attribute__((ext_vector_type(2))); typedef __bf16 bf16x2g_t __attribute__((ext_vector_type(2)));
__device__ __forceinline__ unsigned cvt_pk(float lo, float hi) { f32x2g_t v = {lo, hi}; bf16x2g_t b = __builtin_convertvector(v, bf16x2g_t); return __builtin_bit_cast(unsigned, b); }
typedef short bf16x8_t __attribute__((ext_vector_type(8)));
typedef float f32x16_t __attribute__((ext_vector_type(16)));
typedef __attribute__((address_space(3))) unsigned char lds_u8;
constexpr int AT_PITCH = 144, AT_KBYTES = 64 * AT_PITCH, AT_BUF = 2 * AT_KBYTES;
constexpr float AT_C1 = 0.125f * 1.4426950408889634f;
__device__ __forceinline__ float fexp2(float x) { return __builtin_amdgcn_exp2f(x); }
__device__ __forceinline__ float flog2(float x) { return __builtin_amdgcn_logf(x); }

template <int MODE> __device__ __forceinline__ void attn_unit(const bf16_t* __restrict__ QKV, bf16_t* __restrict__ OC, const float* __restrict__ KM, const unsigned* __restrict__ MASK,
                                                              int b, int h, int qb, lds_u8* lds, int wid, int lane) {
    constexpr int cq = MODE == 0 ? CQ_SB : MODE == 1 ? CQ_MB : CQ_DS, ck = MODE == 0 ? CK_SB : MODE == 1 ? CK_MB : CK_DS, cv = MODE == 0 ? CV_SB : MODE == 1 ? CV_MB : CV_DS;
    constexpr int co = MODE == 0 ? CO_SB : MODE == 1 ? CO_MB : CO_DS;
    const int c = lane & 31, hh = lane >> 5, tid = wid * 64 + lane;
    const int q0 = qb * 256, tq = q0 + 32 * wid + c;
    const size_t rowq = (size_t)b * SEQ + tq;
    bf16x8_t qf[4];
#pragma unroll
    for (int ds = 0; ds < 4; ++ds) qf[ds] = *(const bf16x8_t*)(QKV + rowq * QKV_PITCH + cq + h * 64 + ds * 16 + hh * 8);
    float slope2 = 0.f; unsigned selm = 0u;
    if (MODE != 0) slope2 = exp2f(-0.8f * (float)(MODE == 1 ? (2 * h + 1) : (2 * h + 2))) * 1.4426950408889634f;
    if (MODE == 1) {
        float gate[8];
#pragma unroll
        for (int n = 0; n < 8; ++n) {
            gate[n] = -1e30f;
            if (n < qb) {
                const float* km = KM + (((size_t)b * 8 + n) * 5 + h) * 64 + hh * 8;
                float gs = 0.f;
#pragma unroll
                for (int ds = 0; ds < 4; ++ds) {
                    const f32x4 k0 = *(const f32x4*)(km + ds * 16), k1 = *(const f32x4*)(km + ds * 16 + 4);
                    const bf16x8_t qv = qf[ds];
                    gs += bf2f((unsigned short)qv[0]) * k0[0] + bf2f((unsigned short)qv[1]) * k0[1] + bf2f((unsigned short)qv[2]) * k0[2] + bf2f((unsigned short)qv[3]) * k0[3]
                        + bf2f((unsigned short)qv[4]) * k1[0] + bf2f((unsigned short)qv[5]) * k1[1] + bf2f((unsigned short)qv[6]) * k1[2] + bf2f((unsigned short)qv[7]) * k1[3];
                }
                gs += __shfl_xor(gs, 32);
                gate[n] = gs;
            }
        }
#pragma unroll
        for (int r = 0; r < 3; ++r) {
            float best = -3e38f; int bi = -1;
#pragma unroll
            for (int n = 0; n < 8; ++n) if (!((selm >> n) & 1u) && gate[n] > best) { best = gate[n]; bi = n; }
            if (bi >= 0) selm |= 1u << bi;
        }
        selm &= (1u << qb) - 1u;
    }
    f32x16_t o0, o1;
#pragma unroll
    for (int i = 0; i < 16; ++i) { o0[i] = 0.f; o1[i] = 0.f; }
    float m = -3e38f, l = 0.f, R = 0.f;
    const int jmax = 4 * qb + 3, jw = (q0 + 32 * wid + 31) >> 6;
    const bool isv = tid < 256;
    const int vchunk = (tid >> 5) & 7, vrp = tid & 31, krow = (tid & 255) >> 2, kcp = tid & 3;
    const bf16_t* gsrc0; const bf16_t* gsrc1;
    if (isv) { gsrc0 = QKV + ((size_t)b * SEQ + 2 * vrp) * QKV_PITCH + cv + h * 64 + vchunk * 8; gsrc1 = gsrc0 + QKV_PITCH; }
    else { gsrc0 = QKV + ((size_t)b * SEQ + krow) * QKV_PITCH + ck + h * 64 + kcp * 16; gsrc1 = gsrc0 + 8; }
    const int rho = c, kperm = 16 * ((rho >> 2) & 1) + (rho & 3) + 4 * (rho >> 3);
    const int kfoff = kperm * AT_PITCH + hh * 16;
    const int vfoff = AT_KBYTES + c * AT_PITCH + hh * 32;
    const unsigned* mrow = MASK + rowq * 64;
    u32x4 st0, st1; u32x2 mwn = (u32x2){0u, 0u}, mwc = (u32x2){0u, 0u};
#define AT_LOAD(j) do { st0 = *(const u32x4*)(gsrc0 + (size_t)(j) * 64 * QKV_PITCH); st1 = *(const u32x4*)(gsrc1 + (size_t)(j) * 64 * QKV_PITCH); if (MODE == 2) mwn = *(const u32x2*)(mrow + 2 * (j)); } while (0)
#define AT_STORE(bufi) do { lds_u8* bb = lds + (bufi) * AT_BUF; \
        if (isv) { lds_u8* vb = bb + AT_KBYTES + (vchunk * 8) * AT_PITCH + vrp * 4; \
            *(__attribute__((address_space(3))) unsigned*)(vb + 0 * AT_PITCH) = (st0.x & 0xffffu) | (st1.x << 16); *(__attribute__((address_space(3))) unsigned*)(vb + 1 * AT_PITCH) = (st0.x >> 16) | (st1.x & 0xffff0000u); \
            *(__attribute__((address_space(3))) unsigned*)(vb + 2 * AT_PITCH) = (st0.y & 0xffffu) | (st1.y << 16); *(__attribute__((address_space(3))) unsigned*)(vb + 3 * AT_PITCH) = (st0.y >> 16) | (st1.y & 0xffff0000u); \
            *(__attribute__((address_space(3))) unsigned*)(vb + 4 * AT_PITCH) = (st0.z & 0xffffu) | (st1.z << 16); *(__attribute__((address_space(3))) unsigned*)(vb + 5 * AT_PITCH) = (st0.z >> 16) | (st1.z & 0xffff0000u); \
            *(__attribute__((address_space(3))) unsigned*)(vb + 6 * AT_PITCH) = (st0.w & 0xffffu) | (st1.w << 16); *(__attribute__((address_space(3))) unsigned*)(vb + 7 * AT_PITCH) = (st0.w >> 16) | (st1.w & 0xffff0000u); } \
        else { lds_u8* kb_ = bb + krow * AT_PITCH + kcp * 32; *(__attribute__((address_space(3))) u32x4*)(kb_) = st0; *(__attribute__((address_space(3))) u32x4*)(kb_ + 16) = st1; } } while (0)
    AT_LOAD(jmax); AT_STORE(0); mwc = mwn;
    __syncthreads();
    for (int j = jmax; j >= 0; --j) {
        const int bufi = (jmax - j) & 1;
        if (j > 0) AT_LOAD(j - 1);
        if (j <= jw) {
            const lds_u8* bb = lds + bufi * AT_BUF;
#pragma unroll
            for (int s2 = 1; s2 >= 0; --s2) {
                const int kb = 64 * j + 32 * s2;
                if (kb > q0 + 32 * wid + 31) continue;
                f32x16_t S;
#pragma unroll
                for (int i = 0; i < 16; ++i) S[i] = 0.f;
#pragma unroll
                for (int ds = 0; ds < 4; ++ds) {
                    const bf16x8_t kf = *(const __attribute__((address_space(3))) bf16x8_t*)(bb + kfoff + s2 * 32 * AT_PITCH + ds * 32);
                    S = __builtin_amdgcn_mfma_f32_32x32x16_bf16(kf, qf[ds], S, 0, 0, 0);
                }
                unsigned vm;
                const int k0 = kb + 16 * hh;
                if (MODE == 0) { int nv = tq - k0; nv = nv < 0 ? 0 : (nv > 16 ? 16 : nv); vm = (1u << nv) - 1u; }
                else if (MODE == 1) { if (j >= 4 * qb) { int nv = tq - k0 + 1; nv = nv < 0 ? 0 : (nv > 16 ? 16 : nv); vm = (1u << nv) - 1u; } else vm = ((selm >> (j >> 2)) & 1u) ? 0xffffu : 0u; }
                else { vm = ((s2 ? mwc.y : mwc.x) >> (16 * hh)) & 0xffffu; }
                const bool allv = __ballot(vm != 0xffffu) == 0ull;
                float P[16];
                if (MODE == 0) {
                    float zs[16], cs[16];
#pragma unroll
                    for (int i = 0; i < 16; ++i) {
                        const float zl = S[i] * AT_C1;
                        float sp = fmaxf(zl, 0.f) + flog2(1.f + fexp2(-fabsf(zl)));
                        if (!allv) sp = ((vm >> i) & 1u) ? sp : 0.f;
                        zs[i] = zl; cs[i] = sp;
                    }
                    float run = 0.f;
#pragma unroll
                    for (int i = 15; i >= 0; --i) { run += cs[i]; cs[i] = run; }
                    const float other = __shfl_xor(run, 32);
                    const float base = R + (hh == 0 ? other : 0.f);
#pragma unroll
                    for (int i = 0; i < 16; ++i) { float a = fexp2(zs[i] - (base + cs[i])); if (!allv) a = ((vm >> i) & 1u) ? a : 0.f; P[i] = a; }
                    R += run + other;
                } else {
                    const float bias0 = slope2 * (float)(k0 - tq);
                    float mloc = -3e38f;
#pragma unroll
                    for (int i = 0; i < 16; ++i) { float s = S[i] * AT_C1 + (bias0 + slope2 * (float)i); if (!allv) s = ((vm >> i) & 1u) ? s : -3e38f; P[i] = s; mloc = fmaxf(mloc, s); }
                    mloc = fmaxf(mloc, __shfl_xor(mloc, 32));
                    const float mnew = fmaxf(m, mloc);
                    if (__ballot(mnew > m) != 0ull) {
                        const float alpha = fexp2(m - mnew);
#pragma unroll
                        for (int i = 0; i < 16; ++i) { o0[i] *= alpha; o1[i] *= alpha; }
                        l *= alpha;
                    }
                    m = mnew;
#pragma unroll
                    for (int i = 0; i < 16; ++i) { float pe = fexp2(P[i] - mnew); if (!allv) pe = ((vm >> i) & 1u) ? pe : 0.f; l += pe; P[i] = pe; }
                }
                bf16x8_t pf0, pf1;
                { u32x4 w0, w1;
                  w0.x = cvt_pk(P[0], P[1]); w0.y = cvt_pk(P[2], P[3]); w0.z = cvt_pk(P[4], P[5]); w0.w = cvt_pk(P[6], P[7]);
                  w1.x = cvt_pk(P[8], P[9]); w1.y = cvt_pk(P[10], P[11]); w1.z = cvt_pk(P[12], P[13]); w1.w = cvt_pk(P[14], P[15]);
                  pf0 = __builtin_bit_cast(bf16x8_t, w0); pf1 = __builtin_bit_cast(bf16x8_t, w1); }
                {
                    const bf16x8_t v00 = *(const __attribute__((address_space(3))) bf16x8_t*)(bb + vfoff + s2 * 64);
                    const bf16x8_t v01 = *(const __attribute__((address_space(3))) bf16x8_t*)(bb + vfoff + s2 * 64 + 16);
                    const bf16x8_t v10 = *(const __attribute__((address_space(3))) bf16x8_t*)(bb + vfoff + 32 * AT_PITCH + s2 * 64);
                    const bf16x8_t v11 = *(const __attribute__((address_space(3))) bf16x8_t*)(bb + vfoff + 32 * AT_PITCH + s2 * 64 + 16);
                    o0 = __builtin_amdgcn_mfma_f32_32x32x16_bf16(v00, pf0, o0, 0, 0, 0);
                    o0 = __builtin_amdgcn_mfma_f32_32x32x16_bf16(v01, pf1, o0, 0, 0, 0);
                    o1 = __builtin_amdgcn_mfma_f32_32x32x16_bf16(v10, pf0, o1, 0, 0, 0);
                    o1 = __builtin_amdgcn_mfma_f32_32x32x16_bf16(v11, pf1, o1, 0, 0, 0);
                }
            }
        }
        if (j > 0) AT_STORE(bufi ^ 1);
        mwc = mwn;
        __syncthreads();
    }
#undef AT_LOAD
#undef AT_STORE
    float sc = 1.f;
    if (MODE != 0) { l += __shfl_xor(l, 32); sc = 1.f / l; }
    bf16_t* orow = OC + rowq * OC_PITCH + co + h * 64 + 4 * hh;
#pragma unroll
    for (int g = 0; g < 4; ++g) {
        u32x2 w; w.x = cvt_pk(o0[4 * g] * sc, o0[4 * g + 1] * sc); w.y = cvt_pk(o0[4 * g + 2] * sc, o0[4 * g + 3] * sc);
        *(u32x2*)(orow + 8 * g) = w;
        u32x2 w2; w2.x = cvt_pk(o1[4 * g] * sc, o1[4 * g + 1] * sc); w2.y = cvt_pk(o1[4 * g + 2] * sc, o1[4 * g + 3] * sc);
        *(u32x2*)(orow + 32 + 8 * g) = w2;
    }
}
template <int MODEMASK> __device__ __forceinline__ void phase_fast_attn(const Params& p, unsigned char* lds_raw, Ctx cx) {
    const bf16_t* QKV = (const bf16_t*)(p.ws + WS_R1); bf16_t* OC = (bf16_t*)(p.ws + WS_R2);
    const float* KM = (const float*)(p.ws + WS_KMEAN); const unsigned* MASK = (const unsigned*)(p.ws + WS_MASK);
    lds_u8* lds = (lds_u8*)lds_raw;
    const int lane = lane_id_opaque();
    constexpr int NBH = ((MODEMASK & 1) ? BATCH * H_SB : 0) + ((MODEMASK & 2) ? BATCH * H_MB : 0) + ((MODEMASK & 4) ? BATCH * H_DS : 0);
    for (int u = cx.bid; u < NBH * 8; u += cx.nblk) {
        const int qb = 7 - u / NBH; int r = u % NBH;
        if (MODEMASK & 1) { if (r < BATCH * H_SB) { attn_unit<0>(QKV, OC, KM, MASK, r / H_SB, r % H_SB, qb, lds, cx.wid, lane); continue; } r -= BATCH * H_SB; }
        if (MODEMASK & 2) { if (r < BATCH * H_MB) { attn_unit<1>(QKV, OC, KM, MASK, r / H_MB, r % H_MB, qb, lds, cx.wid, lane); continue; } r -= BATCH * H_MB; }
        if (MODEMASK & 4) { attn_unit<2>(QKV, OC, KM, MASK, r / H_DS, r % H_DS, qb, lds, cx.wid, lane); }
    }
}

__device__ __forceinline__ void phase_zero_pad(const Params& p, Ctx cx) { const int wid = cx.wid, BID = cx.bid, NBLK = cx.nblk; (void)wid; (void)BID; (void)NBLK;
    bf16_t* OC = (bf16_t*)(p.ws + WS_R2);
    const int gt = BID * NTHREADS + TIDX, NT = NBLK * NTHREADS;
    for (int i = gt; i < T * 16; i += NT) {
        const int row = i >> 4, q = i & 15, col = (q < 8 ? 704 : 1088 - 64) + q * 8;
        *(u32x4*)(OC + (size_t)row * OC_PITCH + col) = (u32x4){0u, 0u, 0u, 0u};
    }
}

namespace pg8 {
#define PG8_LAS __attribute__((address_space(3)))
typedef unsigned short bf16_t;
typedef short bf16x8 __attribute__((ext_vector_type(8)));
typedef float f32x4 __attribute__((ext_vector_type(4)));
typedef unsigned u32x4 __attribute__((ext_vector_type(4)));
constexpr int BM = 256, BK = 64, HALF = 128, HTB = HALF * BK * 2  , STAGE_BYTES = 8 * HTB, NXCD = 8, WGM = 8;

__host__ __device__ __forceinline__ int lds_byte(int r, int c) { const int st = (r >> 4) * 2 + (c >> 5), rr = r & 15, cc = c & 31, ob = rr * 64 + cc * 2; return st * 1024 + (ob ^ (((ob >> 9) & 1) << 5)); }
__host__ __device__ __forceinline__ void stage_rc(int b, int& R, int& C) { const int st = b / 1024, sb = b % 1024, swz = sb ^ (((sb >> 9) & 1) << 5); R = (st >> 1) * 16 + swz / 64; C = (st & 1) * 32 + (swz % 64) / 2; }
__host__ __device__ __forceinline__ int perm32(int rho) { const int n = rho >> 4, i = rho & 15; return 8 * (i >> 2) + 4 * n + (i & 3); }

struct Unit { int pm, pn; };
struct Gemm { const bf16_t* A; const bf16_t* Bt; int M, N, K, lda; };

struct StaticOrder {
    int nM, nN, nwg, G, c;
    __host__ __device__ void init(int M, int N, int G_, int c_) { nM = M / BM; nN = N / BM; nwg = nM * nN; G = G_; c = c_; }
    __host__ __device__ bool next(int i, Unit& u) const {
        const long L = (long)i * G + c; if (L >= nwg) return false;
        int wgid = (int)L; { const int q = nwg / NXCD, r = nwg % NXCD, xcd = wgid % NXCD, off = wgid / NXCD; wgid = (xcd < r ? xcd * (q + 1) : r * (q + 1) + (xcd - r) * q) + off; }
        const int nig = WGM * nN, gid = wgid / nig, fm = gid * WGM, gsz = (nM - fm) < WGM ? (nM - fm) : WGM;
        u.pm = fm + ((wgid % nig) % gsz); u.pn = (wgid % nig) / gsz; return true;
    }
    __device__ __forceinline__ void a_ready(const Unit&) const {}
    __device__ __forceinline__ void done(const Unit&) const {}
};


typedef float f32x2_t __attribute__((ext_vector_type(2))); typedef __bf16 bf16x2_t __attribute__((ext_vector_type(2)));
__device__ __forceinline__ unsigned cvt_pk_bf16(float lo, float hi) { f32x2_t v = {lo, hi}; bf16x2_t b = __builtin_convertvector(v, bf16x2_t); return __builtin_bit_cast(unsigned, b); }
struct EpiBf16 {
    static constexpr bool PERM = true, AFTER_DRAIN = false;
    bf16_t* O; int ldc;
    __device__ __forceinline__ void operator()(const f32x4 (&acc)[2][2][4][2], const Unit& u, int wr, int wc, int fr, int fq) const {
        const int row0 = u.pm * BM + wr * 64 + fr, col0 = u.pn * BM + wc * 32 + 8 * fq;
#pragma unroll
        for (int ai = 0; ai < 2; ++ai)
#pragma unroll
            for (int m = 0; m < 4; ++m) { bf16_t* rowp = O + (size_t)(row0 + ai * HALF + m * 16) * ldc + col0;
#pragma unroll
                for (int bj = 0; bj < 2; ++bj) { const f32x4 v0 = acc[ai][bj][m][0], v1 = acc[ai][bj][m][1];
                    u32x4 w; w.x = cvt_pk_bf16(v0[0], v0[1]); w.y = cvt_pk_bf16(v0[2], v0[3]); w.z = cvt_pk_bf16(v1[0], v1[1]); w.w = cvt_pk_bf16(v1[2], v1[3]);
                    *(u32x4*)(rowp + bj * HALF) = w; } }
    }
};

__device__ __forceinline__ float fast_sigmoid(float v) { return __builtin_amdgcn_rcpf(1.f + __builtin_amdgcn_exp2f(-1.4426950408889634f * v)); }
struct EpiSigmoid {
    static constexpr bool PERM = true, AFTER_DRAIN = false;
    bf16_t* O; int ldc; const float* bias;
    __device__ __forceinline__ void operator()(const f32x4 (&acc)[2][2][4][2], const Unit& u, int wr, int wc, int fr, int fq) const {
        const int row0 = u.pm * BM + wr * 64 + fr, col0 = u.pn * BM + wc * 32 + 8 * fq;
        f32x4 bv[2][2];
#pragma unroll
        for (int bj = 0; bj < 2; ++bj)
#pragma unroll
            for (int n = 0; n < 2; ++n) bv[bj][n] = *(const f32x4*)(bias + col0 + bj * HALF + 4 * n);
#pragma unroll
        for (int ai = 0; ai < 2; ++ai)
#pragma unroll
            for (int m = 0; m < 4; ++m) { bf16_t* rowp = O + (size_t)(row0 + ai * HALF + m * 16) * ldc + col0;
#pragma unroll
                for (int bj = 0; bj < 2; ++bj) { const f32x4 v0 = acc[ai][bj][m][0] + bv[bj][0], v1 = acc[ai][bj][m][1] + bv[bj][1];
                    u32x4 w; w.x = cvt_pk_bf16(fast_sigmoid(v0[0]), fast_sigmoid(v0[1])); w.y = cvt_pk_bf16(fast_sigmoid(v0[2]), fast_sigmoid(v0[3]));
                    w.z = cvt_pk_bf16(fast_sigmoid(v1[0]), fast_sigmoid(v1[1])); w.w = cvt_pk_bf16(fast_sigmoid(v1[2]), fast_sigmoid(v1[3]));
                    *(u32x4*)(rowp + bj * HALF) = w; } }
    }
};
struct EpiGate {
    static constexpr bool PERM = true, AFTER_DRAIN = false;
    bf16_t* O; const bf16_t* gates; int br;
    __device__ __forceinline__ void operator()(const f32x4 (&acc)[2][2][4][2], const Unit& u, int wr, int wc, int fr, int fq) const {
        const int row0 = u.pm * BM + wr * 64 + fr, col0 = u.pn * BM + wc * 32 + 8 * fq;
#pragma unroll
        for (int ai = 0; ai < 2; ++ai)
#pragma unroll
            for (int m = 0; m < 4; ++m) { const size_t row = (size_t)(row0 + ai * HALF + m * 16);
#pragma unroll
                for (int bj = 0; bj < 2; ++bj) {
                    const u32x4 gw = *(const u32x4*)(gates + row * 3072 + br * 1024 + col0 + bj * HALF);
                    u32x4 ow = (u32x4){0u, 0u, 0u, 0u};
                    if (br > 0) ow = *(const u32x4*)(O + row * 1024 + col0 + bj * HALF);
                    const f32x4 v0 = acc[ai][bj][m][0], v1 = acc[ai][bj][m][1];
                    u32x4 w;
                    w.x = cvt_pk_bf16(__uint_as_float(ow.x << 16) + __uint_as_float(gw.x << 16) * v0[0], __uint_as_float(ow.x & 0xffff0000u) + __uint_as_float(gw.x & 0xffff0000u) * v0[1]);
                    w.y = cvt_pk_bf16(__uint_as_float(ow.y << 16) + __uint_as_float(gw.y << 16) * v0[2], __uint_as_float(ow.y & 0xffff0000u) + __uint_as_float(gw.y & 0xffff0000u) * v0[3]);
                    w.z = cvt_pk_bf16(__uint_as_float(ow.z << 16) + __uint_as_float(gw.z << 16) * v1[0], __uint_as_float(ow.z & 0xffff0000u) + __uint_as_float(gw.z & 0xffff0000u) * v1[1]);
                    w.w = cvt_pk_bf16(__uint_as_float(ow.w << 16) + __uint_as_float(gw.w << 16) * v1[2], __uint_as_float(ow.w & 0xffff0000u) + __uint_as_float(gw.w & 0xffff0000u) * v1[3]);
                    *(u32x4*)(O + row * 1024 + col0 + bj * HALF) = w; } }
    }
};
struct EpiSwiglu {
    static constexpr bool PERM = true, AFTER_DRAIN = false;
    bf16_t* O; int ldc;
    __device__ __forceinline__ void operator()(const f32x4 (&acc)[2][2][4][2], const Unit& u, int wr, int wc, int fr, int fq) const {
        const int row0 = u.pm * BM + wr * 64 + fr, col0 = u.pn * HALF + wc * 32 + 8 * fq;
#pragma unroll
        for (int ai = 0; ai < 2; ++ai)
#pragma unroll
            for (int m = 0; m < 4; ++m) { bf16_t* rowp = O + (size_t)(row0 + ai * HALF + m * 16) * ldc + col0;
                float o[8];
#pragma unroll
                for (int n = 0; n < 2; ++n)
#pragma unroll
                    for (int e = 0; e < 4; ++e) { const float gt = acc[ai][0][m][n][e]; o[n * 4 + e] = gt * fast_sigmoid(gt) * acc[ai][1][m][n][e]; }
                u32x4 w; w.x = cvt_pk_bf16(o[0], o[1]); w.y = cvt_pk_bf16(o[2], o[3]); w.z = cvt_pk_bf16(o[4], o[5]); w.w = cvt_pk_bf16(o[6], o[7]);
                *(u32x4*)rowp = w; }
    }
};

template <class Epi, class Sched, bool ALIGN_EPI = false, bool SP2 = false>
__device__ __forceinline__ void gemm_phase(PG8_LAS unsigned char* lds, const Gemm g, const Sched& S, const Epi& E, int wid_in) {
    const int wid = wid_in, lane = lane_id_opaque(), tid = wid * 64 + lane, wr = wid >> 2, wc = wid & 3, fr = lane & 15, fq = lane >> 4;
    const int K = g.K, nt = K / BK;
    unsigned voffA[2], voffB[2];
#pragma unroll
    for (int i = 0; i < 2; ++i) { int R, C; stage_rc(tid * 16 + i * 8192, R, C); const int Rb = Epi::PERM ? ((R & ~31) + perm32(R & 31)) : R;
        voffA[i] = (unsigned)(R * g.lda + C) * 2u; voffB[i] = (unsigned)(Rb * K + C) * 2u; }
    const size_t kstep = (size_t)(BK * 2);
    const size_t hstepA = (size_t)HALF * g.lda * 2, hstepB = (size_t)HALF * K * 2;
    const size_t tstepA = 2 * hstepA, tstepB = 2 * hstepB;
    const unsigned ldsw = (unsigned)wid * 1024u;
    const int aoff = lds_byte(wr * 64 + fr, fq * 8), boff = lds_byte(wc * 32 + fr, fq * 8);
#define PG8_SA(b, h) (((b) * 2 + (h)) * HTB)
#define PG8_SB(b, h) ((4 + (b) * 2 + (h)) * HTB)
#define PG8_STAGE(bufoff, gbase, voff) do { _Pragma("unroll") for (int _i = 0; _i < 2; ++_i) \
        __builtin_amdgcn_global_load_lds((const unsigned*)((const char*)(gbase) + (voff)[_i]), (PG8_LAS unsigned*)(lds + (bufoff) + ldsw + _i * 8192), 16, 0, 0); } while (0)
#define PG8_LDA(dst, b, h) do { _Pragma("unroll") for (int m = 0; m < 4; ++m) _Pragma("unroll") for (int k = 0; k < 2; ++k) dst[m][k] = *(const PG8_LAS bf16x8*)(lds + PG8_SA(b, h) + aoff + m * 2048 + k * 1024); } while (0)
#define PG8_LDB(dst, b, h) do { _Pragma("unroll") for (int n = 0; n < 2; ++n) _Pragma("unroll") for (int k = 0; k < 2; ++k) dst[n][k] = *(const PG8_LAS bf16x8*)(lds + PG8_SB(b, h) + boff + n * 2048 + k * 1024); } while (0)
#define PG8_MMA(ai, bj, At, Bt) do { __builtin_amdgcn_s_setprio(1); _Pragma("unroll") for (int m = 0; m < 4; ++m) _Pragma("unroll") for (int n = 0; n < 2; ++n) _Pragma("unroll") for (int k = 0; k < 2; ++k) \
        acc[ai][bj][m][n] = __builtin_amdgcn_mfma_f32_16x16x32_bf16(Bt[n][k], At[m][k], acc[ai][bj][m][n], 0, 0, 0); __builtin_amdgcn_s_setprio(0); } while (0)
#define PG8_WAIT_V(n) asm volatile("s_waitcnt vmcnt(" #n ")" ::: "memory")
#define PG8_WAIT_L(n) asm volatile("s_waitcnt lgkmcnt(" #n ")" ::: "memory")
#define PG8_BAR __builtin_amdgcn_s_barrier()
#define PG8_SCHED __builtin_amdgcn_sched_barrier(0)
    Unit cur, nxt; int ui = 0;
    if (!S.next(0, cur)) return;
    f32x4 acc[2][2][4][2];
#pragma unroll
    for (int a = 0; a < 2; ++a)
#pragma unroll
        for (int b = 0; b < 2; ++b)
#pragma unroll
            for (int m = 0; m < 4; ++m)
#pragma unroll
                for (int n = 0; n < 2; ++n) acc[a][b][m][n] = (f32x4){0.f, 0.f, 0.f, 0.f};
    bf16x8 At[4][2], B0[2][2], B1[2][2];
    const char* cA = (const char*)g.A + (size_t)cur.pm * tstepA; const char* cB = (const char*)g.Bt + (size_t)cur.pn * tstepB;
    S.a_ready(cur);
    if constexpr (SP2) {
        PG8_STAGE(PG8_SB(0, 0), cB, voffB); PG8_STAGE(PG8_SB(0, 1), cB + hstepB, voffB); PG8_STAGE(PG8_SA(0, 0), cA, voffA); PG8_STAGE(PG8_SA(0, 1), cA + hstepA, voffA);
        if (wr == 1) PG8_BAR;
        PG8_WAIT_V(2); PG8_BAR;
        PG8_STAGE(PG8_SB(1, 0), cB + kstep, voffB); PG8_STAGE(PG8_SA(1, 0), cA + kstep, voffA); PG8_STAGE(PG8_SB(1, 1), cB + hstepB + kstep, voffB);
        PG8_WAIT_V(6); PG8_BAR;
    } else {
        PG8_STAGE(PG8_SB(0, 0), cB, voffB); PG8_STAGE(PG8_SA(0, 0), cA, voffA); PG8_STAGE(PG8_SB(0, 1), cB + hstepB, voffB); PG8_STAGE(PG8_SA(0, 1), cA + hstepA, voffA);
        if (wr == 1) PG8_BAR;
        PG8_WAIT_V(4); PG8_BAR;
        PG8_STAGE(PG8_SB(1, 0), cB + kstep, voffB); PG8_STAGE(PG8_SA(1, 0), cA + kstep, voffA); PG8_STAGE(PG8_SB(1, 1), cB + hstepB + kstep, voffB);
        PG8_WAIT_V(6); PG8_BAR;
    }
    for (;;) {
        const bool has_next = S.next(ui + 1, nxt);
        const char* nA = has_next ? (const char*)g.A + (size_t)nxt.pm * tstepA : cA; const char* nB = has_next ? (const char*)g.Bt + (size_t)nxt.pn * tstepB : cB;
        for (int t = 0; t < nt; t += 2) {
            const bool last = (t == nt - 2);
            const char* a1 = cA + (size_t)(t + 1) * kstep;
            const char* a2 = last ? nA : cA + (size_t)(t + 2) * kstep; const char* b2 = last ? nB : cB + (size_t)(t + 2) * kstep;
            const char* a3 = a2 + kstep; const char* b3 = b2 + kstep;
            if (last && has_next) S.a_ready(nxt);
            if constexpr (SP2) {
            PG8_LDB(B0, 0, 0); PG8_LDB(B1, 0, 1); PG8_SCHED; PG8_LDA(At, 0, 0); PG8_STAGE(PG8_SA(1, 1), a1 + hstepA, voffA);
            PG8_WAIT_V(8); PG8_WAIT_L(0); PG8_BAR; PG8_MMA(0, 0, At, B0); PG8_MMA(0, 1, At, B1); PG8_BAR; PG8_SCHED;
            PG8_LDA(At, 0, 1); PG8_STAGE(PG8_SB(0, 0), b2, voffB); PG8_STAGE(PG8_SB(0, 1), b2 + hstepB, voffB); PG8_STAGE(PG8_SA(0, 0), a2, voffA);
            PG8_WAIT_V(8); PG8_WAIT_L(0); PG8_BAR; PG8_MMA(1, 0, At, B0); PG8_MMA(1, 1, At, B1); PG8_BAR; PG8_SCHED;
            PG8_LDB(B0, 1, 0); PG8_LDB(B1, 1, 1); PG8_SCHED; PG8_LDA(At, 1, 0); PG8_STAGE(PG8_SA(0, 1), a2 + hstepA, voffA);
            PG8_WAIT_V(8); PG8_WAIT_L(0); PG8_BAR; PG8_MMA(0, 0, At, B0); PG8_MMA(0, 1, At, B1); PG8_BAR; PG8_SCHED;
            PG8_LDA(At, 1, 1); PG8_STAGE(PG8_SB(1, 0), b3, voffB); PG8_STAGE(PG8_SB(1, 1), b3 + hstepB, voffB); PG8_STAGE(PG8_SA(1, 0), a3, voffA);
            PG8_WAIT_V(8); PG8_WAIT_L(0); PG8_BAR; PG8_MMA(1, 0, At, B0); PG8_MMA(1, 1, At, B1); PG8_BAR; PG8_SCHED;
            } else {
            PG8_LDB(B0, 0, 0); PG8_SCHED; PG8_LDA(At, 0, 0); PG8_STAGE(PG8_SA(1, 1), a1 + hstepA, voffA);
            PG8_WAIT_L(8); PG8_BAR; PG8_WAIT_L(0); PG8_MMA(0, 0, At, B0); PG8_BAR; PG8_SCHED;
            PG8_LDB(B1, 0, 1); PG8_STAGE(PG8_SB(0, 0), b2, voffB);
            PG8_BAR; PG8_WAIT_L(0); PG8_MMA(0, 1, At, B1); PG8_BAR;
            PG8_LDA(At, 0, 1); PG8_STAGE(PG8_SA(0, 0), a2, voffA);
            PG8_BAR; PG8_WAIT_L(0); PG8_MMA(1, 0, At, B0); PG8_BAR; PG8_SCHED;
            PG8_STAGE(PG8_SB(0, 1), b2 + hstepB, voffB);
            PG8_WAIT_V(6); PG8_BAR; PG8_MMA(1, 1, At, B1); PG8_BAR;
            PG8_LDB(B0, 1, 0); PG8_SCHED; PG8_LDA(At, 1, 0); PG8_STAGE(PG8_SA(0, 1), a2 + hstepA, voffA);
            PG8_WAIT_L(8); PG8_BAR; PG8_WAIT_L(0); PG8_MMA(0, 0, At, B0); PG8_BAR; PG8_SCHED;
            PG8_LDB(B1, 1, 1); PG8_STAGE(PG8_SB(1, 0), b3, voffB);
            PG8_BAR; PG8_WAIT_L(0); PG8_MMA(0, 1, At, B1); PG8_BAR;
            PG8_LDA(At, 1, 1); PG8_STAGE(PG8_SA(1, 0), a3, voffA);
            PG8_BAR; PG8_WAIT_L(0); PG8_MMA(1, 0, At, B0); PG8_BAR; PG8_SCHED;
            PG8_STAGE(PG8_SB(1, 1), b3 + hstepB, voffB);
            PG8_WAIT_V(6); PG8_BAR; PG8_MMA(1, 1, At, B1); PG8_BAR;
            }
        }
        if constexpr (ALIGN_EPI) { if (wr == 0) PG8_BAR; }
        if constexpr (!Epi::AFTER_DRAIN) { E(acc, cur, wr, wc, fr, fq); S.done(cur); }
        if (!has_next) break;
#pragma unroll
        for (int a = 0; a < 2; ++a)
#pragma unroll
            for (int b = 0; b < 2; ++b)
#pragma unroll
                for (int m = 0; m < 4; ++m)
#pragma unroll
                    for (int n = 0; n < 2; ++n) acc[a][b][m][n] = (f32x4){0.f, 0.f, 0.f, 0.f};
        cur = nxt; cA = nA; cB = nB; ++ui;
        if constexpr (ALIGN_EPI) { if (wr == 1) PG8_BAR; }
    }
    PG8_WAIT_V(0);
    if constexpr (!ALIGN_EPI) { if (wr == 0) PG8_BAR; }
    PG8_BAR;
    if constexpr (Epi::AFTER_DRAIN) { E.fused(acc, cur, wr, wc, fr, fq, lds, wid, lane); S.done(cur); }
#undef PG8_SA
#undef PG8_SB
#undef PG8_STAGE
#undef PG8_LDA
#undef PG8_LDB
#undef PG8_MMA
#undef PG8_WAIT_V
#undef PG8_WAIT_L
#undef PG8_BAR
#undef PG8_SCHED
}
}


constexpr size_t WT_IN1 = 0;
constexpr size_t WT_G = WT_IN1 + (size_t)3840 * 1024 * 2;
constexpr size_t WT_PROJ = WT_G + (size_t)3072 * 1024 * 2;
constexpr size_t WT_O = WT_PROJ + (size_t)3 * 1024 * 384 * 2;
constexpr size_t WT_UP = WT_O + (size_t)1024 * 1024 * 2;
constexpr size_t WT_DOWN = WT_UP + (size_t)5632 * 1024 * 2;
constexpr size_t WT_END = WT_DOWN + (size_t)1024 * 2816 * 2;
static_assert(WS_WT + WT_END <= WS_R3, "weight copies fit");

__device__ __forceinline__ void tr_item(const float* W, int ldw, int col0, int Kv, int Nv, bf16_t* WT, int ldk, int k0, int n0, int drow0, float* scr, int lane) {
    const int nn = lane & 31; const bool nok = (n0 + nn) < Nv;
#pragma unroll 8
    for (int i = 0; i < 32; ++i) { const int kk = 2 * i + (lane >> 5);
        float v = 0.f; if (nok && (k0 + kk) < Kv) v = W[(size_t)(k0 + kk) * ldw + col0 + n0 + nn];
        scr[kk * 33 + nn] = v; }
    asm volatile("s_waitcnt lgkmcnt(0)" ::: "memory");
    const int c = lane & 7;
#pragma unroll
    for (int j = 0; j < 4; ++j) { const int n = (lane >> 3) + 8 * j; const float* s = scr + (8 * c) * 33 + n;
        u32x4 o; o.x = pk2(s[0 * 33], s[1 * 33]); o.y = pk2(s[2 * 33], s[3 * 33]); o.z = pk2(s[4 * 33], s[5 * 33]); o.w = pk2(s[6 * 33], s[7 * 33]);
        *(u32x4*)(WT + (size_t)(drow0 + n) * ldk + k0 + 8 * c) = o; }
    asm volatile("s_waitcnt lgkmcnt(0)" ::: "memory");
}
__device__ __forceinline__ void phase_weights(const Params& p, int l, float* lds, Ctx cx) { const int wid = cx.wid, BID = cx.bid, NBLK = cx.nblk; (void)wid; (void)BID; (void)NBLK;
    const int lane = lane_id_opaque(), wave = wid, gw = BID * NWAVES + wave, NGW = NBLK * NWAVES;
    float* scr = lds + wave * (64 * 33);
    unsigned char* wt = p.ws + WS_WT;
    constexpr int I_IN1 = 16 * 120, I_G = 16 * 96, I_P = 6 * 32, I_O = 16 * 32, I_UP = 16 * 176, I_DN = 44 * 32;
    constexpr int NITEMS = I_IN1 + I_G + 3 * I_P + I_O + I_UP + I_DN;
    const float* w_in = p.w_in + (size_t)l * DM * D_IN;
    for (int it = gw; it < NITEMS; it += NGW) {
        int r = it;
        if (r < I_IN1) { const int kb = r / 120, nb = r % 120; tr_item(w_in, D_IN, 0, 1024, NQ1, (bf16_t*)(wt + WT_IN1), 1024, kb * 64, nb * 32, nb * 32, scr, lane); continue; } r -= I_IN1;
        if (r < I_G) { const int kb = r / 96, nb = r % 96; tr_item(w_in, D_IN, NQ1, 1024, NGATE, (bf16_t*)(wt + WT_G), 1024, kb * 64, nb * 32, nb * 32, scr, lane); continue; } r -= I_G;
        if (r < 3 * I_P) { const int br = r / I_P, q = r % I_P, kb = q / 32, nb = q % 32;
            const float* W = br == 0 ? p.w_proj_sb + (size_t)l * 384 * DM : br == 1 ? p.w_proj_mb + (size_t)l * 320 * DM : p.w_proj_ds + (size_t)l * 320 * DM;
            tr_item(W, DM, 0, br == 0 ? 384 : 320, DM, (bf16_t*)(wt + WT_PROJ) + (size_t)br * 1024 * 384, 384, kb * 64, nb * 32, nb * 32, scr, lane); continue; } r -= 3 * I_P;
        if (r < I_O) { const int kb = r / 32, nb = r % 32; tr_item(p.w_o + (size_t)l * DM * DM, DM, 0, 1024, DM, (bf16_t*)(wt + WT_O), 1024, kb * 64, nb * 32, nb * 32, scr, lane); continue; } r -= I_O;
        if (r < I_UP) { const int kb = r / 176, nb = r % 176, n0 = nb * 32, bj = n0 / DFF, rr = n0 % DFF, drow0 = 256 * (rr / 128) + 128 * bj + (rr % 128);
            tr_item(p.w_up + (size_t)l * DM * 2 * DFF, 2 * DFF, 0, 1024, 2 * DFF, (bf16_t*)(wt + WT_UP), 1024, kb * 64, n0, drow0, scr, lane); continue; } r -= I_UP;
        { const int kb = r / 32, nb = r % 32; tr_item(p.w_down + (size_t)l * DFF * DM, DM, 0, DFF, DM, (bf16_t*)(wt + WT_DOWN), DFF, kb * 64, nb * 32, nb * 32, scr, lane); }
    }
}

#ifndef ATTN_FAST
#define ATTN_FAST 7
#endif
#ifndef FASTMASK
#define FASTMASK 63
#endif
#define GRID_SYNC() do { asm volatile("s_waitcnt vmcnt(0) lgkmcnt(0)" ::: "memory"); grid.sync(); __builtin_amdgcn_fence(__ATOMIC_ACQUIRE, "agent"); asm volatile("s_waitcnt vmcnt(0)" ::: "memory"); } while (0)
constexpr int RING_BYTES = 131072, LDS_BYTES = 147456;
typedef const __attribute__((address_space(4))) Params* kparams_t;
__device__ __forceinline__ Params load_params(kparams_t pp) {
    Params p; p.x = pp->x; p.c = pp->c; p.w_ada = pp->w_ada; p.b_ada = pp->b_ada; p.g_pre_mix = pp->g_pre_mix; p.g_post_mix = pp->g_post_mix; p.w_in = pp->w_in; p.b_gate = pp->b_gate;
    p.w_proj_sb = pp->w_proj_sb; p.w_proj_mb = pp->w_proj_mb; p.w_proj_ds = pp->w_proj_ds; p.w_o = pp->w_o; p.g_pre_ffn = pp->g_pre_ffn; p.g_post_ffn = pp->g_post_ffn; p.w_up = pp->w_up; p.w_down = pp->w_down;
    p.out = pp->out; p.ws = pp->ws; p.mask = pp->mask; return p;
}
__device__ __forceinline__ bool phase_on(int k) { kparams_t pp = (kparams_t)__builtin_amdgcn_kernarg_segment_ptr(); asm volatile("" : "+s"(pp)); unsigned long long m = pp->mask; asm volatile("" : "+s"(m)); return (m >> k) & 1ull; }
#define PHASE_BEGIN Ctx cx; { int b_ = blockIdx.x, g_ = gridDim.x, w_ = wid; asm volatile("" : "+s"(b_), "+s"(g_), "+s"(w_)); cx.bid = b_; cx.nblk = g_; cx.wid = w_; } kparams_t pp_ = (kparams_t)__builtin_amdgcn_kernarg_segment_ptr(); asm volatile("" : "+s"(pp_)); const Params p = load_params(pp_); \
    unsigned char* ws_ = p.ws; bf16_t* R1 = (bf16_t*)(ws_ + WS_R1); bf16_t* R2 = (bf16_t*)(ws_ + WS_R2); bf16_t* R3 = (bf16_t*)(ws_ + WS_R3); unsigned char* wt = ws_ + WS_WT; (void)R1; (void)R2; (void)R3; (void)wt;
#define PHX(k) phase_on(k)
#define PH(k) phase_on((k) + 16 * l)
template <int l> __device__ __forceinline__ void layer_body(cg::grid_group& grid, float* lds, PG8_LAS unsigned char* lds3, int wid) {
        unsigned char* lds_raw_ = (unsigned char*)lds;
        if (PH(0)) {
            PHASE_BEGIN
            if constexpr ((FASTMASK >> 0) & 1) {
            pg8::Gemm g{R3, (const bf16_t*)(wt + WT_IN1), T, QKV_PITCH, DM, DM}; pg8::StaticOrder S; S.init(T, QKV_PITCH, cx.nblk, cx.bid);
            pg8::EpiBf16 E{R1, QKV_PITCH};
            pg8::gemm_phase<pg8::EpiBf16, pg8::StaticOrder, true, true>(lds3, g, S, E, cx.wid);
            } else {
                NGemm<1> g; g.s[0] = NSeg{R3, DM, p.w_in + (size_t)l * DM * D_IN, D_IN, DM}; g.M = T; g.N = NQ1;
                NEpi e{R1, QKV_PITCH, nullptr, nullptr};
                naive_gemm<1, 0>(lds, g, e, cx);
            }
        }
        GRID_SYNC();
        if (PH(1)) { PHASE_BEGIN phase_kmean(p, cx); phase_dsa_topk(p, lds, cx); }
        if (PH(2)) { PHASE_BEGIN if constexpr (!(ATTN_FAST & 1)) phase_naive_attn<0>(p, cx); phase_zero_pad(p, cx); if constexpr (ATTN_FAST & 1) { __syncthreads(); phase_fast_attn<1>(p, lds_raw_, cx); } }
        GRID_SYNC();
        if (PH(3)) { PHASE_BEGIN if constexpr (!(ATTN_FAST & 2)) phase_naive_attn<1>(p, cx); }
        if (PH(3)) { PHASE_BEGIN if constexpr (!(ATTN_FAST & 4)) phase_naive_attn<2>(p, cx); }
        if (PH(3)) { PHASE_BEGIN if constexpr ((ATTN_FAST & 6) != 0) phase_fast_attn<(ATTN_FAST & 6)>(p, lds_raw_, cx); }
        GRID_SYNC();
        if (PH(4)) {
            PHASE_BEGIN
            if constexpr ((FASTMASK >> 1) & 1) {
            pg8::Gemm g{R3, (const bf16_t*)(wt + WT_G), T, NGATE, DM, DM}; pg8::StaticOrder S; S.init(T, NGATE, cx.nblk, cx.bid);
            pg8::EpiSigmoid E{R1, NGATE, p.b_gate + l * NGATE};
            pg8::gemm_phase<pg8::EpiSigmoid, pg8::StaticOrder, true, true>(lds3, g, S, E, cx.wid);
            } else {
                NGemm<1> g; g.s[0] = NSeg{R3, DM, p.w_in + (size_t)l * DM * D_IN + NQ1, D_IN, DM}; g.M = T; g.N = NGATE;
                NEpi e{R1, NGATE, p.b_gate + l * NGATE, nullptr};
                naive_gemm<1, 1>(lds, g, e, cx);
            }
        }
        GRID_SYNC();
#pragma unroll
        for (int br = 0; br < 3; ++br) if (PH(5 + br)) {
            PHASE_BEGIN
            if constexpr ((FASTMASK >> 2) & 1) {
            pg8::Gemm g{R2 + br * 384, (const bf16_t*)(wt + WT_PROJ) + (size_t)br * 1024 * 384, T, DM, 384, OC_PITCH}; pg8::StaticOrder S; S.init(T, DM, cx.nblk, cx.bid);
            pg8::EpiGate E{R3, R1, br};
            pg8::gemm_phase<pg8::EpiGate, pg8::StaticOrder, true, true>(lds3, g, S, E, cx.wid);
            asm volatile("s_waitcnt vmcnt(0)" ::: "memory");
            __builtin_amdgcn_fence(__ATOMIC_ACQUIRE, "agent");
            asm volatile("s_waitcnt vmcnt(0)" ::: "memory");
            __syncthreads();
            } else {
                if (br == 0) {
                    NGemm<3> g;
                    g.s[0] = NSeg{R2 + CO_SB, OC_PITCH, p.w_proj_sb + (size_t)l * 384 * DM, DM, 384};
                    g.s[1] = NSeg{R2 + CO_MB, OC_PITCH, p.w_proj_mb + (size_t)l * 320 * DM, DM, 320};
                    g.s[2] = NSeg{R2 + CO_DS, OC_PITCH, p.w_proj_ds + (size_t)l * 320 * DM, DM, 320};
                    g.M = T; g.N = DM;
                    NEpi e{R3, DM, nullptr, R1};
                    naive_gemm<3, 2>(lds, g, e, cx);
                }
            }
        }
        GRID_SYNC();
        if (PH(8)) {
            PHASE_BEGIN
            if constexpr ((FASTMASK >> 3) & 1) {
            pg8::Gemm g{R3, (const bf16_t*)(wt + WT_O), T, DM, DM, DM}; pg8::StaticOrder S; S.init(T, DM, cx.nblk, cx.bid);
            pg8::EpiBf16 E{R2, DM};
            pg8::gemm_phase<pg8::EpiBf16, pg8::StaticOrder, true, true>(lds3, g, S, E, cx.wid);
            } else {
                NGemm<1> g; g.s[0] = NSeg{R3, DM, p.w_o + (size_t)l * DM * DM, DM, DM}; g.M = T; g.N = DM;
                NEpi e{R2, DM, nullptr, nullptr};
                naive_gemm<1, 0>(lds, g, e, cx);
            }
        }
        GRID_SYNC();
        if (PH(9)) { PHASE_BEGIN phase_postnorm(p, l == 0 ? p.x : p.out, p.g_post_mix + l * DM, l, 0, cx); }
        GRID_SYNC();
        if (PH(10)) {
            PHASE_BEGIN
            if constexpr ((FASTMASK >> 4) & 1) {
            pg8::Gemm g{R3, (const bf16_t*)(wt + WT_UP), T, 2 * DFF, DM, DM}; pg8::StaticOrder S; S.init(T, 2 * DFF, cx.nblk, cx.bid);
            pg8::EpiSwiglu E{R1, DFF};
            pg8::gemm_phase<pg8::EpiSwiglu, pg8::StaticOrder, true, true>(lds3, g, S, E, cx.wid);
            } else {
                const float* wu = p.w_up + (size_t)l * DM * 2 * DFF;
                NGemm<2> g; g.s[0] = NSeg{R3, DM, wu, 2 * DFF, DM}; g.s[1] = NSeg{R3, DM, wu + DFF, 2 * DFF, DM}; g.M = T; g.N = DFF;
                NEpi e{R1, DFF, nullptr, nullptr};
                naive_gemm<2, 3>(lds, g, e, cx);
            }
        }
        GRID_SYNC();
        if (PH(11)) {
            PHASE_BEGIN
            if constexpr ((FASTMASK >> 5) & 1) {
            pg8::Gemm g{R1, (const bf16_t*)(wt + WT_DOWN), T, DM, DFF, DFF}; pg8::StaticOrder S; S.init(T, DM, cx.nblk, cx.bid);
            pg8::EpiBf16 E{R2, DM};
            pg8::gemm_phase<pg8::EpiBf16, pg8::StaticOrder, true, true>(lds3, g, S, E, cx.wid);
            } else {
                NGemm<1> g; g.s[0] = NSeg{R1, DFF, p.w_down + (size_t)l * DFF * DM, DM, DFF}; g.M = T; g.N = DM;
                NEpi e{R2, DM, nullptr, nullptr};
                naive_gemm<1, 0>(lds, g, e, cx);
            }
        }
        GRID_SYNC();
        if (PH(12)) { PHASE_BEGIN phase_postnorm(p, p.out, p.g_post_ffn + l * DM, l, 1, cx); }
        if (l + 1 < DEPTH) { if (PH(13)) { PHASE_BEGIN __syncthreads(); phase_weights(p, l + 1, lds, cx); } }
        GRID_SYNC();
    }
__global__ void __launch_bounds__(NTHREADS, 2) mega_fwd(Params p_kernarg) {
    cg::grid_group grid = cg::this_grid();
    const int wid = __builtin_amdgcn_readfirstlane((int)threadIdx.x >> 6);
    extern __shared__ __attribute__((aligned(16))) unsigned char lds_raw[];
    float* lds = (float*)lds_raw;
    PG8_LAS unsigned char* lds3 = (PG8_LAS unsigned char*)lds_raw;
    if (PHX(60)) { PHASE_BEGIN phase_mod(p, lds, cx); __syncthreads(); }
    if (PHX(61)) { PHASE_BEGIN phase_weights(p, 0, lds, cx); }
    GRID_SYNC();
    if (PHX(62)) { PHASE_BEGIN phase_prenorm(p, p.x, p.g_pre_mix, 0, 0, cx); }
    GRID_SYNC();
    layer_body<0>(grid, lds, lds3, wid);
    layer_body<1>(grid, lds, lds3, wid);
}

extern "C" void kernel_launch(void* const* d_in, const int* in_sizes, int n_in, void* d_out, int out_size, void* d_ws, size_t ws_size, hipStream_t stream) {
    static int grid_blocks = 0;
    if (grid_blocks == 0) {
        if (n_in != 16 || out_size != T * DM || ws_size < WS_END) { fprintf(stderr, "kernel_launch: unexpected sizes n_in %d out %d ws %zu\n", n_in, out_size, ws_size); grid_blocks = -1; return; }
        int dev = 0, cus = 0, per_cu = 0;
        (void)hipGetDevice(&dev);
        (void)hipDeviceGetAttribute(&cus, hipDeviceAttributeMultiprocessorCount, dev);
        if (hipFuncSetAttribute((const void*)mega_fwd, hipFuncAttributeMaxDynamicSharedMemorySize, LDS_BYTES) != hipSuccess) { fprintf(stderr, "kernel_launch: hipFuncSetAttribute failed\n"); grid_blocks = -1; return; }
        (void)hipOccupancyMaxActiveBlocksPerMultiprocessor(&per_cu, (const void*)mega_fwd, NTHREADS, LDS_BYTES);
        if (per_cu < 1) { fprintf(stderr, "kernel_launch: occupancy query says %d blocks per CU\n", per_cu); per_cu = 1; }
        if (per_cu > 1) per_cu = 1;
        grid_blocks = cus * per_cu;
        fprintf(stderr, "kernel_launch: cus %d per_cu %d grid %d ws %zu\n", cus, per_cu, grid_blocks, ws_size);
    }
    if (grid_blocks < 0) return;
    Params p{};
    p.x = (const float*)d_in[0]; p.c = (const float*)d_in[1]; p.w_ada = (const float*)d_in[2]; p.b_ada = (const float*)d_in[3];
    p.g_pre_mix = (const float*)d_in[4]; p.g_post_mix = (const float*)d_in[5]; p.w_in = (const float*)d_in[6]; p.b_gate = (const float*)d_in[7];
    p.w_proj_sb = (const float*)d_in[8]; p.w_proj_mb = (const float*)d_in[9]; p.w_proj_ds = (const float*)d_in[10]; p.w_o = (const float*)d_in[11];
    p.g_pre_ffn = (const float*)d_in[12]; p.g_post_ffn = (const float*)d_in[13]; p.w_up = (const float*)d_in[14]; p.w_down = (const float*)d_in[15];
    p.out = (float*)d_out; p.ws = (unsigned char*)d_ws; p.mask = ~0ull;
    void* args[] = {&p};
    hipError_t e = hipLaunchCooperativeKernel((const void*)mega_fwd, dim3(grid_blocks), dim3(NTHREADS), args, LDS_BYTES, stream);
    if (e != hipSuccess) fprintf(stderr, "cooperative launch failed: %s (grid %d)\n", hipGetErrorString(e), grid_blocks);
}
```

```cpp
#include <hip/hip_runtime.h>
#include <hip/hip_cooperative_groups.h>
#include <cstdio>
#include <cstdint>
namespace cg = cooperative_groups;

typedef float f32x4 __attribute__((ext_vector_type(4)));
typedef unsigned u32x4 __attribute__((ext_vector_type(4)));
typedef unsigned u32x2 __attribute__((ext_vector_type(2)));
typedef unsigned short bf16_t;

constexpr int BATCH = 8, SEQ = 2048, DM = 1024, T = BATCH * SEQ, DEPTH = 2;
constexpr int HD = 64, H_SB = 6, H_MB = 5, H_DS = 5;
constexpr int D_IN = 6728, NQ1 = 3656, QKV_PITCH = 3840, NGATE = 3072, DFF = 2816;
constexpr int OC_PITCH = 1152;
constexpr int CQ_SB = 0, CK_SB = 384, CV_SB = 768, CQ_MB = 1152, CK_MB = 1472, CV_MB = 1792, CQ_DS = 2112, CK_DS = 2432, CV_DS = 2752, CQ_IX = 3072, CK_IX = 3584, CW_IX = 3648;
constexpr int CO_SB = 0, CO_MB = 384, CO_DS = 768;
constexpr float RMS_EPS = 1e-6f;
constexpr int NTHREADS = 512, NWAVES = 8;
constexpr int QUEUE_SLOT_OFF = 151552 - 64;

constexpr size_t MiB = 1u << 20;
constexpr size_t WS_CTR = 0;
constexpr size_t WS_MOD = 1 * MiB;
constexpr size_t WS_KMEAN = 1 * MiB + 512 * 1024;
constexpr size_t WS_MASK = 2 * MiB;
constexpr size_t WS_WT = 6 * MiB;
constexpr size_t WS_R3 = 42 * MiB;
constexpr size_t WS_R2 = 74 * MiB;
constexpr size_t WS_R1 = 110 * MiB;
constexpr size_t WS_END = 230 * MiB;

struct Params {
    const float* x; const float* c; const float* w_ada; const float* b_ada; const float* g_pre_mix; const float* g_post_mix;
    const float* w_in; const float* b_gate; const float* w_proj_sb; const float* w_proj_mb; const float* w_proj_ds; const float* w_o;
    const float* g_pre_ffn; const float* g_post_ffn; const float* w_up; const float* w_down;
    float* out; unsigned char* ws; unsigned long long mask;
};

struct Ctx { int bid, nblk, wid; };
__device__ __forceinline__ float bf2f(unsigned short b) { return __uint_as_float((unsigned)b << 16); }
__device__ __forceinline__ float bflo(unsigned w) { return __uint_as_float(w << 16); }
__device__ __forceinline__ float bfhi(unsigned w) { return __uint_as_float(w & 0xffff0000u); }
__device__ __forceinline__ unsigned f2bf(float f) { unsigned u = __float_as_uint(f); return (u + 0x7fffu + ((u >> 16) & 1u)) >> 16; }
__device__ __forceinline__ unsigned pk2(float lo, float hi) { return f2bf(lo) | (f2bf(hi) << 16); }
__device__ __forceinline__ float wave_sum(float v) {
#pragma unroll
    for (int o = 1; o < 64; o <<= 1) v += __shfl_xor(v, o);
    return v;
}
__device__ __forceinline__ int lane_id_opaque() { int l; asm volatile("v_mbcnt_lo_u32_b32 %0, -1, 0\n\tv_mbcnt_hi_u32_b32 %0, -1, %0" : "=v"(l)); return l; }
#define TIDX (wid * 64 + lane_id_opaque())
__device__ __forceinline__ float sigmoidf_(float v) { return 1.f / (1.f + __expf(-v)); }

__device__ __forceinline__ void phase_mod(const Params& p, float* lds, Ctx cx) { const int wid = cx.wid, BID = cx.bid, NBLK = cx.nblk; (void)wid; (void)BID; (void)NBLK;
    float* MOD = (float*)(p.ws + WS_MOD);
    const int tid = TIDX;
    float* cact = lds;
    float* red = lds + 8 * 1024;
    for (int i = tid; i < 8 * 1024; i += NTHREADS) { const float v = p.c[i]; cact[i] = v * sigmoidf_(v); }
    __syncthreads();
    for (int item = BID; item < 2 * 96; item += NBLK) {
        const int l = item / 96, ct = item % 96, kg = tid >> 6, col = ct * 64 + (tid & 63);
        const float* W = p.w_ada + (size_t)l * 1024 * 6144 + col;
        float acc[8];
#pragma unroll
        for (int b = 0; b < 8; ++b) acc[b] = 0.f;
        for (int k = kg; k < 1024; k += 8) {
            const float w = W[(size_t)k * 6144];
#pragma unroll
            for (int b = 0; b < 8; ++b) acc[b] += cact[b * 1024 + k] * w;
        }
#pragma unroll
        for (int b = 0; b < 8; ++b) red[(kg * 8 + b) * 64 + (tid & 63)] = acc[b];
        __syncthreads();
        {
            const int b = tid >> 6, cc = tid & 63;
            float s = 0.f;
#pragma unroll
            for (int g = 0; g < 8; ++g) s += red[(g * 8 + b) * 64 + cc];
            MOD[((size_t)l * 8 + b) * 6144 + ct * 64 + cc] = s + p.b_ada[l * 6144 + ct * 64 + cc];
        }
        __syncthreads();
    }
}

__device__ __forceinline__ void normmod_row(const f32x4 (&v)[4], float rstd, const float* g, const float* sc, const float* sh, bf16_t* orow, int lane) {
#pragma unroll
    for (int j = 0; j < 4; ++j) {
        const int c0 = 4 * lane + 256 * j;
        const f32x4 gg = *(const f32x4*)(g + c0), s1 = *(const f32x4*)(sc + c0), s0 = *(const f32x4*)(sh + c0);
        f32x4 o;
#pragma unroll
        for (int e = 0; e < 4; ++e) o[e] = v[j][e] * rstd * gg[e] * (1.f + s1[e]) + s0[e];
        u32x2 w; w.x = pk2(o[0], o[1]); w.y = pk2(o[2], o[3]);
        *(u32x2*)(orow + c0) = w;
    }
}
__device__ __forceinline__ void phase_prenorm(const Params& p, const float* xin, const float* g, int l, int which, Ctx cx) { const int wid = cx.wid, BID = cx.bid, NBLK = cx.nblk; (void)wid; (void)BID; (void)NBLK;
    const float* MOD = (const float*)(p.ws + WS_MOD) + (size_t)l * 8 * 6144;
    bf16_t* XN = (bf16_t*)(p.ws + WS_R3);
    const int lane = lane_id_opaque(), gw = BID * NWAVES + wid, NGW = NBLK * NWAVES;
    for (int m = gw; m < T; m += NGW) {
        const int b = m / SEQ;
        const f32x4* xr = (const f32x4*)(xin + (size_t)m * DM) + lane;
        f32x4 v[4]; float s = 0.f;
#pragma unroll
        for (int j = 0; j < 4; ++j) { v[j] = xr[64 * j]; s += (v[j][0] * v[j][0] + v[j][1] * v[j][1]) + (v[j][2] * v[j][2] + v[j][3] * v[j][3]); }
        const float rstd = rsqrtf(wave_sum(s) * (1.f / DM) + RMS_EPS);
        const float* mb = MOD + (size_t)b * 6144 + which * 3072;
        normmod_row(v, rstd, g, mb + 1024, mb, XN + (size_t)m * DM, lane);
    }
}
__device__ __forceinline__ void phase_postnorm(const Params& p, const float* xin, const float* gpost, int l, int which, Ctx cx) { const int wid = cx.wid, BID = cx.bid, NBLK = cx.nblk; (void)wid; (void)BID; (void)NBLK;
    const float* MODl = (const float*)(p.ws + WS_MOD) + (size_t)l * 8 * 6144;
    const bf16_t* Y = (const bf16_t*)(p.ws + WS_R2);
    bf16_t* XN = (bf16_t*)(p.ws + WS_R3);
    const int lane = lane_id_opaque(), gw = BID * NWAVES + wid, NGW = NBLK * NWAVES;
    const float* gnext = which == 0 ? p.g_pre_ffn + l * DM : (l + 1 < DEPTH ? p.g_pre_mix + (l + 1) * DM : nullptr);
    for (int m = gw; m < T; m += NGW) {
        const int b = m / SEQ;
        const float* gate = MODl + (size_t)b * 6144 + (which == 0 ? 2048 : 5120);
        f32x4 y[4]; float s = 0.f;
#pragma unroll
        for (int j = 0; j < 4; ++j) {
            const u32x2 w = *(const u32x2*)(Y + (size_t)m * DM + 4 * lane + 256 * j);
            y[j] = (f32x4){bflo(w.x), bfhi(w.x), bflo(w.y), bfhi(w.y)};
            s += (y[j][0] * y[j][0] + y[j][1] * y[j][1]) + (y[j][2] * y[j][2] + y[j][3] * y[j][3]);
        }
        const float rstd = rsqrtf(wave_sum(s) * (1.f / DM) + RMS_EPS);
        f32x4 v[4]; float s2 = 0.f;
#pragma unroll
        for (int j = 0; j < 4; ++j) {
            const int c0 = 4 * lane + 256 * j;
            const f32x4 xi = *(const f32x4*)(xin + (size_t)m * DM + c0), gp = *(const f32x4*)(gpost + c0), gt = *(const f32x4*)(gate + c0);
#pragma unroll
            for (int e = 0; e < 4; ++e) v[j][e] = xi[e] + gt[e] * (y[j][e] * rstd * gp[e]);
            *(f32x4*)(p.out + (size_t)m * DM + c0) = v[j];
            s2 += (v[j][0] * v[j][0] + v[j][1] * v[j][1]) + (v[j][2] * v[j][2] + v[j][3] * v[j][3]);
        }
        if (gnext) {
            const float rstd2 = rsqrtf(wave_sum(s2) * (1.f / DM) + RMS_EPS);
            const float* mb = which == 0 ? MODl + (size_t)b * 6144 + 3072 : MODl + (size_t)8 * 6144 + (size_t)b * 6144;
            normmod_row(v, rstd2, gnext, mb + 1024, mb, XN + (size_t)m * DM, lane);
        }
    }
}

struct NSeg { const bf16_t* A; int lda; const float* W; int ldw; int K; };
template <int NSEG> struct NGemm { NSeg s[NSEG]; int M, N; };
struct NEpi { bf16_t* C; int ldc; const float* bias; const bf16_t* gates; };
template <int NSEG, int EPI> __device__ __forceinline__ void naive_gemm(float* lds, const NGemm<NSEG>& g, const NEpi& e, Ctx cx) { const int wid = cx.wid, BID = cx.bid, NBLK = cx.nblk; (void)wid; (void)BID; (void)NBLK;
    float* As = lds;
    float* Bs = lds + 16 * 68;
    const int tid = TIDX, ty = tid >> 5, tx = tid & 31;
    const int tm = g.M / 64, tn = (g.N + 127) / 128;
    for (int item = BID; item < tm * tn; item += NBLK) {
        const int m0 = (item / tn) * 64, n0 = (item % tn) * 128;
        float acc[NSEG][4][4];
#pragma unroll
        for (int s = 0; s < NSEG; ++s)
#pragma unroll
            for (int i = 0; i < 4; ++i)
#pragma unroll
                for (int j = 0; j < 4; ++j) acc[s][i][j] = 0.f;
#pragma unroll
        for (int s = 0; s < NSEG; ++s) {
            const NSeg sg = g.s[s];
#pragma unroll 1
            for (int k0 = 0; k0 < sg.K; k0 += 16) {
                __syncthreads();
                {
                    const int r = tid >> 3, kq = tid & 7;
                    const unsigned w = *(const unsigned*)(sg.A + (size_t)(m0 + r) * sg.lda + k0 + kq * 2);
                    As[(kq * 2 + 0) * 68 + r] = bflo(w); As[(kq * 2 + 1) * 68 + r] = bfhi(w);
                    const int k = tid >> 5, nq = tid & 31, n = n0 + nq * 4;
                    f32x4 bv = (f32x4){0.f, 0.f, 0.f, 0.f};
                    if (n < g.N) bv = *(const f32x4*)(sg.W + (size_t)(k0 + k) * sg.ldw + n);
                    *(f32x4*)(Bs + k * 132 + nq * 4) = bv;
                }
                __syncthreads();
#pragma unroll 4
                for (int k = 0; k < 16; ++k) {
                    const f32x4 a0 = *(const f32x4*)(As + k * 68 + ty * 4), b = *(const f32x4*)(Bs + k * 132 + tx * 4);
#pragma unroll
                    for (int i = 0; i < 4; ++i)
#pragma unroll
                        for (int j = 0; j < 4; ++j) acc[s][i][j] += a0[i] * b[j];
                }
            }
        }
        const int col = n0 + tx * 4;
        if (col < g.N) {
#pragma unroll
            for (int i = 0; i < 4; ++i) {
                const int row = m0 + ty * 4 + i;
                float o[4];
                if (EPI == 0) {
#pragma unroll
                    for (int j = 0; j < 4; ++j) o[j] = acc[0][i][j];
                } else if (EPI == 1) {
#pragma unroll
                    for (int j = 0; j < 4; ++j) o[j] = sigmoidf_(acc[0][i][j] + e.bias[col + j]);
                } else if (EPI == 2) {
#pragma unroll
                    for (int j = 0; j < 4; ++j) o[j] = 0.f;
#pragma unroll
                    for (int s = 0; s < NSEG; ++s) {
                        const u32x2 gw = *(const u32x2*)(e.gates + (size_t)row * NGATE + s * 1024 + col);
                        o[0] += bflo(gw.x) * acc[s][i][0]; o[1] += bfhi(gw.x) * acc[s][i][1]; o[2] += bflo(gw.y) * acc[s][i][2]; o[3] += bfhi(gw.y) * acc[s][i][3];
                    }
                } else {
#pragma unroll
                    for (int j = 0; j < 4; ++j) { const float gt = acc[0][i][j]; o[j] = gt * sigmoidf_(gt) * acc[NSEG - 1][i][j]; }
                }
                u32x2 w; w.x = pk2(o[0], o[1]); w.y = pk2(o[2], o[3]);
                *(u32x2*)(e.C + (size_t)row * e.ldc + col) = w;
            }
        }
    }
}

__device__ __forceinline__ void phase_kmean(const Params& p, Ctx cx) { const int wid = cx.wid, BID = cx.bid, NBLK = cx.nblk; (void)wid; (void)BID; (void)NBLK;
    const bf16_t* QKV = (const bf16_t*)(p.ws + WS_R1);
    float* KM = (float*)(p.ws + WS_KMEAN);
    const int gt = BID * NTHREADS + TIDX, NT = NBLK * NTHREADS;
    for (int o = gt; o < 8 * 8 * 320; o += NT) {
        const int c = o % 320, n = (o / 320) % 8, b = o / (320 * 8);
        const bf16_t* kp = QKV + (size_t)(b * SEQ + n * 256) * QKV_PITCH + CK_MB + c;
        float s = 0.f;
        for (int r = 0; r < 256; ++r) s += bf2f(kp[(size_t)r * QKV_PITCH]);
        KM[o] = s * (1.f / 256.f);
    }
}

__device__ __forceinline__ unsigned ordkey(float f) { const unsigned u = __float_as_uint(f); return u ^ ((u >> 31) ? 0xffffffffu : 0x80000000u); }
__device__ __forceinline__ void phase_dsa_topk(const Params& p, float* lds, Ctx cx) { const int wid = cx.wid, BID = cx.bid, NBLK = cx.nblk; (void)wid; (void)BID; (void)NBLK;
    const bf16_t* QKV = (const bf16_t*)(p.ws + WS_R1);
    unsigned* MASK = (unsigned*)(p.ws + WS_MASK);
    const int lane = lane_id_opaque(), wave = wid, gw = BID * NWAVES + wave, NGW = NBLK * NWAVES;
    float* qs = lds + wave * 520;
    unsigned* skey = (unsigned*)(lds + 8 * 520) + wave * 2048;
    for (int m = gw; m < T; m += NGW) {
        const int b = m / SEQ, t = m % SEQ;
        const bf16_t* qrow = QKV + (size_t)m * QKV_PITCH;
        {
            const u32x4 w = *(const u32x4*)(qrow + CQ_IX + lane * 8);
            qs[lane * 8 + 0] = bflo(w.x); qs[lane * 8 + 1] = bfhi(w.x); qs[lane * 8 + 2] = bflo(w.y); qs[lane * 8 + 3] = bfhi(w.y);
            qs[lane * 8 + 4] = bflo(w.z); qs[lane * 8 + 5] = bfhi(w.z); qs[lane * 8 + 6] = bflo(w.w); qs[lane * 8 + 7] = bfhi(w.w);
            if (lane < 8) qs[512 + lane] = bf2f(qrow[CW_IX + lane]);
        }
        asm volatile("s_waitcnt lgkmcnt(0)" ::: "memory");
        __builtin_amdgcn_wave_barrier();
        const int ni = (t >> 6) + 1;
#pragma unroll 1
        for (int i = 0; i < ni; ++i) {
            const int s = i * 64 + lane;
            const u32x4* kp = (const u32x4*)(QKV + (size_t)(b * SEQ + s) * QKV_PITCH + CK_IX);
            u32x4 kw[8];
#pragma unroll
            for (int q = 0; q < 8; ++q) kw[q] = kp[q];
            float sc = 0.f;
#pragma unroll 1
            for (int h = 0; h < 8; ++h) {
                float lg = 0.f;
#pragma unroll
                for (int q = 0; q < 8; ++q) {
                    const f32x4 q0 = *(const f32x4*)(qs + h * 64 + q * 8), q1 = *(const f32x4*)(qs + h * 64 + q * 8 + 4);
                    lg += q0[0] * bflo(kw[q].x) + q0[1] * bfhi(kw[q].x) + q0[2] * bflo(kw[q].y) + q0[3] * bfhi(kw[q].y)
                        + q1[0] * bflo(kw[q].z) + q1[1] * bfhi(kw[q].z) + q1[2] * bflo(kw[q].w) + q1[3] * bfhi(kw[q].w);
                }
                sc += qs[512 + h] * fmaxf(lg, 0.f);
            }
            if (sc == 0.f) sc = 0.f;
            skey[s] = (s <= t) ? ordkey(sc) : 0u;
        }
        asm volatile("s_waitcnt lgkmcnt(0)" ::: "memory");
        __builtin_amdgcn_wave_barrier();
        unsigned key[32];
#pragma unroll
        for (int i = 0; i < 32; ++i) key[i] = (i < ni) ? skey[i * 64 + lane] : 0u;
        unsigned w = 0u;
        if (t + 1 <= 256) {
#pragma unroll
            for (int i = 0; i < 32; ++i) { const unsigned long long sb = __ballot(key[i] != 0u); if ((lane >> 1) == i) w = (lane & 1) ? (unsigned)(sb >> 32) : (unsigned)sb; }
        } else {
            unsigned Tk = 0u;
#pragma unroll 1
            for (int bit = 31; bit >= 0; --bit) {
                const unsigned cand = Tk | (1u << bit);
                int cnt = 0;
#pragma unroll
                for (int i = 0; i < 32; ++i) cnt += __popcll(__ballot(key[i] >= cand));
                if (cnt >= 256) Tk = cand;
            }
            int cgt = 0;
#pragma unroll
            for (int i = 0; i < 32; ++i) cgt += __popcll(__ballot(key[i] > Tk));
            int need = 256 - cgt;
#pragma unroll
            for (int i = 0; i < 32; ++i) {
                const unsigned long long gtb = __ballot(key[i] > Tk), eqb = __ballot(key[i] == Tk);
                unsigned long long take = 0ull;
                const int ne = __popcll(eqb);
                if (need > 0 && ne > 0) {
                    if (ne <= need) { take = eqb; need -= ne; }
                    else {
                        unsigned long long rem = eqb;
                        for (int q = 0; q < need; ++q) { const unsigned long long low = rem & (~rem + 1ull); take |= low; rem ^= low; }
                        need = 0;
                    }
                }
                const unsigned long long sb = gtb | take;
                if ((lane >> 1) == i) w = (lane & 1) ? (unsigned)(sb >> 32) : (unsigned)sb;
            }
        }
        MASK[(size_t)m * 64 + lane] = w;
        __builtin_amdgcn_wave_barrier();
    }
}

template <int MODE> __device__ __forceinline__ void naive_attn_item(const Params& p, int b, int h, int qc, int lane) {
    const bf16_t* QKV = (const bf16_t*)(p.ws + WS_R1);
    bf16_t* OC = (bf16_t*)(p.ws + WS_R2);
    constexpr int cq = MODE == 0 ? CQ_SB : MODE == 1 ? CQ_MB : CQ_DS, ck = MODE == 0 ? CK_SB : MODE == 1 ? CK_MB : CK_DS, cv = MODE == 0 ? CV_SB : MODE == 1 ? CV_MB : CV_DS;
    constexpr int co = MODE == 0 ? CO_SB : MODE == 1 ? CO_MB : CO_DS;
    const int t = qc * 64 + lane; const size_t row = (size_t)b * SEQ + t;
    float q[64], acc[64];
    {
        const u32x4* qp = (const u32x4*)(QKV + row * QKV_PITCH + cq + h * 64);
#pragma unroll
        for (int i = 0; i < 8; ++i) { const u32x4 w = qp[i];
            q[i * 8 + 0] = bflo(w.x); q[i * 8 + 1] = bfhi(w.x); q[i * 8 + 2] = bflo(w.y); q[i * 8 + 3] = bfhi(w.y);
            q[i * 8 + 4] = bflo(w.z); q[i * 8 + 5] = bfhi(w.z); q[i * 8 + 6] = bflo(w.w); q[i * 8 + 7] = bfhi(w.w); }
    }
#pragma unroll
    for (int d = 0; d < 64; ++d) acc[d] = 0.f;
    const bf16_t* Kb = QKV + (size_t)b * SEQ * QKV_PITCH + ck + h * 64;
    const bf16_t* Vb = QKV + (size_t)b * SEQ * QKV_PITCH + cv + h * 64;
    const int tmax = qc * 64 + 63;
    float outscale = 1.f;
    if (MODE == 0) {
        float R = 0.f;
        for (int s = tmax - 1; s >= 0; --s) {
            const u32x4* kp = (const u32x4*)(Kb + (size_t)s * QKV_PITCH);
            float z = 0.f;
#pragma unroll
            for (int i = 0; i < 8; ++i) { const u32x4 w = kp[i];
                z += q[i * 8 + 0] * bflo(w.x) + q[i * 8 + 1] * bfhi(w.x) + q[i * 8 + 2] * bflo(w.y) + q[i * 8 + 3] * bfhi(w.y)
                   + q[i * 8 + 4] * bflo(w.z) + q[i * 8 + 5] * bfhi(w.z) + q[i * 8 + 6] * bflo(w.w) + q[i * 8 + 7] * bfhi(w.w); }
            z *= 0.125f;
            const float u = -(fmaxf(z, 0.f) + log1pf(__expf(-fabsf(z))));
            const bool act = s < t;
            const float a = act ? __expf(z + u + R) : 0.f;
            if (act) R += u;
            const u32x4* vp = (const u32x4*)(Vb + (size_t)s * QKV_PITCH);
#pragma unroll
            for (int i = 0; i < 8; ++i) { const u32x4 w = vp[i];
                acc[i * 8 + 0] += a * bflo(w.x); acc[i * 8 + 1] += a * bfhi(w.x); acc[i * 8 + 2] += a * bflo(w.y); acc[i * 8 + 3] += a * bfhi(w.y);
                acc[i * 8 + 4] += a * bflo(w.z); acc[i * 8 + 5] += a * bfhi(w.z); acc[i * 8 + 6] += a * bflo(w.w); acc[i * 8 + 7] += a * bfhi(w.w); }
        }
    } else {
        const float slope = exp2f(-0.8f * (float)(MODE == 1 ? (2 * h + 1) : (2 * h + 2)));
        const int own = t >> 8;
        unsigned selm = 0u;
        if (MODE == 1) {
            const float* KM = (const float*)(p.ws + WS_KMEAN);
            float gate[8];
#pragma unroll
            for (int n = 0; n < 8; ++n) {
                gate[n] = -1e30f;
                if (n < own) {
                    const float* km = KM + (((size_t)b * 8 + n) * 5 + h) * 64;
                    float gsum = 0.f;
#pragma unroll
                    for (int d = 0; d < 64; ++d) gsum += q[d] * km[d];
                    gate[n] = gsum;
                }
            }
#pragma unroll
            for (int r = 0; r < 3; ++r) {
                float best = -3e38f; int bi = -1;
#pragma unroll
                for (int n = 0; n < 8; ++n) if (!((selm >> n) & 1u) && gate[n] > best) { best = gate[n]; bi = n; }
                if (bi >= 0) selm |= 1u << bi;
            }
            selm &= (1u << own) - 1u;
        }
        const unsigned* MASK = (const unsigned*)(p.ws + WS_MASK) + row * 64;
        float mx = -3e38f, l = 0.f;
        unsigned mw = 0u;
        for (int s = 0; s <= tmax; ++s) {
            bool allowed;
            if (MODE == 1) {
                const int n = s >> 8;
                allowed = (n < own) ? ((selm >> n) & 1u) : (s <= t);
            } else {
                if ((s & 31) == 0) mw = MASK[s >> 5];
                allowed = (mw >> (s & 31)) & 1u;
            }
            if (!__any(allowed)) continue;
            const u32x4* kp = (const u32x4*)(Kb + (size_t)s * QKV_PITCH);
            float z = 0.f;
#pragma unroll
            for (int i = 0; i < 8; ++i) { const u32x4 w = kp[i];
                z += q[i * 8 + 0] * bflo(w.x) + q[i * 8 + 1] * bfhi(w.x) + q[i * 8 + 2] * bflo(w.y) + q[i * 8 + 3] * bfhi(w.y)
                   + q[i * 8 + 4] * bflo(w.z) + q[i * 8 + 5] * bfhi(w.z) + q[i * 8 + 6] * bflo(w.w) + q[i * 8 + 7] * bfhi(w.w); }
            const float sc = z * 0.125f - slope * (float)(t - s);
            const float mn = allowed ? fmaxf(mx, sc) : mx;
            const float alpha = __expf(mx - mn);
            const float pp = allowed ? __expf(sc - mn) : 0.f;
            mx = mn; l = l * alpha + pp;
            const u32x4* vp = (const u32x4*)(Vb + (size_t)s * QKV_PITCH);
#pragma unroll
            for (int i = 0; i < 8; ++i) { const u32x4 w = vp[i];
                acc[i * 8 + 0] = acc[i * 8 + 0] * alpha + pp * bflo(w.x); acc[i * 8 + 1] = acc[i * 8 + 1] * alpha + pp * bfhi(w.x);
                acc[i * 8 + 2] = acc[i * 8 + 2] * alpha + pp * bflo(w.y); acc[i * 8 + 3] = acc[i * 8 + 3] * alpha + pp * bfhi(w.y);
                acc[i * 8 + 4] = acc[i * 8 + 4] * alpha + pp * bflo(w.z); acc[i * 8 + 5] = acc[i * 8 + 5] * alpha + pp * bfhi(w.z);
                acc[i * 8 + 6] = acc[i * 8 + 6] * alpha + pp * bflo(w.w); acc[i * 8 + 7] = acc[i * 8 + 7] * alpha + pp * bfhi(w.w); }
        }
        outscale = 1.f / l;
    }
    u32x4* op = (u32x4*)(OC + row * OC_PITCH + co + h * 64);
#pragma unroll
    for (int i = 0; i < 8; ++i) { u32x4 w;
        w.x = pk2(acc[i * 8 + 0] * outscale, acc[i * 8 + 1] * outscale); w.y = pk2(acc[i * 8 + 2] * outscale, acc[i * 8 + 3] * outscale);
        w.z = pk2(acc[i * 8 + 4] * outscale, acc[i * 8 + 5] * outscale); w.w = pk2(acc[i * 8 + 6] * outscale, acc[i * 8 + 7] * outscale);
        op[i] = w; }
}
template <int MODE> __device__ __forceinline__ void phase_naive_attn(const Params& p, Ctx cx) { const int wid = cx.wid, BID = cx.bid, NBLK = cx.nblk; (void)wid; (void)BID; (void)NBLK;
    constexpr int NH = MODE == 0 ? H_SB : 5;
    const int lane = lane_id_opaque(), gw = BID * NWAVES + wid, NGW = NBLK * NWAVES;
    const int nitems = BATCH * NH * 32;
    for (int it = gw; it < nitems; it += NGW) {
        const int qc = 31 - it / (BATCH * NH), bh = it % (BATCH * NH);
        naive_attn_item<MODE>(p, bh / NH, bh % NH, qc, lane);
    }
}
typedef float f32x2g_t __attribute__((ext_vector_type(2))); typedef __bf16 bf16x2g_t __attribute__((ext_vector_type(2)));
__device__ __forceinline__ unsigned cvt_pk(float lo, float hi) { f32x2g_t v = {lo, hi}; bf16x2g_t b = __builtin_convertvector(v, bf16x2g_t); return __builtin_bit_cast(unsigned, b); }
typedef short bf16x8_t __attribute__((ext_vector_type(8)));
typedef float f32x16_t __attribute__((ext_vector_type(16)));
typedef __attribute__((address_space(3))) unsigned char lds_u8;
constexpr int AT_PITCH = 144, AT_KBYTES = 64 * AT_PITCH, AT_BUF = 2 * AT_KBYTES;
constexpr float AT_C1 = 0.125f * 1.4426950408889634f;
__device__ __forceinline__ float fexp2(float x) { return __builtin_amdgcn_exp2f(x); }
__device__ __forceinline__ float flog2(float x) { return __builtin_amdgcn_logf(x); }

template <int MODE> __device__ __forceinline__ void attn_unit(const bf16_t* __restrict__ QKV, bf16_t* __restrict__ OC, const float* __restrict__ KM, const unsigned* __restrict__ MASK,
                                                              int b, int h, int qb, lds_u8* lds, int wid, int lane) {
    constexpr int cq = MODE == 0 ? CQ_SB : MODE == 1 ? CQ_MB : CQ_DS, ck = MODE == 0 ? CK_SB : MODE == 1 ? CK_MB : CK_DS, cv = MODE == 0 ? CV_SB : MODE == 1 ? CV_MB : CV_DS;
    constexpr int co = MODE == 0 ? CO_SB : MODE == 1 ? CO_MB : CO_DS;
    const int c = lane & 31, hh = lane >> 5, tid = wid * 64 + lane;
    const int q0 = qb * 256, tq = q0 + 32 * wid + c;
    const size_t rowq = (size_t)b * SEQ + tq;
    bf16x8_t qf[4];
#pragma unroll
    for (int ds = 0; ds < 4; ++ds) qf[ds] = *(const bf16x8_t*)(QKV + rowq * QKV_PITCH + cq + h * 64 + ds * 16 + hh * 8);
    float slope2 = 0.f; unsigned selm = 0u;
    if (MODE != 0) slope2 = exp2f(-0.8f * (float)(MODE == 1 ? (2 * h + 1) : (2 * h + 2))) * 1.4426950408889634f;
    if (MODE == 1) {
        float gate[8];
#pragma unroll
        for (int n = 0; n < 8; ++n) {
            gate[n] = -1e30f;
            if (n < qb) {
                const float* km = KM + (((size_t)b * 8 + n) * 5 + h) * 64 + hh * 8;
                float gs = 0.f;
#pragma unroll
                for (int ds = 0; ds < 4; ++ds) {
                    const f32x4 k0 = *(const f32x4*)(km + ds * 16), k1 = *(const f32x4*)(km + ds * 16 + 4);
                    const bf16x8_t qv = qf[ds];
                    gs += bf2f((unsigned short)qv[0]) * k0[0] + bf2f((unsigned short)qv[1]) * k0[1] + bf2f((unsigned short)qv[2]) * k0[2] + bf2f((unsigned short)qv[3]) * k0[3]
                        + bf2f((unsigned short)qv[4]) * k1[0] + bf2f((unsigned short)qv[5]) * k1[1] + bf2f((unsigned short)qv[6]) * k1[2] + bf2f((unsigned short)qv[7]) * k1[3];
                }
                gs += __shfl_xor(gs, 32);
                gate[n] = gs;
            }
        }
#pragma unroll
        for (int r = 0; r < 3; ++r) {
            float best = -3e38f; int bi = -1;
#pragma unroll
            for (int n = 0; n < 8; ++n) if (!((selm >> n) & 1u) && gate[n] > best) { best = gate[n]; bi = n; }
            if (bi >= 0) selm |= 1u << bi;
        }
        selm &= (1u << qb) - 1u;
    }
    f32x16_t o0, o1;
#pragma unroll
    for (int i = 0; i < 16; ++i) { o0[i] = 0.f; o1[i] = 0.f; }
    float m = -3e38f, l = 0.f, R = 0.f;
    const int jmax = 4 * qb + 3, jw = (q0 + 32 * wid + 31) >> 6;
    const bool isv = tid < 256;
    const int vchunk = (tid >> 5) & 7, vrp = tid & 31, krow = (tid & 255) >> 2, kcp = tid & 3;
    const bf16_t* gsrc0; const bf16_t* gsrc1;
    if (isv) { gsrc0 = QKV + ((size_t)b * SEQ + 2 * vrp) * QKV_PITCH + cv + h * 64 + vchunk * 8; gsrc1 = gsrc0 + QKV_PITCH; }
    else { gsrc0 = QKV + ((size_t)b * SEQ + krow) * QKV_PITCH + ck + h * 64 + kcp * 16; gsrc1 = gsrc0 + 8; }
    const int rho = c, kperm = 16 * ((rho >> 2) & 1) + (rho & 3) + 4 * (rho >> 3);
    const int kfoff = kperm * AT_PITCH + hh * 16;
    const int vfoff = AT_KBYTES + c * AT_PITCH + hh * 32;
    const unsigned* mrow = MASK + rowq * 64;
    u32x4 st0, st1; u32x2 mwn = (u32x2){0u, 0u}, mwc = (u32x2){0u, 0u};
#define AT_LOAD(j) do { st0 = *(const u32x4*)(gsrc0 + (size_t)(j) * 64 * QKV_PITCH); st1 = *(const u32x4*)(gsrc1 + (size_t)(j) * 64 * QKV_PITCH); if (MODE == 2) mwn = *(const u32x2*)(mrow + 2 * (j)); } while (0)
#define AT_STORE(bufi) do { lds_u8* bb = lds + (bufi) * AT_BUF; \
        if (isv) { lds_u8* vb = bb + AT_KBYTES + (vchunk * 8) * AT_PITCH + vrp * 4; \
            *(__attribute__((address_space(3))) unsigned*)(vb + 0 * AT_PITCH) = (st0.x & 0xffffu) | (st1.x << 16); *(__attribute__((address_space(3))) unsigned*)(vb + 1 * AT_PITCH) = (st0.x >> 16) | (st1.x & 0xffff0000u); \
            *(__attribute__((address_space(3))) unsigned*)(vb + 2 * AT_PITCH) = (st0.y & 0xffffu) | (st1.y << 16); *(__attribute__((address_space(3))) unsigned*)(vb + 3 * AT_PITCH) = (st0.y >> 16) | (st1.y & 0xffff0000u); \
            *(__attribute__((address_space(3))) unsigned*)(vb + 4 * AT_PITCH) = (st0.z & 0xffffu) | (st1.z << 16); *(__attribute__((address_space(3))) unsigned*)(vb + 5 * AT_PITCH) = (st0.z >> 16) | (st1.z & 0xffff0000u); \
            *(__attribute__((address_space(3))) unsigned*)(vb + 6 * AT_PITCH) = (st0.w & 0xffffu) | (st1.w << 16); *(__attribute__((address_space(3))) unsigned*)(vb + 7 * AT_PITCH) = (st0.w >> 16) | (st1.w & 0xffff0000u); } \
        else { lds_u8* kb_ = bb + krow * AT_PITCH + kcp * 32; *(__attribute__((address_space(3))) u32x4*)(kb_) = st0; *(__attribute__((address_space(3))) u32x4*)(kb_ + 16) = st1; } } while (0)
    AT_LOAD(jmax); AT_STORE(0); mwc = mwn;
    __syncthreads();
    for (int j = jmax; j >= 0; --j) {
        const int bufi = (jmax - j) & 1;
        if (j > 0) AT_LOAD(j - 1);
        if (j <= jw) {
            const lds_u8* bb = lds + bufi * AT_BUF;
#pragma unroll
            for (int s2 = 1; s2 >= 0; --s2) {
                const int kb = 64 * j + 32 * s2;
                if (kb > q0 + 32 * wid + 31) continue;
                f32x16_t S;
#pragma unroll
                for (int i = 0; i < 16; ++i) S[i] = 0.f;
#pragma unroll
                for (int ds = 0; ds < 4; ++ds) {
                    const bf16x8_t kf = *(const __attribute__((address_space(3))) bf16x8_t*)(bb + kfoff + s2 * 32 * AT_PITCH + ds * 32);
                    S = __builtin_amdgcn_mfma_f32_32x32x16_bf16(kf, qf[ds], S, 0, 0, 0);
                }
                unsigned vm;
                const int k0 = kb + 16 * hh;
                if (MODE == 0) { int nv = tq - k0; nv = nv < 0 ? 0 : (nv > 16 ? 16 : nv); vm = (1u << nv) - 1u; }
                else if (MODE == 1) { if (j >= 4 * qb) { int nv = tq - k0 + 1; nv = nv < 0 ? 0 : (nv > 16 ? 16 : nv); vm = (1u << nv) - 1u; } else vm = ((selm >> (j >> 2)) & 1u) ? 0xffffu : 0u; }
                else { vm = ((s2 ? mwc.y : mwc.x) >> (16 * hh)) & 0xffffu; }
                const bool allv = __ballot(vm != 0xffffu) == 0ull;
                float P[16];
                if (MODE == 0) {
                    float zs[16], cs[16];
#pragma unroll
                    for (int i = 0; i < 16; ++i) {
                        const float zl = S[i] * AT_C1;
                        float sp = fmaxf(zl, 0.f) + flog2(1.f + fexp2(-fabsf(zl)));
                        if (!allv) sp = ((vm >> i) & 1u) ? sp : 0.f;
                        zs[i] = zl; cs[i] = sp;
                    }
                    float run = 0.f;
#pragma unroll
                    for (int i = 15; i >= 0; --i) { run += cs[i]; cs[i] = run; }
                    const float other = __shfl_xor(run, 32);
                    const float base = R + (hh == 0 ? other : 0.f);
#pragma unroll
                    for (int i = 0; i < 16; ++i) { float a = fexp2(zs[i] - (base + cs[i])); if (!allv) a = ((vm >> i) & 1u) ? a : 0.f; P[i] = a; }
                    R += run + other;
                } else {
                    const float bias0 = slope2 * (float)(k0 - tq);
                    float mloc = -3e38f;
#pragma unroll
                    for (int i = 0; i < 16; ++i) { float s = S[i] * AT_C1 + (bias0 + slope2 * (float)i); if (!allv) s = ((vm >> i) & 1u) ? s : -3e38f; P[i] = s; mloc = fmaxf(mloc, s); }
                    mloc = fmaxf(mloc, __shfl_xor(mloc, 32));
                    const float mnew = fmaxf(m, mloc);
                    if (__ballot(mnew > m) != 0ull) {
                        const float alpha = fexp2(m - mnew);
#pragma unroll
                        for (int i = 0; i < 16; ++i) { o0[i] *= alpha; o1[i] *= alpha; }
                        l *= alpha;
                    }
                    m = mnew;
#pragma unroll
                    for (int i = 0; i < 16; ++i) { float pe = fexp2(P[i] - mnew); if (!allv) pe = ((vm >> i) & 1u) ? pe : 0.f; l += pe; P[i] = pe; }
                }
                bf16x8_t pf0, pf1;
                { u32x4 w0, w1;
                  w0.x = cvt_pk(P[0], P[1]); w0.y = cvt_pk(P[2], P[3]); w0.z = cvt_pk(P[4], P[5]); w0.w = cvt_pk(P[6], P[7]);
                  w1.x = cvt_pk(P[8], P[9]); w1.y = cvt_pk(P[10], P[11]); w1.z = cvt_pk(P[12], P[13]); w1.w = cvt_pk(P[14], P[15]);
                  pf0 = __builtin_bit_cast(bf16x8_t, w0); pf1 = __builtin_bit_cast(bf16x8_t, w1); }
                {
                    const bf16x8_t v00 = *(const __attribute__((address_space(3))) bf16x8_t*)(bb + vfoff + s2 * 64);
                    const bf16x8_t v01 = *(const __attribute__((address_space(3))) bf16x8_t*)(bb + vfoff + s2 * 64 + 16);
                    const bf16x8_t v10 = *(const __attribute__((address_space(3))) bf16x8_t*)(bb + vfoff + 32 * AT_PITCH + s2 * 64);
                    const bf16x8_t v11 = *(const __attribute__((address_space(3))) bf16x8_t*)(bb + vfoff + 32 * AT_PITCH + s2 * 64 + 16);
                    o0 = __builtin_amdgcn_mfma_f32_32x32x16_bf16(v00, pf0, o0, 0, 0, 0);
                    o0 = __builtin_amdgcn_mfma_f32_32x32x16_bf16(v01, pf1, o0, 0, 0, 0);
                    o1 = __builtin_amdgcn_mfma_f32_32x32x16_bf16(v10, pf0, o1, 0, 0, 0);
                    o1 = __builtin_amdgcn_mfma_f32_32x32x16_bf16(v11, pf1, o1, 0, 0, 0);
                }
            }
        }
        if (j > 0) AT_STORE(bufi ^ 1);
        mwc = mwn;
        __syncthreads();
    }
#undef AT_LOAD
#undef AT_STORE
    float sc = 1.f;
    if (MODE != 0) { l += __shfl_xor(l, 32); sc = 1.f / l; }
    bf16_t* orow = OC + rowq * OC_PITCH + co + h * 64 + 4 * hh;
#pragma unroll
    for (int g = 0; g < 4; ++g) {
        u32x2 w; w.x = cvt_pk(o0[4 * g] * sc, o0[4 * g + 1] * sc); w.y = cvt_pk(o0[4 * g + 2] * sc, o0[4 * g + 3] * sc);
        *(u32x2*)(orow + 8 * g) = w;
        u32x2 w2; w2.x = cvt_pk(o1[4 * g] * sc, o1[4 * g + 1] * sc); w2.y = cvt_pk(o1[4 * g + 2] * sc, o1[4 * g + 3] * sc);
        *(u32x2*)(orow + 32 + 8 * g) = w2;
    }
}
template <int MODEMASK> __device__ __forceinline__ void phase_fast_attn(const Params& p, unsigned char* lds_raw, Ctx cx) {
    const bf16_t* QKV = (const bf16_t*)(p.ws + WS_R1); bf16_t* OC = (bf16_t*)(p.ws + WS_R2);
    const float* KM = (const float*)(p.ws + WS_KMEAN); const unsigned* MASK = (const unsigned*)(p.ws + WS_MASK);
    lds_u8* lds = (lds_u8*)lds_raw;
    const int lane = lane_id_opaque();
    constexpr int NBH = ((MODEMASK & 1) ? BATCH * H_SB : 0) + ((MODEMASK & 2) ? BATCH * H_MB : 0) + ((MODEMASK & 4) ? BATCH * H_DS : 0);
    for (int u = cx.bid; u < NBH * 8; u += cx.nblk) {
        const int qb = 7 - u / NBH; int r = u % NBH;
        if (MODEMASK & 1) { if (r < BATCH * H_SB) { attn_unit<0>(QKV, OC, KM, MASK, r / H_SB, r % H_SB, qb, lds, cx.wid, lane); continue; } r -= BATCH * H_SB; }
        if (MODEMASK & 2) { if (r < BATCH * H_MB) { attn_unit<1>(QKV, OC, KM, MASK, r / H_MB, r % H_MB, qb, lds, cx.wid, lane); continue; } r -= BATCH * H_MB; }
        if (MODEMASK & 4) { attn_unit<2>(QKV, OC, KM, MASK, r / H_DS, r % H_DS, qb, lds, cx.wid, lane); }
    }
}

typedef float f32x4_t __attribute__((ext_vector_type(4)));
constexpr int TK_QPITCH = 1040, TK_SKPITCH = 8208, TK_SK_OFF = 16 * TK_QPITCH;
constexpr int TK_LDS_END = TK_SK_OFF + 16 * TK_SKPITCH;
__device__ __forceinline__ void topk_select_row(const unsigned (&key)[32], int t, unsigned* mrow, int lane) {
    unsigned w = 0u;
    if (t + 1 <= 256) {
#pragma unroll
        for (int i = 0; i < 32; ++i) { const unsigned long long sb = __ballot(key[i] != 0u); if ((lane >> 1) == i) w = (lane & 1) ? (unsigned)(sb >> 32) : (unsigned)sb; }
    } else {
        unsigned Tk = 0u;
#pragma unroll 1
        for (int bit = 31; bit >= 0; --bit) {
            const unsigned cand = Tk | (1u << bit);
            int cnt = 0;
#pragma unroll
            for (int i = 0; i < 32; ++i) cnt += __popcll(__ballot(key[i] >= cand));
            if (cnt >= 256) Tk = cand;
        }
        int cgt = 0;
#pragma unroll
        for (int i = 0; i < 32; ++i) cgt += __popcll(__ballot(key[i] > Tk));
        int need = 256 - cgt;
#pragma unroll
        for (int i = 0; i < 32; ++i) {
            const unsigned long long gtb = __ballot(key[i] > Tk), eqb = __ballot(key[i] == Tk);
            unsigned long long take = 0ull;
            const int ne = __popcll(eqb);
            if (need > 0 && ne > 0) {
                if (ne <= need) { take = eqb; need -= ne; }
                else { unsigned long long rem = eqb; for (int q = 0; q < need; ++q) { const unsigned long long low = rem & (~rem + 1ull); take |= low; rem ^= low; } need = 0; }
            }
            const unsigned long long sb = gtb | take;
            if ((lane >> 1) == i) w = (lane & 1) ? (unsigned)(sb >> 32) : (unsigned)sb;
        }
    }
    mrow[lane] = w;
}
__device__ __forceinline__ void topk_unit(const bf16_t* __restrict__ QKV, unsigned* __restrict__ MASK, int b, int g, lds_u8* lds, int wid, int lane) {
    const int t0 = 16 * g; const size_t r0 = (size_t)b * SEQ + t0;
    if (t0 + 15 < 256) {
#pragma unroll
        for (int qq = 0; qq < 2; ++qq) { const int q = 2 * wid + qq, t = t0 + q, lo = 32 * lane;
            const unsigned w = (lo + 31 <= t) ? 0xffffffffu : (lo > t ? 0u : ((1u << (t - lo + 1)) - 1u));
            MASK[(r0 + q) * 64 + lane] = w; }
        return;
    }
    const int tid = wid * 64 + lane, qn = lane & 15, kg = lane >> 4;
#pragma unroll
    for (int k = 0; k < 2; ++k) { const int idx = tid + 512 * k, row = idx >> 6, ch = idx & 63;
        *(__attribute__((address_space(3))) u32x4*)(lds + row * TK_QPITCH + ch * 16) = *(const u32x4*)(QKV + (r0 + row) * QKV_PITCH + CQ_IX + ch * 8); }
    float wq[8];
    { const u32x4 w = *(const u32x4*)(QKV + (r0 + qn) * QKV_PITCH + CW_IX);
      wq[0] = bflo(w.x); wq[1] = bfhi(w.x); wq[2] = bflo(w.y); wq[3] = bfhi(w.y); wq[4] = bflo(w.z); wq[5] = bfhi(w.z); wq[6] = bflo(w.w); wq[7] = bfhi(w.w); }
    __syncthreads();
    const int ntiles = g + 1, ntr = (ntiles + 3) & ~3;
    const int tq = t0 + qn;
    for (int kt = wid; kt < ntr; kt += 8) {
        u32x4 outw = (u32x4){0u, 0u, 0u, 0u};
        if (kt < ntiles) {
            const bf16_t* kp = QKV + ((size_t)b * SEQ + 16 * kt + qn) * QKV_PITCH + CK_IX + 8 * kg;
            const bf16x8_t a0 = *(const bf16x8_t*)(kp), a1 = *(const bf16x8_t*)(kp + 32);
            f32x4_t sc = (f32x4_t){0.f, 0.f, 0.f, 0.f};
#pragma unroll
            for (int hd = 0; hd < 8; ++hd) {
                const bf16x8_t b0 = *(const __attribute__((address_space(3))) bf16x8_t*)(lds + qn * TK_QPITCH + (hd * 64 + 8 * kg) * 2);
                const bf16x8_t b1 = *(const __attribute__((address_space(3))) bf16x8_t*)(lds + qn * TK_QPITCH + (hd * 64 + 32 + 8 * kg) * 2);
                f32x4_t acc = (f32x4_t){0.f, 0.f, 0.f, 0.f};
                acc = __builtin_amdgcn_mfma_f32_16x16x32_bf16(a0, b0, acc, 0, 0, 0);
                acc = __builtin_amdgcn_mfma_f32_16x16x32_bf16(a1, b1, acc, 0, 0, 0);
#pragma unroll
                for (int r = 0; r < 4; ++r) sc[r] += wq[hd] * fmaxf(acc[r], 0.f);
            }
            unsigned ok[4];
#pragma unroll
            for (int r = 0; r < 4; ++r) { float s = sc[r]; if (s == 0.f) s = 0.f; ok[r] = (16 * kt + 4 * kg + r <= tq) ? ordkey(s) : 0u; }
            outw = (u32x4){ok[0], ok[1], ok[2], ok[3]};
        }
        *(__attribute__((address_space(3))) u32x4*)(lds + TK_SK_OFF + qn * TK_SKPITCH + (16 * kt + 4 * kg) * 4) = outw;
    }
    __syncthreads();
#pragma unroll 1
    for (int qq = 0; qq < 2; ++qq) {
        const int q = 2 * wid + qq, t = t0 + q, ni = (t >> 6) + 1;
        unsigned key[32];
#pragma unroll
        for (int i = 0; i < 32; ++i) key[i] = (i < ni) ? *(const __attribute__((address_space(3))) unsigned*)(lds + TK_SK_OFF + q * TK_SKPITCH + (i * 64 + lane) * 4) : 0u;
        topk_select_row(key, t, MASK + (r0 + q) * 64, lane);
    }
    __syncthreads();
}
__device__ __forceinline__ void kmean_item(const bf16_t* __restrict__ QKV, float* __restrict__ KM, int item, lds_u8* lds, int wid, int lane) {
    const int h = item % 5, n = (item / 5) % 8, b = item / 40, tid = wid * 64 + lane, c8 = tid & 7, rg = tid >> 3;
    const bf16_t* kp = QKV + ((size_t)b * SEQ + n * 256 + rg) * QKV_PITCH + CK_MB + h * 64 + c8 * 8;
    float a[8];
#pragma unroll
    for (int e = 0; e < 8; ++e) a[e] = 0.f;
#pragma unroll
    for (int r = 0; r < 4; ++r) { const u32x4 w = *(const u32x4*)(kp + (size_t)(64 * r) * QKV_PITCH);
        a[0] += bflo(w.x); a[1] += bfhi(w.x); a[2] += bflo(w.y); a[3] += bfhi(w.y); a[4] += bflo(w.z); a[5] += bfhi(w.z); a[6] += bflo(w.w); a[7] += bfhi(w.w); }
    __attribute__((address_space(3))) float* red = (__attribute__((address_space(3))) float*)lds;
#pragma unroll
    for (int e = 0; e < 8; ++e) red[rg * 65 + c8 * 8 + e] = a[e];
    __syncthreads();
    if (tid < 64) { float s = 0.f;
#pragma unroll 8
        for (int r = 0; r < 64; ++r) s += red[r * 65 + tid];
        KM[(size_t)item * 64 + tid] = s * (1.f / 256.f); }
    __syncthreads();
}
__device__ __forceinline__ int queue_pop(unsigned* ctr, lds_u8* lds, int tid) {
    __attribute__((address_space(3))) volatile int* slot = (__attribute__((address_space(3))) volatile int*)(lds + QUEUE_SLOT_OFF);
    if (tid == 0) *slot = (int)__hip_atomic_fetch_add(ctr, 1u, __ATOMIC_RELAXED, __HIP_MEMORY_SCOPE_AGENT);
    __syncthreads();
    const int u = *slot;
    __syncthreads();
    return u;
}
__device__ __forceinline__ void phase_attn_a(const Params& p, unsigned char* lds_raw, int l, Ctx cx) {
    const bf16_t* QKV = (const bf16_t*)(p.ws + WS_R1); bf16_t* OC = (bf16_t*)(p.ws + WS_R2);
    float* KM = (float*)(p.ws + WS_KMEAN); unsigned* MASK = (unsigned*)(p.ws + WS_MASK);
    unsigned* ctr = (unsigned*)(p.ws + WS_CTR) + 64 * (2 * l);
    lds_u8* lds = (lds_u8*)lds_raw;
    const int lane = lane_id_opaque(), tid = cx.wid * 64 + lane;
    constexpr int N_SB = BATCH * H_SB * 8, N_TK = BATCH * 128, N_KM = 320;
    for (;;) {
        int u = queue_pop(ctr, lds, tid);
        if (u >= N_SB + N_TK + N_KM) break;
        if (u < N_SB) { const int qb = 7 - u / (BATCH * H_SB), r = u % (BATCH * H_SB); attn_unit<0>(QKV, OC, KM, MASK, r / H_SB, r % H_SB, qb, lds, cx.wid, lane); continue; }
        u -= N_SB;
        if (u < N_TK) { const int g = 127 - u / BATCH, b = u % BATCH; topk_unit(QKV, MASK, b, g, lds, cx.wid, lane); continue; }
        u -= N_TK;
        kmean_item(QKV, KM, u, lds, cx.wid, lane);
    }
}
__device__ __forceinline__ void phase_attn_b(const Params& p, unsigned char* lds_raw, int l, Ctx cx) {
    const bf16_t* QKV = (const bf16_t*)(p.ws + WS_R1); bf16_t* OC = (bf16_t*)(p.ws + WS_R2);
    const float* KM = (const float*)(p.ws + WS_KMEAN); const unsigned* MASK = (const unsigned*)(p.ws + WS_MASK);
    unsigned* ctr = (unsigned*)(p.ws + WS_CTR) + 64 * (2 * l + 1);
    lds_u8* lds = (lds_u8*)lds_raw;
    const int lane = lane_id_opaque(), tid = cx.wid * 64 + lane;
    constexpr int NBH = BATCH * (H_MB + H_DS);
    for (;;) {
        const int u = queue_pop(ctr, lds, tid);
        if (u >= NBH * 8) break;
        const int qb = 7 - u / NBH; int r = u % NBH;
        if (r < BATCH * H_MB) { attn_unit<1>(QKV, OC, KM, MASK, r / H_MB, r % H_MB, qb, lds, cx.wid, lane); continue; }
        r -= BATCH * H_MB;
        attn_unit<2>(QKV, OC, KM, MASK, r / H_DS, r % H_DS, qb, lds, cx.wid, lane);
    }
}

__device__ __forceinline__ void phase_zero_pad(const Params& p, Ctx cx) { const int wid = cx.wid, BID = cx.bid, NBLK = cx.nblk; (void)wid; (void)BID; (void)NBLK;
    bf16_t* OC = (bf16_t*)(p.ws + WS_R2);
    const int gt = BID * NTHREADS + TIDX, NT = NBLK * NTHREADS;
    for (int i = gt; i < T * 16; i += NT) {
        const int row = i >> 4, q = i & 15, col = (q < 8 ? 704 : 1088 - 64) + q * 8;
        *(u32x4*)(OC + (size_t)row * OC_PITCH + col) = (u32x4){0u, 0u, 0u, 0u};
    }
}

namespace pg8 {
#define PG8_LAS __attribute__((address_space(3)))
typedef unsigned short bf16_t;
typedef short bf16x8 __attribute__((ext_vector_type(8)));
typedef float f32x4 __attribute__((ext_vector_type(4)));
typedef unsigned u32x4 __attribute__((ext_vector_type(4)));
constexpr int BM = 256, BK = 64, HALF = 128, HTB = HALF * BK * 2  , STAGE_BYTES = 8 * HTB, NXCD = 8, WGM = 8;

__host__ __device__ __forceinline__ int lds_byte(int r, int c) { const int st = (r >> 4) * 2 + (c >> 5), rr = r & 15, cc = c & 31, ob = rr * 64 + cc * 2; return st * 1024 + (ob ^ (((ob >> 9) & 1) << 5)); }
__host__ __device__ __forceinline__ void stage_rc(int b, int& R, int& C) { const int st = b / 1024, sb = b % 1024, swz = sb ^ (((sb >> 9) & 1) << 5); R = (st >> 1) * 16 + swz / 64; C = (st & 1) * 32 + (swz % 64) / 2; }
__host__ __device__ __forceinline__ int perm32(int rho) { const int n = rho >> 4, i = rho & 15; return 8 * (i >> 2) + 4 * n + (i & 3); }

struct Unit { int pm, pn; };
struct Gemm { const bf16_t* A; const bf16_t* Bt; int M, N, K, lda; };

struct StaticOrder {
    int nM, nN, nwg, G, c;
    __host__ __device__ void init(int M, int N, int G_, int c_) { nM = M / BM; nN = N / BM; nwg = nM * nN; G = G_; c = c_; }
    __host__ __device__ bool next(int i, Unit& u) const {
        const long L = (long)i * G + c; if (L >= nwg) return false;
        int wgid = (int)L; { const int q = nwg / NXCD, r = nwg % NXCD, xcd = wgid % NXCD, off = wgid / NXCD; wgid = (xcd < r ? xcd * (q + 1) : r * (q + 1) + (xcd - r) * q) + off; }
        const int nig = WGM * nN, gid = wgid / nig, fm = gid * WGM, gsz = (nM - fm) < WGM ? (nM - fm) : WGM;
        u.pm = fm + ((wgid % nig) % gsz); u.pn = (wgid % nig) / gsz; return true;
    }
    __device__ __forceinline__ void a_ready(const Unit&) const {}
    __device__ __forceinline__ void done(const Unit&) const {}
};


typedef float f32x2_t __attribute__((ext_vector_type(2))); typedef __bf16 bf16x2_t __attribute__((ext_vector_type(2)));
__device__ __forceinline__ unsigned cvt_pk_bf16(float lo, float hi) { f32x2_t v = {lo, hi}; bf16x2_t b = __builtin_convertvector(v, bf16x2_t); return __builtin_bit_cast(unsigned, b); }
struct EpiBf16 {
    static constexpr bool PERM = true, AFTER_DRAIN = false;
    bf16_t* O; int ldc;
    __device__ __forceinline__ void operator()(const f32x4 (&acc)[2][2][4][2], const Unit& u, int wr, int wc, int fr, int fq) const {
        const int row0 = u.pm * BM + wr * 64 + fr, col0 = u.pn * BM + wc * 32 + 8 * fq;
#pragma unroll
        for (int ai = 0; ai < 2; ++ai)
#pragma unroll
            for (int m = 0; m < 4; ++m) { bf16_t* rowp = O + (size_t)(row0 + ai * HALF + m * 16) * ldc + col0;
#pragma unroll
                for (int bj = 0; bj < 2; ++bj) { const f32x4 v0 = acc[ai][bj][m][0], v1 = acc[ai][bj][m][1];
                    u32x4 w; w.x = cvt_pk_bf16(v0[0], v0[1]); w.y = cvt_pk_bf16(v0[2], v0[3]); w.z = cvt_pk_bf16(v1[0], v1[1]); w.w = cvt_pk_bf16(v1[2], v1[3]);
                    *(u32x4*)(rowp + bj * HALF) = w; } }
    }
};

__device__ __forceinline__ float fast_sigmoid(float v) { return __builtin_amdgcn_rcpf(1.f + __builtin_amdgcn_exp2f(-1.4426950408889634f * v)); }
struct EpiSigmoid {
    static constexpr bool PERM = true, AFTER_DRAIN = false;
    bf16_t* O; int ldc; const float* bias;
    __device__ __forceinline__ void operator()(const f32x4 (&acc)[2][2][4][2], const Unit& u, int wr, int wc, int fr, int fq) const {
        const int row0 = u.pm * BM + wr * 64 + fr, col0 = u.pn * BM + wc * 32 + 8 * fq;
        f32x4 bv[2][2];
#pragma unroll
        for (int bj = 0; bj < 2; ++bj)
#pragma unroll
            for (int n = 0; n < 2; ++n) bv[bj][n] = *(const f32x4*)(bias + col0 + bj * HALF + 4 * n);
#pragma unroll
        for (int ai = 0; ai < 2; ++ai)
#pragma unroll
            for (int m = 0; m < 4; ++m) { bf16_t* rowp = O + (size_t)(row0 + ai * HALF + m * 16) * ldc + col0;
#pragma unroll
                for (int bj = 0; bj < 2; ++bj) { const f32x4 v0 = acc[ai][bj][m][0] + bv[bj][0], v1 = acc[ai][bj][m][1] + bv[bj][1];
                    u32x4 w; w.x = cvt_pk_bf16(fast_sigmoid(v0[0]), fast_sigmoid(v0[1])); w.y = cvt_pk_bf16(fast_sigmoid(v0[2]), fast_sigmoid(v0[3]));
                    w.z = cvt_pk_bf16(fast_sigmoid(v1[0]), fast_sigmoid(v1[1])); w.w = cvt_pk_bf16(fast_sigmoid(v1[2]), fast_sigmoid(v1[3]));
                    *(u32x4*)(rowp + bj * HALF) = w; } }
    }
};
struct EpiGate {
    static constexpr bool PERM = true, AFTER_DRAIN = false;
    bf16_t* O; const bf16_t* gates; int br;
    __device__ __forceinline__ void operator()(const f32x4 (&acc)[2][2][4][2], const Unit& u, int wr, int wc, int fr, int fq) const {
        const int row0 = u.pm * BM + wr * 64 + fr, col0 = u.pn * BM + wc * 32 + 8 * fq;
#pragma unroll
        for (int ai = 0; ai < 2; ++ai)
#pragma unroll
            for (int m = 0; m < 4; ++m) { const size_t row = (size_t)(row0 + ai * HALF + m * 16);
#pragma unroll
                for (int bj = 0; bj < 2; ++bj) {
                    const u32x4 gw = *(const u32x4*)(gates + row * 3072 + br * 1024 + col0 + bj * HALF);
                    u32x4 ow = (u32x4){0u, 0u, 0u, 0u};
                    if (br > 0) ow = *(const u32x4*)(O + row * 1024 + col0 + bj * HALF);
                    const f32x4 v0 = acc[ai][bj][m][0], v1 = acc[ai][bj][m][1];
                    u32x4 w;
                    w.x = cvt_pk_bf16(__uint_as_float(ow.x << 16) + __uint_as_float(gw.x << 16) * v0[0], __uint_as_float(ow.x & 0xffff0000u) + __uint_as_float(gw.x & 0xffff0000u) * v0[1]);
                    w.y = cvt_pk_bf16(__uint_as_float(ow.y << 16) + __uint_as_float(gw.y << 16) * v0[2], __uint_as_float(ow.y & 0xffff0000u) + __uint_as_float(gw.y & 0xffff0000u) * v0[3]);
                    w.z = cvt_pk_bf16(__uint_as_float(ow.z << 16) + __uint_as_float(gw.z << 16) * v1[0], __uint_as_float(ow.z & 0xffff0000u) + __uint_as_float(gw.z & 0xffff0000u) * v1[1]);
                    w.w = cvt_pk_bf16(__uint_as_float(ow.w << 16) + __uint_as_float(gw.w << 16) * v1[2], __uint_as_float(ow.w & 0xffff0000u) + __uint_as_float(gw.w & 0xffff0000u) * v1[3]);
                    *(u32x4*)(O + row * 1024 + col0 + bj * HALF) = w; } }
    }
};
struct EpiSwiglu {
    static constexpr bool PERM = true, AFTER_DRAIN = false;
    bf16_t* O; int ldc;
    __device__ __forceinline__ void operator()(const f32x4 (&acc)[2][2][4][2], const Unit& u, int wr, int wc, int fr, int fq) const {
        const int row0 = u.pm * BM + wr * 64 + fr, col0 = u.pn * HALF + wc * 32 + 8 * fq;
#pragma unroll
        for (int ai = 0; ai < 2; ++ai)
#pragma unroll
            for (int m = 0; m < 4; ++m) { bf16_t* rowp = O + (size_t)(row0 + ai * HALF + m * 16) * ldc + col0;
                float o[8];
#pragma unroll
                for (int n = 0; n < 2; ++n)
#pragma unroll
                    for (int e = 0; e < 4; ++e) { const float gt = acc[ai][0][m][n][e]; o[n * 4 + e] = gt * fast_sigmoid(gt) * acc[ai][1][m][n][e]; }
                u32x4 w; w.x = cvt_pk_bf16(o[0], o[1]); w.y = cvt_pk_bf16(o[2], o[3]); w.z = cvt_pk_bf16(o[4], o[5]); w.w = cvt_pk_bf16(o[6], o[7]);
                *(u32x4*)rowp = w; }
    }
};

template <class Epi, class Sched, bool ALIGN_EPI = false, bool SP2 = false>
__device__ __forceinline__ void gemm_phase(PG8_LAS unsigned char* lds, const Gemm g, const Sched& S, const Epi& E, int wid_in) {
    const int wid = wid_in, lane = lane_id_opaque(), tid = wid * 64 + lane, wr = wid >> 2, wc = wid & 3, fr = lane & 15, fq = lane >> 4;
    const int K = g.K, nt = K / BK;
    unsigned voffA[2], voffB[2];
#pragma unroll
    for (int i = 0; i < 2; ++i) { int R, C; stage_rc(tid * 16 + i * 8192, R, C); const int Rb = Epi::PERM ? ((R & ~31) + perm32(R & 31)) : R;
        voffA[i] = (unsigned)(R * g.lda + C) * 2u; voffB[i] = (unsigned)(Rb * K + C) * 2u; }
    const size_t kstep = (size_t)(BK * 2);
    const size_t hstepA = (size_t)HALF * g.lda * 2, hstepB = (size_t)HALF * K * 2;
    const size_t tstepA = 2 * hstepA, tstepB = 2 * hstepB;
    const unsigned ldsw = (unsigned)wid * 1024u;
    const int aoff = lds_byte(wr * 64 + fr, fq * 8), boff = lds_byte(wc * 32 + fr, fq * 8);
#define PG8_SA(b, h) (((b) * 2 + (h)) * HTB)
#define PG8_SB(b, h) ((4 + (b) * 2 + (h)) * HTB)
#define PG8_STAGE(bufoff, gbase, voff) do { _Pragma("unroll") for (int _i = 0; _i < 2; ++_i) \
        __builtin_amdgcn_global_load_lds((const unsigned*)((const char*)(gbase) + (voff)[_i]), (PG8_LAS unsigned*)(lds + (bufoff) + ldsw + _i * 8192), 16, 0, 0); } while (0)
#define PG8_LDA(dst, b, h) do { _Pragma("unroll") for (int m = 0; m < 4; ++m) _Pragma("unroll") for (int k = 0; k < 2; ++k) dst[m][k] = *(const PG8_LAS bf16x8*)(lds + PG8_SA(b, h) + aoff + m * 2048 + k * 1024); } while (0)
#define PG8_LDB(dst, b, h) do { _Pragma("unroll") for (int n = 0; n < 2; ++n) _Pragma("unroll") for (int k = 0; k < 2; ++k) dst[n][k] = *(const PG8_LAS bf16x8*)(lds + PG8_SB(b, h) + boff + n * 2048 + k * 1024); } while (0)
#define PG8_MMA(ai, bj, At, Bt) do { __builtin_amdgcn_s_setprio(1); _Pragma("unroll") for (int m = 0; m < 4; ++m) _Pragma("unroll") for (int n = 0; n < 2; ++n) _Pragma("unroll") for (int k = 0; k < 2; ++k) \
        acc[ai][bj][m][n] = __builtin_amdgcn_mfma_f32_16x16x32_bf16(Bt[n][k], At[m][k], acc[ai][bj][m][n], 0, 0, 0); __builtin_amdgcn_s_setprio(0); } while (0)
#define PG8_WAIT_V(n) asm volatile("s_waitcnt vmcnt(" #n ")" ::: "memory")
#define PG8_WAIT_L(n) asm volatile("s_waitcnt lgkmcnt(" #n ")" ::: "memory")
#define PG8_BAR __builtin_amdgcn_s_barrier()
#define PG8_SCHED __builtin_amdgcn_sched_barrier(0)
    Unit cur, nxt; int ui = 0;
    if (!S.next(0, cur)) return;
    f32x4 acc[2][2][4][2];
#pragma unroll
    for (int a = 0; a < 2; ++a)
#pragma unroll
        for (int b = 0; b < 2; ++b)
#pragma unroll
            for (int m = 0; m < 4; ++m)
#pragma unroll
                for (int n = 0; n < 2; ++n) acc[a][b][m][n] = (f32x4){0.f, 0.f, 0.f, 0.f};
    bf16x8 At[4][2], B0[2][2], B1[2][2];
    const char* cA = (const char*)g.A + (size_t)cur.pm * tstepA; const char* cB = (const char*)g.Bt + (size_t)cur.pn * tstepB;
    S.a_ready(cur);
    if constexpr (SP2) {
        PG8_STAGE(PG8_SB(0, 0), cB, voffB); PG8_STAGE(PG8_SB(0, 1), cB + hstepB, voffB); PG8_STAGE(PG8_SA(0, 0), cA, voffA); PG8_STAGE(PG8_SA(0, 1), cA + hstepA, voffA);
        if (wr == 1) PG8_BAR;
        PG8_WAIT_V(2); PG8_BAR;
        PG8_STAGE(PG8_SB(1, 0), cB + kstep, voffB); PG8_STAGE(PG8_SA(1, 0), cA + kstep, voffA); PG8_STAGE(PG8_SB(1, 1), cB + hstepB + kstep, voffB);
        PG8_WAIT_V(6); PG8_BAR;
    } else {
        PG8_STAGE(PG8_SB(0, 0), cB, voffB); PG8_STAGE(PG8_SA(0, 0), cA, voffA); PG8_STAGE(PG8_SB(0, 1), cB + hstepB, voffB); PG8_STAGE(PG8_SA(0, 1), cA + hstepA, voffA);
        if (wr == 1) PG8_BAR;
        PG8_WAIT_V(4); PG8_BAR;
        PG8_STAGE(PG8_SB(1, 0), cB + kstep, voffB); PG8_STAGE(PG8_SA(1, 0), cA + kstep, voffA); PG8_STAGE(PG8_SB(1, 1), cB + hstepB + kstep, voffB);
        PG8_WAIT_V(6); PG8_BAR;
    }
    for (;;) {
        const bool has_next = S.next(ui + 1, nxt);
        const char* nA = has_next ? (const char*)g.A + (size_t)nxt.pm * tstepA : cA; const char* nB = has_next ? (const char*)g.Bt + (size_t)nxt.pn * tstepB : cB;
        for (int t = 0; t < nt; t += 2) {
            const bool last = (t == nt - 2);
            const char* a1 = cA + (size_t)(t + 1) * kstep;
            const char* a2 = last ? nA : cA + (size_t)(t + 2) * kstep; const char* b2 = last ? nB : cB + (size_t)(t + 2) * kstep;
            const char* a3 = a2 + kstep; const char* b3 = b2 + kstep;
            if (last && has_next) S.a_ready(nxt);
            if constexpr (SP2) {
            PG8_LDB(B0, 0, 0); PG8_LDB(B1, 0, 1); PG8_SCHED; PG8_LDA(At, 0, 0); PG8_STAGE(PG8_SA(1, 1), a1 + hstepA, voffA);
            PG8_WAIT_V(8); PG8_WAIT_L(0); PG8_BAR; PG8_MMA(0, 0, At, B0); PG8_MMA(0, 1, At, B1); PG8_BAR; PG8_SCHED;
            PG8_LDA(At, 0, 1); PG8_STAGE(PG8_SB(0, 0), b2, voffB); PG8_STAGE(PG8_SB(0, 1), b2 + hstepB, voffB); PG8_STAGE(PG8_SA(0, 0), a2, voffA);
            PG8_WAIT_V(8); PG8_WAIT_L(0); PG8_BAR; PG8_MMA(1, 0, At, B0); PG8_MMA(1, 1, At, B1); PG8_BAR; PG8_SCHED;
            PG8_LDB(B0, 1, 0); PG8_LDB(B1, 1, 1); PG8_SCHED; PG8_LDA(At, 1, 0); PG8_STAGE(PG8_SA(0, 1), a2 + hstepA, voffA);
            PG8_WAIT_V(8); PG8_WAIT_L(0); PG8_BAR; PG8_MMA(0, 0, At, B0); PG8_MMA(0, 1, At, B1); PG8_BAR; PG8_SCHED;
            PG8_LDA(At, 1, 1); PG8_STAGE(PG8_SB(1, 0), b3, voffB); PG8_STAGE(PG8_SB(1, 1), b3 + hstepB, voffB); PG8_STAGE(PG8_SA(1, 0), a3, voffA);
            PG8_WAIT_V(8); PG8_WAIT_L(0); PG8_BAR; PG8_MMA(1, 0, At, B0); PG8_MMA(1, 1, At, B1); PG8_BAR; PG8_SCHED;
            } else {
            PG8_LDB(B0, 0, 0); PG8_SCHED; PG8_LDA(At, 0, 0); PG8_STAGE(PG8_SA(1, 1), a1 + hstepA, voffA);
            PG8_WAIT_L(8); PG8_BAR; PG8_WAIT_L(0); PG8_MMA(0, 0, At, B0); PG8_BAR; PG8_SCHED;
            PG8_LDB(B1, 0, 1); PG8_STAGE(PG8_SB(0, 0), b2, voffB);
            PG8_BAR; PG8_WAIT_L(0); PG8_MMA(0, 1, At, B1); PG8_BAR;
            PG8_LDA(At, 0, 1); PG8_STAGE(PG8_SA(0, 0), a2, voffA);
            PG8_BAR; PG8_WAIT_L(0); PG8_MMA(1, 0, At, B0); PG8_BAR; PG8_SCHED;
            PG8_STAGE(PG8_SB(0, 1), b2 + hstepB, voffB);
            PG8_WAIT_V(6); PG8_BAR; PG8_MMA(1, 1, At, B1); PG8_BAR;
            PG8_LDB(B0, 1, 0); PG8_SCHED; PG8_LDA(At, 1, 0); PG8_STAGE(PG8_SA(0, 1), a2 + hstepA, voffA);
            PG8_WAIT_L(8); PG8_BAR; PG8_WAIT_L(0); PG8_MMA(0, 0, At, B0); PG8_BAR; PG8_SCHED;
            PG8_LDB(B1, 1, 1); PG8_STAGE(PG8_SB(1, 0), b3, voffB);
            PG8_BAR; PG8_WAIT_L(0); PG8_MMA(0, 1, At, B1); PG8_BAR;
            PG8_LDA(At, 1, 1); PG8_STAGE(PG8_SA(1, 0), a3, voffA);
            PG8_BAR; PG8_WAIT_L(0); PG8_MMA(1, 0, At, B0); PG8_BAR; PG8_SCHED;
            PG8_STAGE(PG8_SB(1, 1), b3 + hstepB, voffB);
            PG8_WAIT_V(6); PG8_BAR; PG8_MMA(1, 1, At, B1); PG8_BAR;
            }
        }
        if constexpr (ALIGN_EPI) { if (wr == 0) PG8_BAR; }
        if constexpr (!Epi::AFTER_DRAIN) { const int le_ = lane_id_opaque(); E(acc, cur, wr, wc, le_ & 15, le_ >> 4); S.done(cur); }
        if (!has_next) break;
#pragma unroll
        for (int a = 0; a < 2; ++a)
#pragma unroll
            for (int b = 0; b < 2; ++b)
#pragma unroll
                for (int m = 0; m < 4; ++m)
#pragma unroll
                    for (int n = 0; n < 2; ++n) acc[a][b][m][n] = (f32x4){0.f, 0.f, 0.f, 0.f};
        cur = nxt; cA = nA; cB = nB; ++ui;
        if constexpr (ALIGN_EPI) { if (wr == 1) PG8_BAR; }
    }
    PG8_WAIT_V(0);
    if constexpr (!ALIGN_EPI) { if (wr == 0) PG8_BAR; }
    PG8_BAR;
    if constexpr (Epi::AFTER_DRAIN) { E.fused(acc, cur, wr, wc, fr, fq, lds, wid, lane); S.done(cur); }
#undef PG8_SA
#undef PG8_SB
#undef PG8_STAGE
#undef PG8_LDA
#undef PG8_LDB
#undef PG8_MMA
#undef PG8_WAIT_V
#undef PG8_WAIT_L
#undef PG8_BAR
#undef PG8_SCHED
}
}


constexpr size_t WT_IN1 = 0;
constexpr size_t WT_G = WT_IN1 + (size_t)3840 * 1024 * 2;
constexpr size_t WT_PROJ = WT_G + (size_t)3072 * 1024 * 2;
constexpr size_t WT_O = WT_PROJ + (size_t)3 * 1024 * 384 * 2;
constexpr size_t WT_UP = WT_O + (size_t)1024 * 1024 * 2;
constexpr size_t WT_DOWN = WT_UP + (size_t)5632 * 1024 * 2;
constexpr size_t WT_END = WT_DOWN + (size_t)1024 * 2816 * 2;
static_assert(WS_WT + WT_END <= WS_R3, "weight copies fit");

__device__ __forceinline__ void tr_item(const float* W, int ldw, int col0, int Kv, int Nv, bf16_t* WT, int ldk, int k0, int n0, int drow0, float* scr, int lane) {
    const int nn = lane & 31; const bool nok = (n0 + nn) < Nv;
#pragma unroll 8
    for (int i = 0; i < 32; ++i) { const int kk = 2 * i + (lane >> 5);
        float v = 0.f; if (nok && (k0 + kk) < Kv) v = W[(size_t)(k0 + kk) * ldw + col0 + n0 + nn];
        scr[kk * 33 + nn] = v; }
    asm volatile("s_waitcnt lgkmcnt(0)" ::: "memory");
    const int c = lane & 7;
#pragma unroll
    for (int j = 0; j < 4; ++j) { const int n = (lane >> 3) + 8 * j; const float* s = scr + (8 * c) * 33 + n;
        u32x4 o; o.x = pk2(s[0 * 33], s[1 * 33]); o.y = pk2(s[2 * 33], s[3 * 33]); o.z = pk2(s[4 * 33], s[5 * 33]); o.w = pk2(s[6 * 33], s[7 * 33]);
        *(u32x4*)(WT + (size_t)(drow0 + n) * ldk + k0 + 8 * c) = o; }
    asm volatile("s_waitcnt lgkmcnt(0)" ::: "memory");
}
__device__ __forceinline__ void phase_weights(const Params& p, int l, float* lds, Ctx cx) { const int wid = cx.wid, BID = cx.bid, NBLK = cx.nblk; (void)wid; (void)BID; (void)NBLK;
    const int lane = lane_id_opaque(), wave = wid, gw = BID * NWAVES + wave, NGW = NBLK * NWAVES;
    float* scr = lds + wave * (64 * 33);
    unsigned char* wt = p.ws + WS_WT;
    constexpr int I_IN1 = 16 * 120, I_G = 16 * 96, I_P = 6 * 32, I_O = 16 * 32, I_UP = 16 * 176, I_DN = 44 * 32;
    constexpr int NITEMS = I_IN1 + I_G + 3 * I_P + I_O + I_UP + I_DN;
    const float* w_in = p.w_in + (size_t)l * DM * D_IN;
    for (int it = gw; it < NITEMS; it += NGW) {
        int r = it;
        if (r < I_IN1) { const int kb = r / 120, nb = r % 120; tr_item(w_in, D_IN, 0, 1024, NQ1, (bf16_t*)(wt + WT_IN1), 1024, kb * 64, nb * 32, nb * 32, scr, lane); continue; } r -= I_IN1;
        if (r < I_G) { const int kb = r / 96, nb = r % 96; tr_item(w_in, D_IN, NQ1, 1024, NGATE, (bf16_t*)(wt + WT_G), 1024, kb * 64, nb * 32, nb * 32, scr, lane); continue; } r -= I_G;
        if (r < 3 * I_P) { const int br = r / I_P, q = r % I_P, kb = q / 32, nb = q % 32;
            const float* W = br == 0 ? p.w_proj_sb + (size_t)l * 384 * DM : br == 1 ? p.w_proj_mb + (size_t)l * 320 * DM : p.w_proj_ds + (size_t)l * 320 * DM;
            tr_item(W, DM, 0, br == 0 ? 384 : 320, DM, (bf16_t*)(wt + WT_PROJ) + (size_t)br * 1024 * 384, 384, kb * 64, nb * 32, nb * 32, scr, lane); continue; } r -= 3 * I_P;
        if (r < I_O) { const int kb = r / 32, nb = r % 32; tr_item(p.w_o + (size_t)l * DM * DM, DM, 0, 1024, DM, (bf16_t*)(wt + WT_O), 1024, kb * 64, nb * 32, nb * 32, scr, lane); continue; } r -= I_O;
        if (r < I_UP) { const int kb = r / 176, nb = r % 176, n0 = nb * 32, bj = n0 / DFF, rr = n0 % DFF, drow0 = 256 * (rr / 128) + 128 * bj + (rr % 128);
            tr_item(p.w_up + (size_t)l * DM * 2 * DFF, 2 * DFF, 0, 1024, 2 * DFF, (bf16_t*)(wt + WT_UP), 1024, kb * 64, n0, drow0, scr, lane); continue; } r -= I_UP;
        { const int kb = r / 32, nb = r % 32; tr_item(p.w_down + (size_t)l * DFF * DM, DM, 0, DFF, DM, (bf16_t*)(wt + WT_DOWN), DFF, kb * 64, nb * 32, nb * 32, scr, lane); }
    }
}

#ifndef ATTN_QUEUE
#define ATTN_QUEUE 1
#endif
#ifndef ATTN_FAST
#define ATTN_FAST 7
#endif
#ifndef FASTMASK
#define FASTMASK 63
#endif
#define GRID_SYNC() do { asm volatile("s_waitcnt vmcnt(0) lgkmcnt(0)" ::: "memory"); grid.sync(); __builtin_amdgcn_fence(__ATOMIC_ACQUIRE, "agent"); asm volatile("s_waitcnt vmcnt(0)" ::: "memory"); } while (0)
constexpr int RING_BYTES = 131072, LDS_BYTES = 151552;
static_assert(TK_LDS_END <= QUEUE_SLOT_OFF && QUEUE_SLOT_OFF + 16 <= LDS_BYTES, "LDS map");
typedef const __attribute__((address_space(4))) Params* kparams_t;
__device__ __forceinline__ Params load_params(kparams_t pp) {
    Params p; p.x = pp->x; p.c = pp->c; p.w_ada = pp->w_ada; p.b_ada = pp->b_ada; p.g_pre_mix = pp->g_pre_mix; p.g_post_mix = pp->g_post_mix; p.w_in = pp->w_in; p.b_gate = pp->b_gate;
    p.w_proj_sb = pp->w_proj_sb; p.w_proj_mb = pp->w_proj_mb; p.w_proj_ds = pp->w_proj_ds; p.w_o = pp->w_o; p.g_pre_ffn = pp->g_pre_ffn; p.g_post_ffn = pp->g_post_ffn; p.w_up = pp->w_up; p.w_down = pp->w_down;
    p.out = pp->out; p.ws = pp->ws; p.mask = pp->mask; return p;
}
__device__ __forceinline__ bool phase_on(int k) { kparams_t pp = (kparams_t)__builtin_amdgcn_kernarg_segment_ptr(); asm volatile("" : "+s"(pp)); unsigned long long m = pp->mask; asm volatile("" : "+s"(m)); return (m >> k) & 1ull; }
#define PHASE_BEGIN Ctx cx; { int b_ = blockIdx.x, g_ = gridDim.x, w_ = wid; asm volatile("" : "+s"(b_), "+s"(g_), "+s"(w_)); cx.bid = b_; cx.nblk = g_; cx.wid = w_; } kparams_t pp_ = (kparams_t)__builtin_amdgcn_kernarg_segment_ptr(); asm volatile("" : "+s"(pp_)); const Params p = load_params(pp_); \
    unsigned char* ws_ = p.ws; bf16_t* R1 = (bf16_t*)(ws_ + WS_R1); bf16_t* R2 = (bf16_t*)(ws_ + WS_R2); bf16_t* R3 = (bf16_t*)(ws_ + WS_R3); unsigned char* wt = ws_ + WS_WT; (void)R1; (void)R2; (void)R3; (void)wt;
#define PHX(k) phase_on(k)
#define PH(k) phase_on((k) + 16 * l)
template <int l> __device__ __forceinline__ void layer_body(cg::grid_group& grid, float* lds, PG8_LAS unsigned char* lds3, int wid) {
        unsigned char* lds_raw_ = (unsigned char*)lds;
        if (PH(0)) {
            PHASE_BEGIN
            if constexpr ((FASTMASK >> 0) & 1) {
            pg8::Gemm g{R3, (const bf16_t*)(wt + WT_IN1), T, QKV_PITCH, DM, DM}; pg8::StaticOrder S; S.init(T, QKV_PITCH, cx.nblk, cx.bid);
            pg8::EpiBf16 E{R1, QKV_PITCH};
            pg8::gemm_phase<pg8::EpiBf16, pg8::StaticOrder, true, true>(lds3, g, S, E, cx.wid);
            } else {
                NGemm<1> g; g.s[0] = NSeg{R3, DM, p.w_in + (size_t)l * DM * D_IN, D_IN, DM}; g.M = T; g.N = NQ1;
                NEpi e{R1, QKV_PITCH, nullptr, nullptr};
                naive_gemm<1, 0>(lds, g, e, cx);
            }
        }
        GRID_SYNC();
#if ATTN_QUEUE
        if (PH(1)) { PHASE_BEGIN phase_zero_pad(p, cx); __syncthreads(); phase_attn_a(p, lds_raw_, l, cx); }
#else
        if (PH(1)) { PHASE_BEGIN phase_kmean(p, cx); phase_dsa_topk(p, lds, cx); }
        if (PH(2)) { PHASE_BEGIN if constexpr (!(ATTN_FAST & 1)) phase_naive_attn<0>(p, cx); phase_zero_pad(p, cx); if constexpr (ATTN_FAST & 1) { __syncthreads(); phase_fast_attn<1>(p, lds_raw_, cx); } }
#endif
        GRID_SYNC();
#if ATTN_QUEUE
        if (PH(3)) { PHASE_BEGIN phase_attn_b(p, lds_raw_, l, cx); }
#else
        if (PH(3)) { PHASE_BEGIN if constexpr (!(ATTN_FAST & 2)) phase_naive_attn<1>(p, cx); }
        if (PH(3)) { PHASE_BEGIN if constexpr (!(ATTN_FAST & 4)) phase_naive_attn<2>(p, cx); }
        if (PH(3)) { PHASE_BEGIN if constexpr ((ATTN_FAST & 6) != 0) phase_fast_attn<(ATTN_FAST & 6)>(p, lds_raw_, cx); }
#endif
        GRID_SYNC();
        if (PH(4)) {
            PHASE_BEGIN
            if constexpr ((FASTMASK >> 1) & 1) {
            pg8::Gemm g{R3, (const bf16_t*)(wt + WT_G), T, NGATE, DM, DM}; pg8::StaticOrder S; S.init(T, NGATE, cx.nblk, cx.bid);
            pg8::EpiSigmoid E{R1, NGATE, p.b_gate + l * NGATE};
            pg8::gemm_phase<pg8::EpiSigmoid, pg8::StaticOrder, true, true>(lds3, g, S, E, cx.wid);
            } else {
                NGemm<1> g; g.s[0] = NSeg{R3, DM, p.w_in + (size_t)l * DM * D_IN + NQ1, D_IN, DM}; g.M = T; g.N = NGATE;
                NEpi e{R1, NGATE, p.b_gate + l * NGATE, nullptr};
                naive_gemm<1, 1>(lds, g, e, cx);
            }
        }
        GRID_SYNC();
#pragma unroll
        for (int br = 0; br < 3; ++br) if (PH(5 + br)) {
            PHASE_BEGIN
            if constexpr ((FASTMASK >> 2) & 1) {
            pg8::Gemm g{R2 + br * 384, (const bf16_t*)(wt + WT_PROJ) + (size_t)br * 1024 * 384, T, DM, 384, OC_PITCH}; pg8::StaticOrder S; S.init(T, DM, cx.nblk, cx.bid);
            pg8::EpiGate E{R3, R1, br};
            pg8::gemm_phase<pg8::EpiGate, pg8::StaticOrder, true, true>(lds3, g, S, E, cx.wid);
            asm volatile("s_waitcnt vmcnt(0)" ::: "memory");
            __builtin_amdgcn_fence(__ATOMIC_ACQUIRE, "agent");
            asm volatile("s_waitcnt vmcnt(0)" ::: "memory");
            __syncthreads();
            } else {
                if (br == 0) {
                    NGemm<3> g;
                    g.s[0] = NSeg{R2 + CO_SB, OC_PITCH, p.w_proj_sb + (size_t)l * 384 * DM, DM, 384};
                    g.s[1] = NSeg{R2 + CO_MB, OC_PITCH, p.w_proj_mb + (size_t)l * 320 * DM, DM, 320};
                    g.s[2] = NSeg{R2 + CO_DS, OC_PITCH, p.w_proj_ds + (size_t)l * 320 * DM, DM, 320};
                    g.M = T; g.N = DM;
                    NEpi e{R3, DM, nullptr, R1};
                    naive_gemm<3, 2>(lds, g, e, cx);
                }
            }
        }
        GRID_SYNC();
        if (PH(8)) {
            PHASE_BEGIN
            if constexpr ((FASTMASK >> 3) & 1) {
            pg8::Gemm g{R3, (const bf16_t*)(wt + WT_O), T, DM, DM, DM}; pg8::StaticOrder S; S.init(T, DM, cx.nblk, cx.bid);
            pg8::EpiBf16 E{R2, DM};
            pg8::gemm_phase<pg8::EpiBf16, pg8::StaticOrder, true, true>(lds3, g, S, E, cx.wid);
            } else {
                NGemm<1> g; g.s[0] = NSeg{R3, DM, p.w_o + (size_t)l * DM * DM, DM, DM}; g.M = T; g.N = DM;
                NEpi e{R2, DM, nullptr, nullptr};
                naive_gemm<1, 0>(lds, g, e, cx);
            }
        }
        GRID_SYNC();
        if (PH(9)) { PHASE_BEGIN phase_postnorm(p, l == 0 ? p.x : p.out, p.g_post_mix + l * DM, l, 0, cx); }
        GRID_SYNC();
        if (PH(10)) {
            PHASE_BEGIN
            if constexpr ((FASTMASK >> 4) & 1) {
            pg8::Gemm g{R3, (const bf16_t*)(wt + WT_UP), T, 2 * DFF, DM, DM}; pg8::StaticOrder S; S.init(T, 2 * DFF, cx.nblk, cx.bid);
            pg8::EpiSwiglu E{R1, DFF};
            pg8::gemm_phase<pg8::EpiSwiglu, pg8::StaticOrder, true, true>(lds3, g, S, E, cx.wid);
            } else {
                const float* wu = p.w_up + (size_t)l * DM * 2 * DFF;
                NGemm<2> g; g.s[0] = NSeg{R3, DM, wu, 2 * DFF, DM}; g.s[1] = NSeg{R3, DM, wu + DFF, 2 * DFF, DM}; g.M = T; g.N = DFF;
                NEpi e{R1, DFF, nullptr, nullptr};
                naive_gemm<2, 3>(lds, g, e, cx);
            }
        }
        GRID_SYNC();
        if (PH(11)) {
            PHASE_BEGIN
            if constexpr ((FASTMASK >> 5) & 1) {
            pg8::Gemm g{R1, (const bf16_t*)(wt + WT_DOWN), T, DM, DFF, DFF}; pg8::StaticOrder S; S.init(T, DM, cx.nblk, cx.bid);
            pg8::EpiBf16 E{R2, DM};
            pg8::gemm_phase<pg8::EpiBf16, pg8::StaticOrder, true, true>(lds3, g, S, E, cx.wid);
            } else {
                NGemm<1> g; g.s[0] = NSeg{R1, DFF, p.w_down + (size_t)l * DFF * DM, DM, DFF}; g.M = T; g.N = DM;
                NEpi e{R2, DM, nullptr, nullptr};
                naive_gemm<1, 0>(lds, g, e, cx);
            }
        }
        GRID_SYNC();
        if (PH(12)) { PHASE_BEGIN phase_postnorm(p, p.out, p.g_post_ffn + l * DM, l, 1, cx); }
        if (l + 1 < DEPTH) { if (PH(13)) { PHASE_BEGIN __syncthreads(); phase_weights(p, l + 1, lds, cx); } }
        GRID_SYNC();
    }
__global__ void __launch_bounds__(NTHREADS, 2) mega_fwd(Params p_kernarg) {
    cg::grid_group grid = cg::this_grid();
    const int wid = __builtin_amdgcn_readfirstlane((int)threadIdx.x >> 6);
    extern __shared__ __attribute__((aligned(16))) unsigned char lds_raw[];
    float* lds = (float*)lds_raw;
    PG8_LAS unsigned char* lds3 = (PG8_LAS unsigned char*)lds_raw;
    if (PHX(60)) { PHASE_BEGIN if (cx.bid == 0 && cx.wid == 0) { const int ln = lane_id_opaque(); if (ln < 8) ((unsigned*)(p.ws + WS_CTR))[64 * ln] = 0u; } phase_mod(p, lds, cx); __syncthreads(); }
    if (PHX(61)) { PHASE_BEGIN phase_weights(p, 0, lds, cx); }
    GRID_SYNC();
    if (PHX(62)) { PHASE_BEGIN phase_prenorm(p, p.x, p.g_pre_mix, 0, 0, cx); }
    GRID_SYNC();
    layer_body<0>(grid, lds, lds3, wid);
    layer_body<1>(grid, lds, lds3, wid);
}

extern "C" void kernel_launch(void* const* d_in, const int* in_sizes, int n_in, void* d_out, int out_size, void* d_ws, size_t ws_size, hipStream_t stream) {
    static int grid_blocks = 0;
    if (grid_blocks == 0) {
        if (n_in != 16 || out_size != T * DM || ws_size < WS_END) { fprintf(stderr, "kernel_launch: unexpected sizes n_in %d out %d ws %zu\n", n_in, out_size, ws_size); grid_blocks = -1; return; }
        int dev = 0, cus = 0, per_cu = 0;
        (void)hipGetDevice(&dev);
        (void)hipDeviceGetAttribute(&cus, hipDeviceAttributeMultiprocessorCount, dev);
        if (hipFuncSetAttribute((const void*)mega_fwd, hipFuncAttributeMaxDynamicSharedMemorySize, LDS_BYTES) != hipSuccess) { fprintf(stderr, "kernel_launch: hipFuncSetAttribute failed\n"); grid_blocks = -1; return; }
        (void)hipOccupancyMaxActiveBlocksPerMultiprocessor(&per_cu, (const void*)mega_fwd, NTHREADS, LDS_BYTES);
        if (per_cu < 1) { fprintf(stderr, "kernel_launch: occupancy query says %d blocks per CU\n", per_cu); per_cu = 1; }
        if (per_cu > 1) per_cu = 1;
        grid_blocks = cus * per_cu;
        fprintf(stderr, "kernel_launch: cus %d per_cu %d grid %d ws %zu\n", cus, per_cu, grid_blocks, ws_size);
    }
    if (grid_blocks < 0) return;
    Params p{};
    p.x = (const float*)d_in[0]; p.c = (const float*)d_in[1]; p.w_ada = (const float*)d_in[2]; p.b_ada = (const float*)d_in[3];
    p.g_pre_mix = (const float*)d_in[4]; p.g_post_mix = (const float*)d_in[5]; p.w_in = (const float*)d_in[6]; p.b_gate = (const float*)d_in[7];
    p.w_proj_sb = (const float*)d_in[8]; p.w_proj_mb = (const float*)d_in[9]; p.w_proj_ds = (const float*)d_in[10]; p.w_o = (const float*)d_in[11];
    p.g_pre_ffn = (const float*)d_in[12]; p.g_post_ffn = (const float*)d_in[13]; p.w_up = (const float*)d_in[14]; p.w_down = (const float*)d_in[15];
    p.out = (float*)d_out; p.ws = (unsigned char*)d_ws; p.mask = ~0ull;
    void* args[] = {&p};
    hipError_t e = hipLaunchCooperativeKernel((const void*)mega_fwd, dim3(grid_blocks), dim3(NTHREADS), args, LDS_BYTES, stream);
    if (e != hipSuccess) fprintf(stderr, "cooperative launch failed: %s (grid %d)\n", hipGetErrorString(e), grid_blocks);
}
```

```cpp
#include <hip/hip_runtime.h>
#include <hip/hip_cooperative_groups.h>
#include <cstdio>
#include <cstdint>
namespace cg = cooperative_groups;

typedef float f32x4 __attribute__((ext_vector_type(4)));
typedef unsigned u32x4 __attribute__((ext_vector_type(4)));
typedef unsigned u32x2 __attribute__((ext_vector_type(2)));
typedef unsigned short bf16_t;

constexpr int BATCH = 8, SEQ = 2048, DM = 1024, T = BATCH * SEQ, DEPTH = 2;
constexpr int HD = 64, H_SB = 6, H_MB = 5, H_DS = 5;
constexpr int D_IN = 6728, NQ1 = 3656, QKV_PITCH = 3840, NGATE = 3072, DFF = 2816;
constexpr int OC_PITCH = 1152;
constexpr int CQ_SB = 0, CK_SB = 384, CV_SB = 768, CQ_MB = 1152, CK_MB = 1472, CV_MB = 1792, CQ_DS = 2112, CK_DS = 2432, CV_DS = 2752, CQ_IX = 3072, CK_IX = 3584, CW_IX = 3648;
constexpr int CO_SB = 0, CO_MB = 384, CO_DS = 768;
constexpr float RMS_EPS = 1e-6f;
constexpr int NTHREADS = 512, NWAVES = 8;
constexpr int QUEUE_SLOT_OFF = 151552 - 64, XB_ST_OFF = 151552 - 32;

constexpr size_t MiB = 1u << 20;
constexpr size_t WS_CTR = 0;
constexpr int CW_BAR = 4096;
constexpr size_t WS_MOD = 1 * MiB;
constexpr size_t WS_KMEAN = 1 * MiB + 512 * 1024;
constexpr size_t WS_MASK = 2 * MiB;
constexpr size_t WS_WT = 6 * MiB;
constexpr size_t WS_R3 = 42 * MiB;
constexpr size_t WS_R2 = 74 * MiB;
constexpr size_t WS_R1 = 110 * MiB;
constexpr size_t WS_END = 230 * MiB;

struct Params {
    const float* x; const float* c; const float* w_ada; const float* b_ada; const float* g_pre_mix; const float* g_post_mix;
    const float* w_in; const float* b_gate; const float* w_proj_sb; const float* w_proj_mb; const float* w_proj_ds; const float* w_o;
    const float* g_pre_ffn; const float* g_post_ffn; const float* w_up; const float* w_down;
    float* out; unsigned char* ws; unsigned long long mask;
};

struct Ctx { int bid, nblk, wid; };
__device__ __forceinline__ float bf2f(unsigned short b) { return __uint_as_float((unsigned)b << 16); }
__device__ __forceinline__ float bflo(unsigned w) { return __uint_as_float(w << 16); }
__device__ __forceinline__ float bfhi(unsigned w) { return __uint_as_float(w & 0xffff0000u); }
__device__ __forceinline__ unsigned f2bf(float f) { unsigned u = __float_as_uint(f); return (u + 0x7fffu + ((u >> 16) & 1u)) >> 16; }
__device__ __forceinline__ unsigned pk2(float lo, float hi) { return f2bf(lo) | (f2bf(hi) << 16); }
__device__ __forceinline__ float wave_sum(float v) {
#pragma unroll
    for (int o = 1; o < 64; o <<= 1) v += __shfl_xor(v, o);
    return v;
}
__device__ __forceinline__ int lane_id_opaque() { int l; asm volatile("v_mbcnt_lo_u32_b32 %0, -1, 0\n\tv_mbcnt_hi_u32_b32 %0, -1, %0" : "=v"(l)); return l; }
#define TIDX (wid * 64 + lane_id_opaque())
__device__ __forceinline__ float sigmoidf_(float v) { return 1.f / (1.f + __expf(-v)); }

__device__ __forceinline__ void phase_mod(const Params& p, float* lds, Ctx cx) { const int wid = cx.wid, BID = cx.bid, NBLK = cx.nblk; (void)wid; (void)BID; (void)NBLK;
    float* MOD = (float*)(p.ws + WS_MOD);
    const int tid = TIDX;
    float* cact = lds;
    float* red = lds + 8 * 1024;
    for (int i = tid; i < 8 * 1024; i += NTHREADS) { const float v = p.c[i]; cact[i] = v * sigmoidf_(v); }
    __syncthreads();
    for (int item = BID; item < 2 * 96; item += NBLK) {
        const int l = item / 96, ct = item % 96, kg = tid >> 6, col = ct * 64 + (tid & 63);
        const float* W = p.w_ada + (size_t)l * 1024 * 6144 + col;
        float acc[8];
#pragma unroll
        for (int b = 0; b < 8; ++b) acc[b] = 0.f;
        for (int k = kg; k < 1024; k += 8) {
            const float w = W[(size_t)k * 6144];
#pragma unroll
            for (int b = 0; b < 8; ++b) acc[b] += cact[b * 1024 + k] * w;
        }
#pragma unroll
        for (int b = 0; b < 8; ++b) red[(kg * 8 + b) * 64 + (tid & 63)] = acc[b];
        __syncthreads();
        {
            const int b = tid >> 6, cc = tid & 63;
            float s = 0.f;
#pragma unroll
            for (int g = 0; g < 8; ++g) s += red[(g * 8 + b) * 64 + cc];
            MOD[((size_t)l * 8 + b) * 6144 + ct * 64 + cc] = s + p.b_ada[l * 6144 + ct * 64 + cc];
        }
        __syncthreads();
    }
}

__device__ __forceinline__ void normmod_row(const f32x4 (&v)[4], float rstd, const float* g, const float* sc, const float* sh, bf16_t* orow, int lane) {
#pragma unroll
    for (int j = 0; j < 4; ++j) {
        const int c0 = 4 * lane + 256 * j;
        const f32x4 gg = *(const f32x4*)(g + c0), s1 = *(const f32x4*)(sc + c0), s0 = *(const f32x4*)(sh + c0);
        f32x4 o;
#pragma unroll
        for (int e = 0; e < 4; ++e) o[e] = v[j][e] * rstd * gg[e] * (1.f + s1[e]) + s0[e];
        u32x2 w; w.x = pk2(o[0], o[1]); w.y = pk2(o[2], o[3]);
        *(u32x2*)(orow + c0) = w;
    }
}
__device__ __forceinline__ void phase_prenorm(const Params& p, const float* xin, const float* g, int l, int which, Ctx cx) { const int wid = cx.wid, BID = cx.bid, NBLK = cx.nblk; (void)wid; (void)BID; (void)NBLK;
    const float* MOD = (const float*)(p.ws + WS_MOD) + (size_t)l * 8 * 6144;
    bf16_t* XN = (bf16_t*)(p.ws + WS_R3);
    const int lane = lane_id_opaque(), gw = BID * NWAVES + wid, NGW = NBLK * NWAVES;
    for (int m = gw; m < T; m += NGW) {
        const int b = m / SEQ;
        const f32x4* xr = (const f32x4*)(xin + (size_t)m * DM) + lane;
        f32x4 v[4]; float s = 0.f;
#pragma unroll
        for (int j = 0; j < 4; ++j) { v[j] = xr[64 * j]; s += (v[j][0] * v[j][0] + v[j][1] * v[j][1]) + (v[j][2] * v[j][2] + v[j][3] * v[j][3]); }
        const float rstd = rsqrtf(wave_sum(s) * (1.f / DM) + RMS_EPS);
        const float* mb = MOD + (size_t)b * 6144 + which * 3072;
        normmod_row(v, rstd, g, mb + 1024, mb, XN + (size_t)m * DM, lane);
    }
}
__device__ __forceinline__ void phase_postnorm(const Params& p, const float* xin, const float* gpost, int l, int which, Ctx cx) { const int wid = cx.wid, BID = cx.bid, NBLK = cx.nblk; (void)wid; (void)BID; (void)NBLK;
    const float* MODl = (const float*)(p.ws + WS_MOD) + (size_t)l * 8 * 6144;
    const bf16_t* Y = (const bf16_t*)(p.ws + WS_R2);
    bf16_t* XN = (bf16_t*)(p.ws + WS_R3);
    const int lane = lane_id_opaque(), gw = BID * NWAVES + wid, NGW = NBLK * NWAVES;
    const float* gnext = which == 0 ? p.g_pre_ffn + l * DM : (l + 1 < DEPTH ? p.g_pre_mix + (l + 1) * DM : nullptr);
    for (int m = gw; m < T; m += NGW) {
        const int b = m / SEQ;
        const float* gate = MODl + (size_t)b * 6144 + (which == 0 ? 2048 : 5120);
        f32x4 y[4]; float s = 0.f;
#pragma unroll
        for (int j = 0; j < 4; ++j) {
            const u32x2 w = *(const u32x2*)(Y + (size_t)m * DM + 4 * lane + 256 * j);
            y[j] = (f32x4){bflo(w.x), bfhi(w.x), bflo(w.y), bfhi(w.y)};
            s += (y[j][0] * y[j][0] + y[j][1] * y[j][1]) + (y[j][2] * y[j][2] + y[j][3] * y[j][3]);
        }
        const float rstd = rsqrtf(wave_sum(s) * (1.f / DM) + RMS_EPS);
        f32x4 v[4]; float s2 = 0.f;
#pragma unroll
        for (int j = 0; j < 4; ++j) {
            const int c0 = 4 * lane + 256 * j;
            const f32x4 xi = *(const f32x4*)(xin + (size_t)m * DM + c0), gp = *(const f32x4*)(gpost + c0), gt = *(const f32x4*)(gate + c0);
#pragma unroll
            for (int e = 0; e < 4; ++e) v[j][e] = xi[e] + gt[e] * (y[j][e] * rstd * gp[e]);
            *(f32x4*)(p.out + (size_t)m * DM + c0) = v[j];
            s2 += (v[j][0] * v[j][0] + v[j][1] * v[j][1]) + (v[j][2] * v[j][2] + v[j][3] * v[j][3]);
        }
        if (gnext) {
            const float rstd2 = rsqrtf(wave_sum(s2) * (1.f / DM) + RMS_EPS);
            const float* mb = which == 0 ? MODl + (size_t)b * 6144 + 3072 : MODl + (size_t)8 * 6144 + (size_t)b * 6144;
            normmod_row(v, rstd2, gnext, mb + 1024, mb, XN + (size_t)m * DM, lane);
        }
    }
}

struct NSeg { const bf16_t* A; int lda; const float* W; int ldw; int K; };
template <int NSEG> struct NGemm { NSeg s[NSEG]; int M, N; };
struct NEpi { bf16_t* C; int ldc; const float* bias; const bf16_t* gates; };
template <int NSEG, int EPI> __device__ __forceinline__ void naive_gemm(float* lds, const NGemm<NSEG>& g, const NEpi& e, Ctx cx) { const int wid = cx.wid, BID = cx.bid, NBLK = cx.nblk; (void)wid; (void)BID; (void)NBLK;
    float* As = lds;
    float* Bs = lds + 16 * 68;
    const int tid = TIDX, ty = tid >> 5, tx = tid & 31;
    const int tm = g.M / 64, tn = (g.N + 127) / 128;
    for (int item = BID; item < tm * tn; item += NBLK) {
        const int m0 = (item / tn) * 64, n0 = (item % tn) * 128;
        float acc[NSEG][4][4];
#pragma unroll
        for (int s = 0; s < NSEG; ++s)
#pragma unroll
            for (int i = 0; i < 4; ++i)
#pragma unroll
                for (int j = 0; j < 4; ++j) acc[s][i][j] = 0.f;
#pragma unroll
        for (int s = 0; s < NSEG; ++s) {
            const NSeg sg = g.s[s];
#pragma unroll 1
            for (int k0 = 0; k0 < sg.K; k0 += 16) {
                __syncthreads();
                {
                    const int r = tid >> 3, kq = tid & 7;
                    const unsigned w = *(const unsigned*)(sg.A + (size_t)(m0 + r) * sg.lda + k0 + kq * 2);
                    As[(kq * 2 + 0) * 68 + r] = bflo(w); As[(kq * 2 + 1) * 68 + r] = bfhi(w);
                    const int k = tid >> 5, nq = tid & 31, n = n0 + nq * 4;
                    f32x4 bv = (f32x4){0.f, 0.f, 0.f, 0.f};
                    if (n < g.N) bv = *(const f32x4*)(sg.W + (size_t)(k0 + k) * sg.ldw + n);
                    *(f32x4*)(Bs + k * 132 + nq * 4) = bv;
                }
                __syncthreads();
#pragma unroll 4
                for (int k = 0; k < 16; ++k) {
                    const f32x4 a0 = *(const f32x4*)(As + k * 68 + ty * 4), b = *(const f32x4*)(Bs + k * 132 + tx * 4);
#pragma unroll
                    for (int i = 0; i < 4; ++i)
#pragma unroll
                        for (int j = 0; j < 4; ++j) acc[s][i][j] += a0[i] * b[j];
                }
            }
        }
        const int col = n0 + tx * 4;
        if (col < g.N) {
#pragma unroll
            for (int i = 0; i < 4; ++i) {
                const int row = m0 + ty * 4 + i;
                float o[4];
                if (EPI == 0) {
#pragma unroll
                    for (int j = 0; j < 4; ++j) o[j] = acc[0][i][j];
                } else if (EPI == 1) {
#pragma unroll
                    for (int j = 0; j < 4; ++j) o[j] = sigmoidf_(acc[0][i][j] + e.bias[col + j]);
                } else if (EPI == 2) {
#pragma unroll
                    for (int j = 0; j < 4; ++j) o[j] = 0.f;
#pragma unroll
                    for (int s = 0; s < NSEG; ++s) {
                        const u32x2 gw = *(const u32x2*)(e.gates + (size_t)row * NGATE + s * 1024 + col);
                        o[0] += bflo(gw.x) * acc[s][i][0]; o[1] += bfhi(gw.x) * acc[s][i][1]; o[2] += bflo(gw.y) * acc[s][i][2]; o[3] += bfhi(gw.y) * acc[s][i][3];
                    }
                } else {
#pragma unroll
                    for (int j = 0; j < 4; ++j) { const float gt = acc[0][i][j]; o[j] = gt * sigmoidf_(gt) * acc[NSEG - 1][i][j]; }
                }
                u32x2 w; w.x = pk2(o[0], o[1]); w.y = pk2(o[2], o[3]);
                *(u32x2*)(e.C + (size_t)row * e.ldc + col) = w;
            }
        }
    }
}

__device__ __forceinline__ void phase_kmean(const Params& p, Ctx cx) { const int wid = cx.wid, BID = cx.bid, NBLK = cx.nblk; (void)wid; (void)BID; (void)NBLK;
    const bf16_t* QKV = (const bf16_t*)(p.ws + WS_R1);
    float* KM = (float*)(p.ws + WS_KMEAN);
    const int gt = BID * NTHREADS + TIDX, NT = NBLK * NTHREADS;
    for (int o = gt; o < 8 * 8 * 320; o += NT) {
        const int c = o % 320, n = (o / 320) % 8, b = o / (320 * 8);
        const bf16_t* kp = QKV + (size_t)(b * SEQ + n * 256) * QKV_PITCH + CK_MB + c;
        float s = 0.f;
        for (int r = 0; r < 256; ++r) s += bf2f(kp[(size_t)r * QKV_PITCH]);
        KM[o] = s * (1.f / 256.f);
    }
}

__device__ __forceinline__ unsigned ordkey(float f) { const unsigned u = __float_as_uint(f); return u ^ ((u >> 31) ? 0xffffffffu : 0x80000000u); }
__device__ __forceinline__ void phase_dsa_topk(const Params& p, float* lds, Ctx cx) { const int wid = cx.wid, BID = cx.bid, NBLK = cx.nblk; (void)wid; (void)BID; (void)NBLK;
    const bf16_t* QKV = (const bf16_t*)(p.ws + WS_R1);
    unsigned* MASK = (unsigned*)(p.ws + WS_MASK);
    const int lane = lane_id_opaque(), wave = wid, gw = BID * NWAVES + wave, NGW = NBLK * NWAVES;
    float* qs = lds + wave * 520;
    unsigned* skey = (unsigned*)(lds + 8 * 520) + wave * 2048;
    for (int m = gw; m < T; m += NGW) {
        const int b = m / SEQ, t = m % SEQ;
        const bf16_t* qrow = QKV + (size_t)m * QKV_PITCH;
        {
            const u32x4 w = *(const u32x4*)(qrow + CQ_IX + lane * 8);
            qs[lane * 8 + 0] = bflo(w.x); qs[lane * 8 + 1] = bfhi(w.x); qs[lane * 8 + 2] = bflo(w.y); qs[lane * 8 + 3] = bfhi(w.y);
            qs[lane * 8 + 4] = bflo(w.z); qs[lane * 8 + 5] = bfhi(w.z); qs[lane * 8 + 6] = bflo(w.w); qs[lane * 8 + 7] = bfhi(w.w);
            if (lane < 8) qs[512 + lane] = bf2f(qrow[CW_IX + lane]);
        }
        asm volatile("s_waitcnt lgkmcnt(0)" ::: "memory");
        __builtin_amdgcn_wave_barrier();
        const int ni = (t >> 6) + 1;
#pragma unroll 1
        for (int i = 0; i < ni; ++i) {
            const int s = i * 64 + lane;
            const u32x4* kp = (const u32x4*)(QKV + (size_t)(b * SEQ + s) * QKV_PITCH + CK_IX);
            u32x4 kw[8];
#pragma unroll
            for (int q = 0; q < 8; ++q) kw[q] = kp[q];
            float sc = 0.f;
#pragma unroll 1
            for (int h = 0; h < 8; ++h) {
                float lg = 0.f;
#pragma unroll
                for (int q = 0; q < 8; ++q) {
                    const f32x4 q0 = *(const f32x4*)(qs + h * 64 + q * 8), q1 = *(const f32x4*)(qs + h * 64 + q * 8 + 4);
                    lg += q0[0] * bflo(kw[q].x) + q0[1] * bfhi(kw[q].x) + q0[2] * bflo(kw[q].y) + q0[3] * bfhi(kw[q].y)
                        + q1[0] * bflo(kw[q].z) + q1[1] * bfhi(kw[q].z) + q1[2] * bflo(kw[q].w) + q1[3] * bfhi(kw[q].w);
                }
                sc += qs[512 + h] * fmaxf(lg, 0.f);
            }
            if (sc == 0.f) sc = 0.f;
            skey[s] = (s <= t) ? ordkey(sc) : 0u;
        }
        asm volatile("s_waitcnt lgkmcnt(0)" ::: "memory");
        __builtin_amdgcn_wave_barrier();
        unsigned key[32];
#pragma unroll
        for (int i = 0; i < 32; ++i) key[i] = (i < ni) ? skey[i * 64 + lane] : 0u;
        unsigned w = 0u;
        if (t + 1 <= 256) {
#pragma unroll
            for (int i = 0; i < 32; ++i) { const unsigned long long sb = __ballot(key[i] != 0u); if ((lane >> 1) == i) w = (lane & 1) ? (unsigned)(sb >> 32) : (unsigned)sb; }
        } else {
            unsigned Tk = 0u;
#pragma unroll 1
            for (int bit = 31; bit >= 0; --bit) {
                const unsigned cand = Tk | (1u << bit);
                int cnt = 0;
#pragma unroll
                for (int i = 0; i < 32; ++i) cnt += __popcll(__ballot(key[i] >= cand));
                if (cnt >= 256) Tk = cand;
            }
            int cgt = 0;
#pragma unroll
            for (int i = 0; i < 32; ++i) cgt += __popcll(__ballot(key[i] > Tk));
            int need = 256 - cgt;
#pragma unroll
            for (int i = 0; i < 32; ++i) {
                const unsigned long long gtb = __ballot(key[i] > Tk), eqb = __ballot(key[i] == Tk);
                unsigned long long take = 0ull;
                const int ne = __popcll(eqb);
                if (need > 0 && ne > 0) {
                    if (ne <= need) { take = eqb; need -= ne; }
                    else {
                        unsigned long long rem = eqb;
                        for (int q = 0; q < need; ++q) { const unsigned long long low = rem & (~rem + 1ull); take |= low; rem ^= low; }
                        need = 0;
                    }
                }
                const unsigned long long sb = gtb | take;
                if ((lane >> 1) == i) w = (lane & 1) ? (unsigned)(sb >> 32) : (unsigned)sb;
            }
        }
        MASK[(size_t)m * 64 + lane] = w;
        __builtin_amdgcn_wave_barrier();
    }
}

template <int MODE> __device__ __forceinline__ void naive_attn_item(const Params& p, int b, int h, int qc, int lane) {
    const bf16_t* QKV = (const bf16_t*)(p.ws + WS_R1);
    bf16_t* OC = (bf16_t*)(p.ws + WS_R2);
    constexpr int cq = MODE == 0 ? CQ_SB : MODE == 1 ? CQ_MB : CQ_DS, ck = MODE == 0 ? CK_SB : MODE == 1 ? CK_MB : CK_DS, cv = MODE == 0 ? CV_SB : MODE == 1 ? CV_MB : CV_DS;
    constexpr int co = MODE == 0 ? CO_SB : MODE == 1 ? CO_MB : CO_DS;
    const int t = qc * 64 + lane; const size_t row = (size_t)b * SEQ + t;
    float q[64], acc[64];
    {
        const u32x4* qp = (const u32x4*)(QKV + row * QKV_PITCH + cq + h * 64);
#pragma unroll
        for (int i = 0; i < 8; ++i) { const u32x4 w = qp[i];
            q[i * 8 + 0] = bflo(w.x); q[i * 8 + 1] = bfhi(w.x); q[i * 8 + 2] = bflo(w.y); q[i * 8 + 3] = bfhi(w.y);
            q[i * 8 + 4] = bflo(w.z); q[i * 8 + 5] = bfhi(w.z); q[i * 8 + 6] = bflo(w.w); q[i * 8 + 7] = bfhi(w.w); }
    }
#pragma unroll
    for (int d = 0; d < 64; ++d) acc[d] = 0.f;
    const bf16_t* Kb = QKV + (size_t)b * SEQ * QKV_PITCH + ck + h * 64;
    const bf16_t* Vb = QKV + (size_t)b * SEQ * QKV_PITCH + cv + h * 64;
    const int tmax = qc * 64 + 63;
    float outscale = 1.f;
    if (MODE == 0) {
        float R = 0.f;
        for (int s = tmax - 1; s >= 0; --s) {
            const u32x4* kp = (const u32x4*)(Kb + (size_t)s * QKV_PITCH);
            float z = 0.f;
#pragma unroll
            for (int i = 0; i < 8; ++i) { const u32x4 w = kp[i];
                z += q[i * 8 + 0] * bflo(w.x) + q[i * 8 + 1] * bfhi(w.x) + q[i * 8 + 2] * bflo(w.y) + q[i * 8 + 3] * bfhi(w.y)
                   + q[i * 8 + 4] * bflo(w.z) + q[i * 8 + 5] * bfhi(w.z) + q[i * 8 + 6] * bflo(w.w) + q[i * 8 + 7] * bfhi(w.w); }
            z *= 0.125f;
            const float u = -(fmaxf(z, 0.f) + log1pf(__expf(-fabsf(z))));
            const bool act = s < t;
            const float a = act ? __expf(z + u + R) : 0.f;
            if (act) R += u;
            const u32x4* vp = (const u32x4*)(Vb + (size_t)s * QKV_PITCH);
#pragma unroll
            for (int i = 0; i < 8; ++i) { const u32x4 w = vp[i];
                acc[i * 8 + 0] += a * bflo(w.x); acc[i * 8 + 1] += a * bfhi(w.x); acc[i * 8 + 2] += a * bflo(w.y); acc[i * 8 + 3] += a * bfhi(w.y);
                acc[i * 8 + 4] += a * bflo(w.z); acc[i * 8 + 5] += a * bfhi(w.z); acc[i * 8 + 6] += a * bflo(w.w); acc[i * 8 + 7] += a * bfhi(w.w); }
        }
    } else {
        const float slope = exp2f(-0.8f * (float)(MODE == 1 ? (2 * h + 1) : (2 * h + 2)));
        const int own = t >> 8;
        unsigned selm = 0u;
        if (MODE == 1) {
            const float* KM = (const float*)(p.ws + WS_KMEAN);
            float gate[8];
#pragma unroll
            for (int n = 0; n < 8; ++n) {
                gate[n] = -1e30f;
                if (n < own) {
                    const float* km = KM + (((size_t)b * 8 + n) * 5 + h) * 64;
                    float gsum = 0.f;
#pragma unroll
                    for (int d = 0; d < 64; ++d) gsum += q[d] * km[d];
                    gate[n] = gsum;
                }
            }
#pragma unroll
            for (int r = 0; r < 3; ++r) {
                float best = -3e38f; int bi = -1;
#pragma unroll
                for (int n = 0; n < 8; ++n) if (!((selm >> n) & 1u) && gate[n] > best) { best = gate[n]; bi = n; }
                if (bi >= 0) selm |= 1u << bi;
            }
            selm &= (1u << own) - 1u;
        }
        const unsigned* MASK = (const unsigned*)(p.ws + WS_MASK) + row * 64;
        float mx = -3e38f, l = 0.f;
        unsigned mw = 0u;
        for (int s = 0; s <= tmax; ++s) {
            bool allowed;
            if (MODE == 1) {
                const int n = s >> 8;
                allowed = (n < own) ? ((selm >> n) & 1u) : (s <= t);
            } else {
                if ((s & 31) == 0) mw = MASK[s >> 5];
                allowed = (mw >> (s & 31)) & 1u;
            }
            if (!__any(allowed)) continue;
            const u32x4* kp = (const u32x4*)(Kb + (size_t)s * QKV_PITCH);
            float z = 0.f;
#pragma unroll
            for (int i = 0; i < 8; ++i) { const u32x4 w = kp[i];
                z += q[i * 8 + 0] * bflo(w.x) + q[i * 8 + 1] * bfhi(w.x) + q[i * 8 + 2] * bflo(w.y) + q[i * 8 + 3] * bfhi(w.y)
                   + q[i * 8 + 4] * bflo(w.z) + q[i * 8 + 5] * bfhi(w.z) + q[i * 8 + 6] * bflo(w.w) + q[i * 8 + 7] * bfhi(w.w); }
            const float sc = z * 0.125f - slope * (float)(t - s);
            const float mn = allowed ? fmaxf(mx, sc) : mx;
            const float alpha = __expf(mx - mn);
            const float pp = allowed ? __expf(sc - mn) : 0.f;
            mx = mn; l = l * alpha + pp;
            const u32x4* vp = (const u32x4*)(Vb + (size_t)s * QKV_PITCH);
#pragma unroll
            for (int i = 0; i < 8; ++i) { const u32x4 w = vp[i];
                acc[i * 8 + 0] = acc[i * 8 + 0] * alpha + pp * bflo(w.x); acc[i * 8 + 1] = acc[i * 8 + 1] * alpha + pp * bfhi(w.x);
                acc[i * 8 + 2] = acc[i * 8 + 2] * alpha + pp * bflo(w.y); acc[i * 8 + 3] = acc[i * 8 + 3] * alpha + pp * bfhi(w.y);
                acc[i * 8 + 4] = acc[i * 8 + 4] * alpha + pp * bflo(w.z); acc[i * 8 + 5] = acc[i * 8 + 5] * alpha + pp * bfhi(w.z);
                acc[i * 8 + 6] = acc[i * 8 + 6] * alpha + pp * bflo(w.w); acc[i * 8 + 7] = acc[i * 8 + 7] * alpha + pp * bfhi(w.w); }
        }
        outscale = 1.f / l;
    }
    u32x4* op = (u32x4*)(OC + row * OC_PITCH + co + h * 64);
#pragma unroll
    for (int i = 0; i < 8; ++i) { u32x4 w;
        w.x = pk2(acc[i * 8 + 0] * outscale, acc[i * 8 + 1] * outscale); w.y = pk2(acc[i * 8 + 2] * outscale, acc[i * 8 + 3] * outscale);
        w.z = pk2(acc[i * 8 + 4] * outscale, acc[i * 8 + 5] * outscale); w.w = pk2(acc[i * 8 + 6] * outscale, acc[i * 8 + 7] * outscale);
        op[i] = w; }
}
template <int MODE> __device__ __forceinline__ void phase_naive_attn(const Params& p, Ctx cx) { const int wid = cx.wid, BID = cx.bid, NBLK = cx.nblk; (void)wid; (void)BID; (void)NBLK;
    constexpr int NH = MODE == 0 ? H_SB : 5;
    const int lane = lane_id_opaque(), gw = BID * NWAVES + wid, NGW = NBLK * NWAVES;
    const int nitems = BATCH * NH * 32;
    for (int it = gw; it < nitems; it += NGW) {
        const int qc = 31 - it / (BATCH * NH), bh = it % (BATCH * NH);
        naive_attn_item<MODE>(p, bh / NH, bh % NH, qc, lane);
    }
}
typedef float f32x2g_t __attribute__((ext_vector_type(2))); typedef __bf16 bf16x2g_t __attribute__((ext_vector_type(2)));
__device__ __forceinline__ unsigned cvt_pk(float lo, float hi) { f32x2g_t v = {lo, hi}; bf16x2g_t b = __builtin_convertvector(v, bf16x2g_t); return __builtin_bit_cast(unsigned, b); }
typedef short bf16x8_t __attribute__((ext_vector_type(8)));
typedef float f32x16_t __attribute__((ext_vector_type(16)));
typedef __attribute__((address_space(3))) unsigned char lds_u8;
constexpr int AT_PITCH = 144, AT_KBYTES = 64 * AT_PITCH, AT_BUF = 2 * AT_KBYTES;
constexpr float AT_C1 = 0.125f * 1.4426950408889634f;
__device__ __forceinline__ float fexp2(float x) { return __builtin_amdgcn_exp2f(x); }
__device__ __forceinline__ float flog2(float x) { return __builtin_amdgcn_logf(x); }

template <int MODE> __device__ __forceinline__ void attn_unit(const bf16_t* __restrict__ QKV, bf16_t* __restrict__ OC, const float* __restrict__ KM, const unsigned* __restrict__ MASK,
                                                              int b, int h, int qb, lds_u8* lds, int wid, int lane) {
    constexpr int cq = MODE == 0 ? CQ_SB : MODE == 1 ? CQ_MB : CQ_DS, ck = MODE == 0 ? CK_SB : MODE == 1 ? CK_MB : CK_DS, cv = MODE == 0 ? CV_SB : MODE == 1 ? CV_MB : CV_DS;
    constexpr int co = MODE == 0 ? CO_SB : MODE == 1 ? CO_MB : CO_DS;
    const int c = lane & 31, hh = lane >> 5, tid = wid * 64 + lane;
    const int q0 = qb * 256, tq = q0 + 32 * wid + c;
    const size_t rowq = (size_t)b * SEQ + tq;
    bf16x8_t qf[4];
#pragma unroll
    for (int ds = 0; ds < 4; ++ds) qf[ds] = *(const bf16x8_t*)(QKV + rowq * QKV_PITCH + cq + h * 64 + ds * 16 + hh * 8);
    float slope2 = 0.f; unsigned selm = 0u;
    if (MODE != 0) slope2 = exp2f(-0.8f * (float)(MODE == 1 ? (2 * h + 1) : (2 * h + 2))) * 1.4426950408889634f;
    if (MODE == 1) {
        float gate[8];
#pragma unroll
        for (int n = 0; n < 8; ++n) {
            gate[n] = -1e30f;
            if (n < qb) {
                const float* km = KM + (((size_t)b * 8 + n) * 5 + h) * 64 + hh * 8;
                float gs = 0.f;
#pragma unroll
                for (int ds = 0; ds < 4; ++ds) {
                    const f32x4 k0 = *(const f32x4*)(km + ds * 16), k1 = *(const f32x4*)(km + ds * 16 + 4);
                    const bf16x8_t qv = qf[ds];
                    gs += bf2f((unsigned short)qv[0]) * k0[0] + bf2f((unsigned short)qv[1]) * k0[1] + bf2f((unsigned short)qv[2]) * k0[2] + bf2f((unsigned short)qv[3]) * k0[3]
                        + bf2f((unsigned short)qv[4]) * k1[0] + bf2f((unsigned short)qv[5]) * k1[1] + bf2f((unsigned short)qv[6]) * k1[2] + bf2f((unsigned short)qv[7]) * k1[3];
                }
                gs += __shfl_xor(gs, 32);
                gate[n] = gs;
            }
        }
#pragma unroll
        for (int r = 0; r < 3; ++r) {
            float best = -3e38f; int bi = -1;
#pragma unroll
            for (int n = 0; n < 8; ++n) if (!((selm >> n) & 1u) && gate[n] > best) { best = gate[n]; bi = n; }
            if (bi >= 0) selm |= 1u << bi;
        }
        selm &= (1u << qb) - 1u;
    }
    f32x16_t o0, o1;
#pragma unroll
    for (int i = 0; i < 16; ++i) { o0[i] = 0.f; o1[i] = 0.f; }
    float m = -3e38f, l = 0.f, R = 0.f;
    const int jmax = 4 * qb + 3, jw = (q0 + 32 * wid + 31) >> 6;
    const bool isv = tid < 256;
    const int vchunk = (tid >> 5) & 7, vrp = tid & 31, krow = (tid & 255) >> 2, kcp = tid & 3;
    const bf16_t* gsrc0; const bf16_t* gsrc1;
    if (isv) { gsrc0 = QKV + ((size_t)b * SEQ + 2 * vrp) * QKV_PITCH + cv + h * 64 + vchunk * 8; gsrc1 = gsrc0 + QKV_PITCH; }
    else { gsrc0 = QKV + ((size_t)b * SEQ + krow) * QKV_PITCH + ck + h * 64 + kcp * 16; gsrc1 = gsrc0 + 8; }
    const int rho = c, kperm = 16 * ((rho >> 2) & 1) + (rho & 3) + 4 * (rho >> 3);
    const int kfoff = kperm * AT_PITCH + hh * 16;
    const int vfoff = AT_KBYTES + c * AT_PITCH + hh * 32;
    const unsigned* mrow = MASK + rowq * 64;
    u32x4 st0, st1; u32x2 mwn = (u32x2){0u, 0u}, mwc = (u32x2){0u, 0u};
#define AT_LOAD(j) do { st0 = *(const u32x4*)(gsrc0 + (size_t)(j) * 64 * QKV_PITCH); st1 = *(const u32x4*)(gsrc1 + (size_t)(j) * 64 * QKV_PITCH); if (MODE == 2) mwn = *(const u32x2*)(mrow + 2 * (j)); } while (0)
#define AT_STORE(bufi) do { lds_u8* bb = lds + (bufi) * AT_BUF; \
        if (isv) { lds_u8* vb = bb + AT_KBYTES + (vchunk * 8) * AT_PITCH + vrp * 4; \
            *(__attribute__((address_space(3))) unsigned*)(vb + 0 * AT_PITCH) = (st0.x & 0xffffu) | (st1.x << 16); *(__attribute__((address_space(3))) unsigned*)(vb + 1 * AT_PITCH) = (st0.x >> 16) | (st1.x & 0xffff0000u); \
            *(__attribute__((address_space(3))) unsigned*)(vb + 2 * AT_PITCH) = (st0.y & 0xffffu) | (st1.y << 16); *(__attribute__((address_space(3))) unsigned*)(vb + 3 * AT_PITCH) = (st0.y >> 16) | (st1.y & 0xffff0000u); \
            *(__attribute__((address_space(3))) unsigned*)(vb + 4 * AT_PITCH) = (st0.z & 0xffffu) | (st1.z << 16); *(__attribute__((address_space(3))) unsigned*)(vb + 5 * AT_PITCH) = (st0.z >> 16) | (st1.z & 0xffff0000u); \
            *(__attribute__((address_space(3))) unsigned*)(vb + 6 * AT_PITCH) = (st0.w & 0xffffu) | (st1.w << 16); *(__attribute__((address_space(3))) unsigned*)(vb + 7 * AT_PITCH) = (st0.w >> 16) | (st1.w & 0xffff0000u); } \
        else { lds_u8* kb_ = bb + krow * AT_PITCH + kcp * 32; *(__attribute__((address_space(3))) u32x4*)(kb_) = st0; *(__attribute__((address_space(3))) u32x4*)(kb_ + 16) = st1; } } while (0)
    AT_LOAD(jmax); AT_STORE(0); mwc = mwn;
    __syncthreads();
    for (int j = jmax; j >= 0; --j) {
        const int bufi = (jmax - j) & 1;
        if (j > 0) AT_LOAD(j - 1);
        if (j <= jw) {
            const lds_u8* bb = lds + bufi * AT_BUF;
#pragma unroll
            for (int s2 = 1; s2 >= 0; --s2) {
                const int kb = 64 * j + 32 * s2;
                if (kb > q0 + 32 * wid + 31) continue;
                f32x16_t S;
#pragma unroll
                for (int i = 0; i < 16; ++i) S[i] = 0.f;
#pragma unroll
                for (int ds = 0; ds < 4; ++ds) {
                    const bf16x8_t kf = *(const __attribute__((address_space(3))) bf16x8_t*)(bb + kfoff + s2 * 32 * AT_PITCH + ds * 32);
                    S = __builtin_amdgcn_mfma_f32_32x32x16_bf16(kf, qf[ds], S, 0, 0, 0);
                }
                unsigned vm;
                const int k0 = kb + 16 * hh;
                if (MODE == 0) { int nv = tq - k0; nv = nv < 0 ? 0 : (nv > 16 ? 16 : nv); vm = (1u << nv) - 1u; }
                else if (MODE == 1) { if (j >= 4 * qb) { int nv = tq - k0 + 1; nv = nv < 0 ? 0 : (nv > 16 ? 16 : nv); vm = (1u << nv) - 1u; } else vm = ((selm >> (j >> 2)) & 1u) ? 0xffffu : 0u; }
                else { vm = ((s2 ? mwc.y : mwc.x) >> (16 * hh)) & 0xffffu; }
                const bool allv = __ballot(vm != 0xffffu) == 0ull;
                float P[16];
                if (MODE == 0) {
                    float zs[16], cs[16];
#pragma unroll
                    for (int i = 0; i < 16; ++i) {
                        const float zl = S[i] * AT_C1;
                        float sp = fmaxf(zl, 0.f) + flog2(1.f + fexp2(-fabsf(zl)));
                        if (!allv) sp = ((vm >> i) & 1u) ? sp : 0.f;
                        zs[i] = zl; cs[i] = sp;
                    }
                    float run = 0.f;
#pragma unroll
                    for (int i = 15; i >= 0; --i) { run += cs[i]; cs[i] = run; }
                    const float other = __shfl_xor(run, 32);
                    const float base = R + (hh == 0 ? other : 0.f);
#pragma unroll
                    for (int i = 0; i < 16; ++i) { float a = fexp2(zs[i] - (base + cs[i])); if (!allv) a = ((vm >> i) & 1u) ? a : 0.f; P[i] = a; }
                    R += run + other;
                } else {
                    const float bias0 = slope2 * (float)(k0 - tq);
                    float mloc = -3e38f;
#pragma unroll
                    for (int i = 0; i < 16; ++i) { float s = S[i] * AT_C1 + (bias0 + slope2 * (float)i); if (!allv) s = ((vm >> i) & 1u) ? s : -3e38f; P[i] = s; mloc = fmaxf(mloc, s); }
                    mloc = fmaxf(mloc, __shfl_xor(mloc, 32));
                    const float mnew = fmaxf(m, mloc);
                    if (__ballot(mnew > m) != 0ull) {
                        const float alpha = fexp2(m - mnew);
#pragma unroll
                        for (int i = 0; i < 16; ++i) { o0[i] *= alpha; o1[i] *= alpha; }
                        l *= alpha;
                    }
                    m = mnew;
#pragma unroll
                    for (int i = 0; i < 16; ++i) { float pe = fexp2(P[i] - mnew); if (!allv) pe = ((vm >> i) & 1u) ? pe : 0.f; l += pe; P[i] = pe; }
                }
                bf16x8_t pf0, pf1;
                { u32x4 w0, w1;
                  w0.x = cvt_pk(P[0], P[1]); w0.y = cvt_pk(P[2], P[3]); w0.z = cvt_pk(P[4], P[5]); w0.w = cvt_pk(P[6], P[7]);
                  w1.x = cvt_pk(P[8], P[9]); w1.y = cvt_pk(P[10], P[11]); w1.z = cvt_pk(P[12], P[13]); w1.w = cvt_pk(P[14], P[15]);
                  pf0 = __builtin_bit_cast(bf16x8_t, w0); pf1 = __builtin_bit_cast(bf16x8_t, w1); }
                {
                    const bf16x8_t v00 = *(const __attribute__((address_space(3))) bf16x8_t*)(bb + vfoff + s2 * 64);
                    const bf16x8_t v01 = *(const __attribute__((address_space(3))) bf16x8_t*)(bb + vfoff + s2 * 64 + 16);
                    const bf16x8_t v10 = *(const __attribute__((address_space(3))) bf16x8_t*)(bb + vfoff + 32 * AT_PITCH + s2 * 64);
                    const bf16x8_t v11 = *(const __attribute__((address_space(3))) bf16x8_t*)(bb + vfoff + 32 * AT_PITCH + s2 * 64 + 16);
                    o0 = __builtin_amdgcn_mfma_f32_32x32x16_bf16(v00, pf0, o0, 0, 0, 0);
                    o0 = __builtin_amdgcn_mfma_f32_32x32x16_bf16(v01, pf1, o0, 0, 0, 0);
                    o1 = __builtin_amdgcn_mfma_f32_32x32x16_bf16(v10, pf0, o1, 0, 0, 0);
                    o1 = __builtin_amdgcn_mfma_f32_32x32x16_bf16(v11, pf1, o1, 0, 0, 0);
                }
            }
        }
        if (j > 0) AT_STORE(bufi ^ 1);
        mwc = mwn;
        __syncthreads();
    }
#undef AT_LOAD
#undef AT_STORE
    float sc = 1.f;
    if (MODE != 0) { l += __shfl_xor(l, 32); sc = 1.f / l; }
    bf16_t* orow = OC + rowq * OC_PITCH + co + h * 64 + 4 * hh;
#pragma unroll
    for (int g = 0; g < 4; ++g) {
        u32x2 w; w.x = cvt_pk(o0[4 * g] * sc, o0[4 * g + 1] * sc); w.y = cvt_pk(o0[4 * g + 2] * sc, o0[4 * g + 3] * sc);
        *(u32x2*)(orow + 8 * g) = w;
        u32x2 w2; w2.x = cvt_pk(o1[4 * g] * sc, o1[4 * g + 1] * sc); w2.y = cvt_pk(o1[4 * g + 2] * sc, o1[4 * g + 3] * sc);
        *(u32x2*)(orow + 32 + 8 * g) = w2;
    }
}
template <int MODEMASK> __device__ __forceinline__ void phase_fast_attn(const Params& p, unsigned char* lds_raw, Ctx cx) {
    const bf16_t* QKV = (const bf16_t*)(p.ws + WS_R1); bf16_t* OC = (bf16_t*)(p.ws + WS_R2);
    const float* KM = (const float*)(p.ws + WS_KMEAN); const unsigned* MASK = (const unsigned*)(p.ws + WS_MASK);
    lds_u8* lds = (lds_u8*)lds_raw;
    const int lane = lane_id_opaque();
    constexpr int NBH = ((MODEMASK & 1) ? BATCH * H_SB : 0) + ((MODEMASK & 2) ? BATCH * H_MB : 0) + ((MODEMASK & 4) ? BATCH * H_DS : 0);
    for (int u = cx.bid; u < NBH * 8; u += cx.nblk) {
        const int qb = 7 - u / NBH; int r = u % NBH;
        if (MODEMASK & 1) { if (r < BATCH * H_SB) { attn_unit<0>(QKV, OC, KM, MASK, r / H_SB, r % H_SB, qb, lds, cx.wid, lane); continue; } r -= BATCH * H_SB; }
        if (MODEMASK & 2) { if (r < BATCH * H_MB) { attn_unit<1>(QKV, OC, KM, MASK, r / H_MB, r % H_MB, qb, lds, cx.wid, lane); continue; } r -= BATCH * H_MB; }
        if (MODEMASK & 4) { attn_unit<2>(QKV, OC, KM, MASK, r / H_DS, r % H_DS, qb, lds, cx.wid, lane); }
    }
}

typedef float f32x4_t __attribute__((ext_vector_type(4)));
constexpr int TK_QPITCH = 1040, TK_SKPITCH = 8208, TK_SK_OFF = 16 * TK_QPITCH;
constexpr int TK_LDS_END = TK_SK_OFF + 16 * TK_SKPITCH;
__device__ __forceinline__ void topk_select_row(const unsigned (&key)[32], int t, unsigned* mrow, int lane) {
    unsigned w = 0u;
    if (t + 1 <= 256) {
#pragma unroll
        for (int i = 0; i < 32; ++i) { const unsigned long long sb = __ballot(key[i] != 0u); if ((lane >> 1) == i) w = (lane & 1) ? (unsigned)(sb >> 32) : (unsigned)sb; }
    } else {
        unsigned Tk = 0u;
#pragma unroll 1
        for (int bit = 31; bit >= 0; --bit) {
            const unsigned cand = Tk | (1u << bit);
            int cnt = 0;
#pragma unroll
            for (int i = 0; i < 32; ++i) cnt += __popcll(__ballot(key[i] >= cand));
            if (cnt >= 256) Tk = cand;
        }
        int cgt = 0;
#pragma unroll
        for (int i = 0; i < 32; ++i) cgt += __popcll(__ballot(key[i] > Tk));
        int need = 256 - cgt;
#pragma unroll
        for (int i = 0; i < 32; ++i) {
            const unsigned long long gtb = __ballot(key[i] > Tk), eqb = __ballot(key[i] == Tk);
            unsigned long long take = 0ull;
            const int ne = __popcll(eqb);
            if (need > 0 && ne > 0) {
                if (ne <= need) { take = eqb; need -= ne; }
                else { unsigned long long rem = eqb; for (int q = 0; q < need; ++q) { const unsigned long long low = rem & (~rem + 1ull); take |= low; rem ^= low; } need = 0; }
            }
            const unsigned long long sb = gtb | take;
            if ((lane >> 1) == i) w = (lane & 1) ? (unsigned)(sb >> 32) : (unsigned)sb;
        }
    }
    mrow[lane] = w;
}
__device__ __forceinline__ void topk_unit(const bf16_t* __restrict__ QKV, unsigned* __restrict__ MASK, int b, int g, lds_u8* lds, int wid, int lane) {
    const int t0 = 16 * g; const size_t r0 = (size_t)b * SEQ + t0;
    if (t0 + 15 < 256) {
#pragma unroll
        for (int qq = 0; qq < 2; ++qq) { const int q = 2 * wid + qq, t = t0 + q, lo = 32 * lane;
            const unsigned w = (lo + 31 <= t) ? 0xffffffffu : (lo > t ? 0u : ((1u << (t - lo + 1)) - 1u));
            MASK[(r0 + q) * 64 + lane] = w; }
        return;
    }
    const int tid = wid * 64 + lane, qn = lane & 15, kg = lane >> 4;
#pragma unroll
    for (int k = 0; k < 2; ++k) { const int idx = tid + 512 * k, row = idx >> 6, ch = idx & 63;
        *(__attribute__((address_space(3))) u32x4*)(lds + row * TK_QPITCH + ch * 16) = *(const u32x4*)(QKV + (r0 + row) * QKV_PITCH + CQ_IX + ch * 8); }
    float wq[8];
    { const u32x4 w = *(const u32x4*)(QKV + (r0 + qn) * QKV_PITCH + CW_IX);
      wq[0] = bflo(w.x); wq[1] = bfhi(w.x); wq[2] = bflo(w.y); wq[3] = bfhi(w.y); wq[4] = bflo(w.z); wq[5] = bfhi(w.z); wq[6] = bflo(w.w); wq[7] = bfhi(w.w); }
    __syncthreads();
    const int ntiles = g + 1, ntr = (ntiles + 3) & ~3;
    const int tq = t0 + qn;
    for (int kt = wid; kt < ntr; kt += 8) {
        u32x4 outw = (u32x4){0u, 0u, 0u, 0u};
        if (kt < ntiles) {
            const bf16_t* kp = QKV + ((size_t)b * SEQ + 16 * kt + qn) * QKV_PITCH + CK_IX + 8 * kg;
            const bf16x8_t a0 = *(const bf16x8_t*)(kp), a1 = *(const bf16x8_t*)(kp + 32);
            f32x4_t sc = (f32x4_t){0.f, 0.f, 0.f, 0.f};
#pragma unroll
            for (int hd = 0; hd < 8; ++hd) {
                const bf16x8_t b0 = *(const __attribute__((address_space(3))) bf16x8_t*)(lds + qn * TK_QPITCH + (hd * 64 + 8 * kg) * 2);
                const bf16x8_t b1 = *(const __attribute__((address_space(3))) bf16x8_t*)(lds + qn * TK_QPITCH + (hd * 64 + 32 + 8 * kg) * 2);
                f32x4_t acc = (f32x4_t){0.f, 0.f, 0.f, 0.f};
                acc = __builtin_amdgcn_mfma_f32_16x16x32_bf16(a0, b0, acc, 0, 0, 0);
                acc = __builtin_amdgcn_mfma_f32_16x16x32_bf16(a1, b1, acc, 0, 0, 0);
#pragma unroll
                for (int r = 0; r < 4; ++r) sc[r] += wq[hd] * fmaxf(acc[r], 0.f);
            }
            unsigned ok[4];
#pragma unroll
            for (int r = 0; r < 4; ++r) { float s = sc[r]; if (s == 0.f) s = 0.f; ok[r] = (16 * kt + 4 * kg + r <= tq) ? ordkey(s) : 0u; }
            outw = (u32x4){ok[0], ok[1], ok[2], ok[3]};
        }
        *(__attribute__((address_space(3))) u32x4*)(lds + TK_SK_OFF + qn * TK_SKPITCH + (16 * kt + 4 * kg) * 4) = outw;
    }
    __syncthreads();
#pragma unroll 1
    for (int qq = 0; qq < 2; ++qq) {
        const int q = 2 * wid + qq, t = t0 + q, ni = (t >> 6) + 1;
        unsigned key[32];
#pragma unroll
        for (int i = 0; i < 32; ++i) key[i] = (i < ni) ? *(const __attribute__((address_space(3))) unsigned*)(lds + TK_SK_OFF + q * TK_SKPITCH + (i * 64 + lane) * 4) : 0u;
        topk_select_row(key, t, MASK + (r0 + q) * 64, lane);
    }
    __syncthreads();
}
__device__ __forceinline__ void kmean_item(const bf16_t* __restrict__ QKV, float* __restrict__ KM, int item, lds_u8* lds, int wid, int lane) {
    const int h = item % 5, n = (item / 5) % 8, b = item / 40, tid = wid * 64 + lane, c8 = tid & 7, rg = tid >> 3;
    const bf16_t* kp = QKV + ((size_t)b * SEQ + n * 256 + rg) * QKV_PITCH + CK_MB + h * 64 + c8 * 8;
    float a[8];
#pragma unroll
    for (int e = 0; e < 8; ++e) a[e] = 0.f;
#pragma unroll
    for (int r = 0; r < 4; ++r) { const u32x4 w = *(const u32x4*)(kp + (size_t)(64 * r) * QKV_PITCH);
        a[0] += bflo(w.x); a[1] += bfhi(w.x); a[2] += bflo(w.y); a[3] += bfhi(w.y); a[4] += bflo(w.z); a[5] += bfhi(w.z); a[6] += bflo(w.w); a[7] += bfhi(w.w); }
    __attribute__((address_space(3))) float* red = (__attribute__((address_space(3))) float*)lds;
#pragma unroll
    for (int e = 0; e < 8; ++e) red[rg * 65 + c8 * 8 + e] = a[e];
    __syncthreads();
    if (tid < 64) { float s = 0.f;
#pragma unroll 8
        for (int r = 0; r < 64; ++r) s += red[r * 65 + tid];
        KM[(size_t)item * 64 + tid] = s * (1.f / 256.f); }
    __syncthreads();
}
__device__ __forceinline__ int queue_pop(unsigned* ctr, lds_u8* lds, int tid) {
    __attribute__((address_space(3))) volatile int* slot = (__attribute__((address_space(3))) volatile int*)(lds + QUEUE_SLOT_OFF);
    if (tid == 0) *slot = (int)__hip_atomic_fetch_add(ctr, 1u, __ATOMIC_RELAXED, __HIP_MEMORY_SCOPE_AGENT);
    __syncthreads();
    const int u = *slot;
    __syncthreads();
    return u;
}
__device__ __forceinline__ void phase_attn_a(const Params& p, unsigned char* lds_raw, int l, Ctx cx, int rep = 0) {
    const bf16_t* QKV = (const bf16_t*)(p.ws + WS_R1); bf16_t* OC = (bf16_t*)(p.ws + WS_R2);
    float* KM = (float*)(p.ws + WS_KMEAN); unsigned* MASK = (unsigned*)(p.ws + WS_MASK);
    unsigned* ctr = (unsigned*)(p.ws + WS_CTR) + 64 * (2 * l + 4 * rep);
    lds_u8* lds = (lds_u8*)lds_raw;
    const int lane = lane_id_opaque(), tid = cx.wid * 64 + lane;
    constexpr int N_SB = BATCH * H_SB * 8, N_TK = BATCH * 128, N_KM = 320;
    for (;;) {
        int u = queue_pop(ctr, lds, tid);
        if (u >= N_SB + N_TK + N_KM) break;
        if (u < N_SB) { const int qb = 7 - u / (BATCH * H_SB), r = u % (BATCH * H_SB); attn_unit<0>(QKV, OC, KM, MASK, r / H_SB, r % H_SB, qb, lds, cx.wid, lane); continue; }
        u -= N_SB;
        if (u < N_TK) { const int g = 127 - u / BATCH, b = u % BATCH; topk_unit(QKV, MASK, b, g, lds, cx.wid, lane); continue; }
        u -= N_TK;
        kmean_item(QKV, KM, u, lds, cx.wid, lane);
    }
}
__device__ __forceinline__ void phase_attn_b(const Params& p, unsigned char* lds_raw, int l, Ctx cx, int rep = 0) {
    const bf16_t* QKV = (const bf16_t*)(p.ws + WS_R1); bf16_t* OC = (bf16_t*)(p.ws + WS_R2);
    const float* KM = (const float*)(p.ws + WS_KMEAN); const unsigned* MASK = (const unsigned*)(p.ws + WS_MASK);
    unsigned* ctr = (unsigned*)(p.ws + WS_CTR) + 64 * (2 * l + 1 + 4 * rep);
    lds_u8* lds = (lds_u8*)lds_raw;
    const int lane = lane_id_opaque(), tid = cx.wid * 64 + lane;
    constexpr int NBH = BATCH * (H_MB + H_DS);
    for (;;) {
        const int u = queue_pop(ctr, lds, tid);
        if (u >= NBH * 8) break;
        const int qb = 7 - u / NBH; int r = u % NBH;
        if (r < BATCH * H_MB) { attn_unit<1>(QKV, OC, KM, MASK, r / H_MB, r % H_MB, qb, lds, cx.wid, lane); continue; }
        r -= BATCH * H_MB;
        attn_unit<2>(QKV, OC, KM, MASK, r / H_DS, r % H_DS, qb, lds, cx.wid, lane);
    }
}

__device__ __forceinline__ void phase_zero_pad(const Params& p, Ctx cx) { const int wid = cx.wid, BID = cx.bid, NBLK = cx.nblk; (void)wid; (void)BID; (void)NBLK;
    bf16_t* OC = (bf16_t*)(p.ws + WS_R2);
    const int gt = BID * NTHREADS + TIDX, NT = NBLK * NTHREADS;
    for (int i = gt; i < T * 16; i += NT) {
        const int row = i >> 4, q = i & 15, col = (q < 8 ? 704 : 1088 - 64) + q * 8;
        *(u32x4*)(OC + (size_t)row * OC_PITCH + col) = (u32x4){0u, 0u, 0u, 0u};
    }
}

namespace pg8 {
#define PG8_LAS __attribute__((address_space(3)))
typedef unsigned short bf16_t;
typedef short bf16x8 __attribute__((ext_vector_type(8)));
typedef float f32x4 __attribute__((ext_vector_type(4)));
typedef unsigned u32x4 __attribute__((ext_vector_type(4)));
constexpr int BM = 256, BK = 64, HALF = 128, HTB = HALF * BK * 2  , STAGE_BYTES = 8 * HTB, NXCD = 8, WGM = 8;

__host__ __device__ __forceinline__ int lds_byte(int r, int c) { const int st = (r >> 4) * 2 + (c >> 5), rr = r & 15, cc = c & 31, ob = rr * 64 + cc * 2; return st * 1024 + (ob ^ (((ob >> 9) & 1) << 5)); }
__host__ __device__ __forceinline__ void stage_rc(int b, int& R, int& C) { const int st = b / 1024, sb = b % 1024, swz = sb ^ (((sb >> 9) & 1) << 5); R = (st >> 1) * 16 + swz / 64; C = (st & 1) * 32 + (swz % 64) / 2; }
__host__ __device__ __forceinline__ int perm32(int rho) { const int n = rho >> 4, i = rho & 15; return 8 * (i >> 2) + 4 * n + (i & 3); }

struct Unit { int pm, pn; };
struct Gemm { const bf16_t* A; const bf16_t* Bt; int M, N, K, lda; };

struct StaticOrder {
    int nM, nN, nwg, G, c;
    __host__ __device__ void init(int M, int N, int G_, int c_) { nM = M / BM; nN = N / BM; nwg = nM * nN; G = G_; c = c_; }
    __host__ __device__ bool next(int i, Unit& u) const {
        const long L = (long)i * G + c; if (L >= nwg) return false;
        int wgid = (int)L; { const int q = nwg / NXCD, r = nwg % NXCD, xcd = wgid % NXCD, off = wgid / NXCD; wgid = (xcd < r ? xcd * (q + 1) : r * (q + 1) + (xcd - r) * q) + off; }
        const int nig = WGM * nN, gid = wgid / nig, fm = gid * WGM, gsz = (nM - fm) < WGM ? (nM - fm) : WGM;
        u.pm = fm + ((wgid % nig) % gsz); u.pn = (wgid % nig) / gsz; return true;
    }
    __device__ __forceinline__ void a_ready(const Unit&) const {}
    __device__ __forceinline__ void done(const Unit&) const {}
};


typedef float f32x2_t __attribute__((ext_vector_type(2))); typedef __bf16 bf16x2_t __attribute__((ext_vector_type(2)));
__device__ __forceinline__ unsigned cvt_pk_bf16(float lo, float hi) { f32x2_t v = {lo, hi}; bf16x2_t b = __builtin_convertvector(v, bf16x2_t); return __builtin_bit_cast(unsigned, b); }
struct EpiBf16 {
    static constexpr bool PERM = true, AFTER_DRAIN = false;
    bf16_t* O; int ldc;
    __device__ __forceinline__ void operator()(const f32x4 (&acc)[2][2][4][2], const Unit& u, int wr, int wc, int fr, int fq) const {
        const int row0 = u.pm * BM + wr * 64 + fr, col0 = u.pn * BM + wc * 32 + 8 * fq;
#pragma unroll
        for (int ai = 0; ai < 2; ++ai)
#pragma unroll
            for (int m = 0; m < 4; ++m) { bf16_t* rowp = O + (size_t)(row0 + ai * HALF + m * 16) * ldc + col0;
#pragma unroll
                for (int bj = 0; bj < 2; ++bj) { const f32x4 v0 = acc[ai][bj][m][0], v1 = acc[ai][bj][m][1];
                    u32x4 w; w.x = cvt_pk_bf16(v0[0], v0[1]); w.y = cvt_pk_bf16(v0[2], v0[3]); w.z = cvt_pk_bf16(v1[0], v1[1]); w.w = cvt_pk_bf16(v1[2], v1[3]);
                    *(u32x4*)(rowp + bj * HALF) = w; } }
    }
};

__device__ __forceinline__ float fast_sigmoid(float v) { return __builtin_amdgcn_rcpf(1.f + __builtin_amdgcn_exp2f(-1.4426950408889634f * v)); }
struct EpiSigmoid {
    static constexpr bool PERM = true, AFTER_DRAIN = false;
    bf16_t* O; int ldc; const float* bias;
    __device__ __forceinline__ void operator()(const f32x4 (&acc)[2][2][4][2], const Unit& u, int wr, int wc, int fr, int fq) const {
        const int row0 = u.pm * BM + wr * 64 + fr, col0 = u.pn * BM + wc * 32 + 8 * fq;
        f32x4 bv[2][2];
#pragma unroll
        for (int bj = 0; bj < 2; ++bj)
#pragma unroll
            for (int n = 0; n < 2; ++n) bv[bj][n] = *(const f32x4*)(bias + col0 + bj * HALF + 4 * n);
#pragma unroll
        for (int ai = 0; ai < 2; ++ai)
#pragma unroll
            for (int m = 0; m < 4; ++m) { bf16_t* rowp = O + (size_t)(row0 + ai * HALF + m * 16) * ldc + col0;
#pragma unroll
                for (int bj = 0; bj < 2; ++bj) { const f32x4 v0 = acc[ai][bj][m][0] + bv[bj][0], v1 = acc[ai][bj][m][1] + bv[bj][1];
                    u32x4 w; w.x = cvt_pk_bf16(fast_sigmoid(v0[0]), fast_sigmoid(v0[1])); w.y = cvt_pk_bf16(fast_sigmoid(v0[2]), fast_sigmoid(v0[3]));
                    w.z = cvt_pk_bf16(fast_sigmoid(v1[0]), fast_sigmoid(v1[1])); w.w = cvt_pk_bf16(fast_sigmoid(v1[2]), fast_sigmoid(v1[3]));
                    *(u32x4*)(rowp + bj * HALF) = w; } }
    }
};
struct EpiGate {
    static constexpr bool PERM = true, AFTER_DRAIN = false;
    bf16_t* O; const bf16_t* gates; int br;
    __device__ __forceinline__ void operator()(const f32x4 (&acc)[2][2][4][2], const Unit& u, int wr, int wc, int fr, int fq) const {
        const int row0 = u.pm * BM + wr * 64 + fr, col0 = u.pn * BM + wc * 32 + 8 * fq;
#pragma unroll
        for (int ai = 0; ai < 2; ++ai)
#pragma unroll
            for (int m = 0; m < 4; ++m) { const size_t row = (size_t)(row0 + ai * HALF + m * 16);
#pragma unroll
                for (int bj = 0; bj < 2; ++bj) {
                    const u32x4 gw = *(const u32x4*)(gates + row * 3072 + br * 1024 + col0 + bj * HALF);
                    u32x4 ow = (u32x4){0u, 0u, 0u, 0u};
                    if (br > 0) ow = *(const u32x4*)(O + row * 1024 + col0 + bj * HALF);
                    const f32x4 v0 = acc[ai][bj][m][0], v1 = acc[ai][bj][m][1];
                    u32x4 w;
                    w.x = cvt_pk_bf16(__uint_as_float(ow.x << 16) + __uint_as_float(gw.x << 16) * v0[0], __uint_as_float(ow.x & 0xffff0000u) + __uint_as_float(gw.x & 0xffff0000u) * v0[1]);
                    w.y = cvt_pk_bf16(__uint_as_float(ow.y << 16) + __uint_as_float(gw.y << 16) * v0[2], __uint_as_float(ow.y & 0xffff0000u) + __uint_as_float(gw.y & 0xffff0000u) * v0[3]);
                    w.z = cvt_pk_bf16(__uint_as_float(ow.z << 16) + __uint_as_float(gw.z << 16) * v1[0], __uint_as_float(ow.z & 0xffff0000u) + __uint_as_float(gw.z & 0xffff0000u) * v1[1]);
                    w.w = cvt_pk_bf16(__uint_as_float(ow.w << 16) + __uint_as_float(gw.w << 16) * v1[2], __uint_as_float(ow.w & 0xffff0000u) + __uint_as_float(gw.w & 0xffff0000u) * v1[3]);
                    *(u32x4*)(O + row * 1024 + col0 + bj * HALF) = w; } }
    }
};
struct EpiSwiglu {
    static constexpr bool PERM = true, AFTER_DRAIN = false;
    bf16_t* O; int ldc;
    __device__ __forceinline__ void operator()(const f32x4 (&acc)[2][2][4][2], const Unit& u, int wr, int wc, int fr, int fq) const {
        const int row0 = u.pm * BM + wr * 64 + fr, col0 = u.pn * HALF + wc * 32 + 8 * fq;
#pragma unroll
        for (int ai = 0; ai < 2; ++ai)
#pragma unroll
            for (int m = 0; m < 4; ++m) { bf16_t* rowp = O + (size_t)(row0 + ai * HALF + m * 16) * ldc + col0;
                float o[8];
#pragma unroll
                for (int n = 0; n < 2; ++n)
#pragma unroll
                    for (int e = 0; e < 4; ++e) { const float gt = acc[ai][0][m][n][e]; o[n * 4 + e] = gt * fast_sigmoid(gt) * acc[ai][1][m][n][e]; }
                u32x4 w; w.x = cvt_pk_bf16(o[0], o[1]); w.y = cvt_pk_bf16(o[2], o[3]); w.z = cvt_pk_bf16(o[4], o[5]); w.w = cvt_pk_bf16(o[6], o[7]);
                *(u32x4*)rowp = w; }
    }
};

template <class Epi, class Sched, bool ALIGN_EPI = false, bool SP2 = false>
__device__ __forceinline__ void gemm_phase(PG8_LAS unsigned char* lds, const Gemm g, const Sched& S, const Epi& E, int wid_in) {
    const int wid = wid_in, lane = lane_id_opaque(), tid = wid * 64 + lane, wr = wid >> 2, wc = wid & 3, fr = lane & 15, fq = lane >> 4;
    const int K = g.K, nt = K / BK;
    unsigned voffA[2], voffB[2];
#pragma unroll
    for (int i = 0; i < 2; ++i) { int R, C; stage_rc(tid * 16 + i * 8192, R, C); const int Rb = Epi::PERM ? ((R & ~31) + perm32(R & 31)) : R;
        voffA[i] = (unsigned)(R * g.lda + C) * 2u; voffB[i] = (unsigned)(Rb * K + C) * 2u; }
    const size_t kstep = (size_t)(BK * 2);
    const size_t hstepA = (size_t)HALF * g.lda * 2, hstepB = (size_t)HALF * K * 2;
    const size_t tstepA = 2 * hstepA, tstepB = 2 * hstepB;
    const unsigned ldsw = (unsigned)wid * 1024u;
    const int aoff = lds_byte(wr * 64 + fr, fq * 8), boff = lds_byte(wc * 32 + fr, fq * 8);
#define PG8_SA(b, h) (((b) * 2 + (h)) * HTB)
#define PG8_SB(b, h) ((4 + (b) * 2 + (h)) * HTB)
#define PG8_STAGE(bufoff, gbase, voff) do { _Pragma("unroll") for (int _i = 0; _i < 2; ++_i) \
        __builtin_amdgcn_global_load_lds((const unsigned*)((const char*)(gbase) + (voff)[_i]), (PG8_LAS unsigned*)(lds + (bufoff) + ldsw + _i * 8192), 16, 0, 0); } while (0)
#define PG8_LDA(dst, b, h) do { _Pragma("unroll") for (int m = 0; m < 4; ++m) _Pragma("unroll") for (int k = 0; k < 2; ++k) dst[m][k] = *(const PG8_LAS bf16x8*)(lds + PG8_SA(b, h) + aoff + m * 2048 + k * 1024); } while (0)
#define PG8_LDB(dst, b, h) do { _Pragma("unroll") for (int n = 0; n < 2; ++n) _Pragma("unroll") for (int k = 0; k < 2; ++k) dst[n][k] = *(const PG8_LAS bf16x8*)(lds + PG8_SB(b, h) + boff + n * 2048 + k * 1024); } while (0)
#define PG8_MMA(ai, bj, At, Bt) do { __builtin_amdgcn_s_setprio(1); _Pragma("unroll") for (int m = 0; m < 4; ++m) _Pragma("unroll") for (int n = 0; n < 2; ++n) _Pragma("unroll") for (int k = 0; k < 2; ++k) \
        acc[ai][bj][m][n] = __builtin_amdgcn_mfma_f32_16x16x32_bf16(Bt[n][k], At[m][k], acc[ai][bj][m][n], 0, 0, 0); __builtin_amdgcn_s_setprio(0); } while (0)
#define PG8_WAIT_V(n) asm volatile("s_waitcnt vmcnt(" #n ")" ::: "memory")
#define PG8_WAIT_L(n) asm volatile("s_waitcnt lgkmcnt(" #n ")" ::: "memory")
#define PG8_BAR __builtin_amdgcn_s_barrier()
#define PG8_SCHED __builtin_amdgcn_sched_barrier(0)
    Unit cur, nxt; int ui = 0;
    if (!S.next(0, cur)) return;
    f32x4 acc[2][2][4][2];
#pragma unroll
    for (int a = 0; a < 2; ++a)
#pragma unroll
        for (int b = 0; b < 2; ++b)
#pragma unroll
            for (int m = 0; m < 4; ++m)
#pragma unroll
                for (int n = 0; n < 2; ++n) acc[a][b][m][n] = (f32x4){0.f, 0.f, 0.f, 0.f};
    bf16x8 At[4][2], B0[2][2], B1[2][2];
    const char* cA = (const char*)g.A + (size_t)cur.pm * tstepA; const char* cB = (const char*)g.Bt + (size_t)cur.pn * tstepB;
    S.a_ready(cur);
    if constexpr (SP2) {
        PG8_STAGE(PG8_SB(0, 0), cB, voffB); PG8_STAGE(PG8_SB(0, 1), cB + hstepB, voffB); PG8_STAGE(PG8_SA(0, 0), cA, voffA); PG8_STAGE(PG8_SA(0, 1), cA + hstepA, voffA);
        if (wr == 1) PG8_BAR;
        PG8_WAIT_V(2); PG8_BAR;
        PG8_STAGE(PG8_SB(1, 0), cB + kstep, voffB); PG8_STAGE(PG8_SA(1, 0), cA + kstep, voffA); PG8_STAGE(PG8_SB(1, 1), cB + hstepB + kstep, voffB);
        PG8_WAIT_V(6); PG8_BAR;
    } else {
        PG8_STAGE(PG8_SB(0, 0), cB, voffB); PG8_STAGE(PG8_SA(0, 0), cA, voffA); PG8_STAGE(PG8_SB(0, 1), cB + hstepB, voffB); PG8_STAGE(PG8_SA(0, 1), cA + hstepA, voffA);
        if (wr == 1) PG8_BAR;
        PG8_WAIT_V(4); PG8_BAR;
        PG8_STAGE(PG8_SB(1, 0), cB + kstep, voffB); PG8_STAGE(PG8_SA(1, 0), cA + kstep, voffA); PG8_STAGE(PG8_SB(1, 1), cB + hstepB + kstep, voffB);
        PG8_WAIT_V(6); PG8_BAR;
    }
    for (;;) {
        const bool has_next = S.next(ui + 1, nxt);
        const char* nA = has_next ? (const char*)g.A + (size_t)nxt.pm * tstepA : cA; const char* nB = has_next ? (const char*)g.Bt + (size_t)nxt.pn * tstepB : cB;
        for (int t = 0; t < nt; t += 2) {
            const bool last = (t == nt - 2);
            const char* a1 = cA + (size_t)(t + 1) * kstep;
            const char* a2 = last ? nA : cA + (size_t)(t + 2) * kstep; const char* b2 = last ? nB : cB + (size_t)(t + 2) * kstep;
            const char* a3 = a2 + kstep; const char* b3 = b2 + kstep;
            if (last && has_next) S.a_ready(nxt);
            if constexpr (SP2) {
            PG8_LDB(B0, 0, 0); PG8_LDB(B1, 0, 1); PG8_SCHED; PG8_LDA(At, 0, 0); PG8_STAGE(PG8_SA(1, 1), a1 + hstepA, voffA);
            PG8_WAIT_V(8); PG8_WAIT_L(0); PG8_BAR; PG8_MMA(0, 0, At, B0); PG8_MMA(0, 1, At, B1); PG8_BAR; PG8_SCHED;
            PG8_LDA(At, 0, 1); PG8_STAGE(PG8_SB(0, 0), b2, voffB); PG8_STAGE(PG8_SB(0, 1), b2 + hstepB, voffB); PG8_STAGE(PG8_SA(0, 0), a2, voffA);
            PG8_WAIT_V(8); PG8_WAIT_L(0); PG8_BAR; PG8_MMA(1, 0, At, B0); PG8_MMA(1, 1, At, B1); PG8_BAR; PG8_SCHED;
            PG8_LDB(B0, 1, 0); PG8_LDB(B1, 1, 1); PG8_SCHED; PG8_LDA(At, 1, 0); PG8_STAGE(PG8_SA(0, 1), a2 + hstepA, voffA);
            PG8_WAIT_V(8); PG8_WAIT_L(0); PG8_BAR; PG8_MMA(0, 0, At, B0); PG8_MMA(0, 1, At, B1); PG8_BAR; PG8_SCHED;
            PG8_LDA(At, 1, 1); PG8_STAGE(PG8_SB(1, 0), b3, voffB); PG8_STAGE(PG8_SB(1, 1), b3 + hstepB, voffB); PG8_STAGE(PG8_SA(1, 0), a3, voffA);
            PG8_WAIT_V(8); PG8_WAIT_L(0); PG8_BAR; PG8_MMA(1, 0, At, B0); PG8_MMA(1, 1, At, B1); PG8_BAR; PG8_SCHED;
            } else {
            PG8_LDB(B0, 0, 0); PG8_SCHED; PG8_LDA(At, 0, 0); PG8_STAGE(PG8_SA(1, 1), a1 + hstepA, voffA);
            PG8_WAIT_L(8); PG8_BAR; PG8_WAIT_L(0); PG8_MMA(0, 0, At, B0); PG8_BAR; PG8_SCHED;
            PG8_LDB(B1, 0, 1); PG8_STAGE(PG8_SB(0, 0), b2, voffB);
            PG8_BAR; PG8_WAIT_L(0); PG8_MMA(0, 1, At, B1); PG8_BAR;
            PG8_LDA(At, 0, 1); PG8_STAGE(PG8_SA(0, 0), a2, voffA);
            PG8_BAR; PG8_WAIT_L(0); PG8_MMA(1, 0, At, B0); PG8_BAR; PG8_SCHED;
            PG8_STAGE(PG8_SB(0, 1), b2 + hstepB, voffB);
            PG8_WAIT_V(6); PG8_BAR; PG8_MMA(1, 1, At, B1); PG8_BAR;
            PG8_LDB(B0, 1, 0); PG8_SCHED; PG8_LDA(At, 1, 0); PG8_STAGE(PG8_SA(0, 1), a2 + hstepA, voffA);
            PG8_WAIT_L(8); PG8_BAR; PG8_WAIT_L(0); PG8_MMA(0, 0, At, B0); PG8_BAR; PG8_SCHED;
            PG8_LDB(B1, 1, 1); PG8_STAGE(PG8_SB(1, 0), b3, voffB);
            PG8_BAR; PG8_WAIT_L(0); PG8_MMA(0, 1, At, B1); PG8_BAR;
            PG8_LDA(At, 1, 1); PG8_STAGE(PG8_SA(1, 0), a3, voffA);
            PG8_BAR; PG8_WAIT_L(0); PG8_MMA(1, 0, At, B0); PG8_BAR; PG8_SCHED;
            PG8_STAGE(PG8_SB(1, 1), b3 + hstepB, voffB);
            PG8_WAIT_V(6); PG8_BAR; PG8_MMA(1, 1, At, B1); PG8_BAR;
            }
        }
        if constexpr (ALIGN_EPI) { if (wr == 0) PG8_BAR; }
        if constexpr (!Epi::AFTER_DRAIN) { const int le_ = lane_id_opaque(); E(acc, cur, wr, wc, le_ & 15, le_ >> 4); S.done(cur); }
        if (!has_next) break;
#pragma unroll
        for (int a = 0; a < 2; ++a)
#pragma unroll
            for (int b = 0; b < 2; ++b)
#pragma unroll
                for (int m = 0; m < 4; ++m)
#pragma unroll
                    for (int n = 0; n < 2; ++n) acc[a][b][m][n] = (f32x4){0.f, 0.f, 0.f, 0.f};
        cur = nxt; cA = nA; cB = nB; ++ui;
        if constexpr (ALIGN_EPI) { if (wr == 1) PG8_BAR; }
    }
    PG8_WAIT_V(0);
    if constexpr (!ALIGN_EPI) { if (wr == 0) PG8_BAR; }
    PG8_BAR;
    if constexpr (Epi::AFTER_DRAIN) { E.fused(acc, cur, wr, wc, fr, fq, lds, wid, lane); S.done(cur); }
#undef PG8_SA
#undef PG8_SB
#undef PG8_STAGE
#undef PG8_LDA
#undef PG8_LDB
#undef PG8_MMA
#undef PG8_WAIT_V
#undef PG8_WAIT_L
#undef PG8_BAR
#undef PG8_SCHED
}
}


constexpr size_t WT_IN1 = 0;
constexpr size_t WT_G = WT_IN1 + (size_t)3840 * 1024 * 2;
constexpr size_t WT_PROJ = WT_G + (size_t)3072 * 1024 * 2;
constexpr size_t WT_O = WT_PROJ + (size_t)3 * 1024 * 384 * 2;
constexpr size_t WT_UP = WT_O + (size_t)1024 * 1024 * 2;
constexpr size_t WT_DOWN = WT_UP + (size_t)5632 * 1024 * 2;
constexpr size_t WT_END = WT_DOWN + (size_t)1024 * 2816 * 2;
static_assert(WS_WT + WT_END <= WS_R3, "weight copies fit");

__device__ __forceinline__ void tr_item(const float* W, int ldw, int col0, int Kv, int Nv, bf16_t* WT, int ldk, int k0, int n0, int drow0, float* scr, int lane) {
    const int nn = lane & 31; const bool nok = (n0 + nn) < Nv;
#pragma unroll 8
    for (int i = 0; i < 32; ++i) { const int kk = 2 * i + (lane >> 5);
        float v = 0.f; if (nok && (k0 + kk) < Kv) v = W[(size_t)(k0 + kk) * ldw + col0 + n0 + nn];
        scr[kk * 33 + nn] = v; }
    asm volatile("s_waitcnt lgkmcnt(0)" ::: "memory");
    const int c = lane & 7;
#pragma unroll
    for (int j = 0; j < 4; ++j) { const int n = (lane >> 3) + 8 * j; const float* s = scr + (8 * c) * 33 + n;
        u32x4 o; o.x = pk2(s[0 * 33], s[1 * 33]); o.y = pk2(s[2 * 33], s[3 * 33]); o.z = pk2(s[4 * 33], s[5 * 33]); o.w = pk2(s[6 * 33], s[7 * 33]);
        *(u32x4*)(WT + (size_t)(drow0 + n) * ldk + k0 + 8 * c) = o; }
    asm volatile("s_waitcnt lgkmcnt(0)" ::: "memory");
}
__device__ __forceinline__ void phase_weights(const Params& p, int l, float* lds, Ctx cx) { const int wid = cx.wid, BID = cx.bid, NBLK = cx.nblk; (void)wid; (void)BID; (void)NBLK;
    const int lane = lane_id_opaque(), wave = wid, gw = BID * NWAVES + wave, NGW = NBLK * NWAVES;
    float* scr = lds + wave * (64 * 33);
    unsigned char* wt = p.ws + WS_WT;
    constexpr int I_IN1 = 16 * 120, I_G = 16 * 96, I_P = 6 * 32, I_O = 16 * 32, I_UP = 16 * 176, I_DN = 44 * 32;
    constexpr int NITEMS = I_IN1 + I_G + 3 * I_P + I_O + I_UP + I_DN;
    const float* w_in = p.w_in + (size_t)l * DM * D_IN;
    for (int it = gw; it < NITEMS; it += NGW) {
        int r = it;
        if (r < I_IN1) { const int kb = r / 120, nb = r % 120; tr_item(w_in, D_IN, 0, 1024, NQ1, (bf16_t*)(wt + WT_IN1), 1024, kb * 64, nb * 32, nb * 32, scr, lane); continue; } r -= I_IN1;
        if (r < I_G) { const int kb = r / 96, nb = r % 96; tr_item(w_in, D_IN, NQ1, 1024, NGATE, (bf16_t*)(wt + WT_G), 1024, kb * 64, nb * 32, nb * 32, scr, lane); continue; } r -= I_G;
        if (r < 3 * I_P) { const int br = r / I_P, q = r % I_P, kb = q / 32, nb = q % 32;
            const float* W = br == 0 ? p.w_proj_sb + (size_t)l * 384 * DM : br == 1 ? p.w_proj_mb + (size_t)l * 320 * DM : p.w_proj_ds + (size_t)l * 320 * DM;
            tr_item(W, DM, 0, br == 0 ? 384 : 320, DM, (bf16_t*)(wt + WT_PROJ) + (size_t)br * 1024 * 384, 384, kb * 64, nb * 32, nb * 32, scr, lane); continue; } r -= 3 * I_P;
        if (r < I_O) { const int kb = r / 32, nb = r % 32; tr_item(p.w_o + (size_t)l * DM * DM, DM, 0, 1024, DM, (bf16_t*)(wt + WT_O), 1024, kb * 64, nb * 32, nb * 32, scr, lane); continue; } r -= I_O;
        if (r < I_UP) { const int kb = r / 176, nb = r % 176, n0 = nb * 32, bj = n0 / DFF, rr = n0 % DFF, drow0 = 256 * (rr / 128) + 128 * bj + (rr % 128);
            tr_item(p.w_up + (size_t)l * DM * 2 * DFF, 2 * DFF, 0, 1024, 2 * DFF, (bf16_t*)(wt + WT_UP), 1024, kb * 64, n0, drow0, scr, lane); continue; } r -= I_UP;
        { const int kb = r / 32, nb = r % 32; tr_item(p.w_down + (size_t)l * DFF * DM, DM, 0, DFF, DM, (bf16_t*)(wt + WT_DOWN), DFF, kb * 64, nb * 32, nb * 32, scr, lane); }
    }
}

#define XB_TMO      128
#define XB_XCNT(j)  (256  + 64 * (j))
#define XB_XSUB(j)  (1280 + 64 * (j))
#define XB_XGEN(j)  (2304 + 64 * (j))
#define XB_TOP      3328
#define XB_TOPGEN   3392
#define XCD_BAR_WORDS 3456
#define XB_SPIN_CAP (1u << 18)

__device__ __forceinline__ unsigned xb_ld(unsigned* p)              { return __hip_atomic_load(p, __ATOMIC_RELAXED, __HIP_MEMORY_SCOPE_AGENT); }
__device__ __forceinline__ unsigned xb_add(unsigned* p, unsigned v) { return __hip_atomic_fetch_add(p, v, __ATOMIC_RELAXED, __HIP_MEMORY_SCOPE_AGENT); }
__device__ __forceinline__ unsigned xb_xcc_id() { return (unsigned)__builtin_amdgcn_s_getreg((3 << 11) | 20) & 0xFu; }
#define XB_SPIN(cond, bar) do { unsigned _sp = 0; while (cond) { __builtin_amdgcn_s_sleep(1); \
    if ((++_sp & 255u) == 0u) { if (xb_ld(&(bar)[XB_TMO])) break; if (_sp > XB_SPIN_CAP) { atomicAdd(&(bar)[XB_TMO], 1u); break; } } } } while (0)

struct XcdBarrier {
    unsigned* bar; unsigned x;
    volatile __attribute__((address_space(3))) unsigned* st;
};

__device__ __forceinline__ XcdBarrier xcd_barrier_post(unsigned* bar, volatile __attribute__((address_space(3))) unsigned* st) {
    XcdBarrier b; b.bar = bar; b.x = xb_xcc_id(); b.st = st;
    if (threadIdx.x == 0) (void)xb_add(&bar[XB_XCNT(b.x)], 1u);
    return b;
}
__device__ __forceinline__ void xcd_barrier_complete(unsigned* bar, unsigned x, unsigned& nloc, unsigned& nx) {
    const unsigned G = gridDim.x * gridDim.y * gridDim.z;
    unsigned sum, cnt, mine, sp = 0u;
    for (;;) {
        sum = 0u; cnt = 0u; mine = 0u;
#pragma unroll
        for (unsigned j = 0; j < 16; ++j) { const unsigned c = xb_ld(&bar[XB_XCNT(j)]); sum += c; cnt += (c > 0u) ? 1u : 0u; mine = (j == x) ? c : mine; }
        if (sum == G) break;
        __builtin_amdgcn_s_sleep(1);
        if ((++sp & 255u) == 0u) { if (xb_ld(&bar[XB_TMO])) break; if (sp > XB_SPIN_CAP) { atomicAdd(&bar[XB_TMO], 1u); break; } }
    }
    nloc = mine > 0u ? mine : 1u; nx = cnt > 0u ? cnt : 1u;
}

__device__ __forceinline__ void xcd_barrier(const XcdBarrier& b) {
    asm volatile("s_waitcnt vmcnt(0)" ::: "memory");
    __syncthreads();
    if (threadIdx.x == 0) {
        unsigned* bar = b.bar;
        __builtin_amdgcn_s_waitcnt(0);
        unsigned nloc = b.st[0], nx = b.st[1];
        if (nloc == 0u) { xcd_barrier_complete(bar, b.x, nloc, nx); b.st[0] = nloc; b.st[1] = nx; }
        const unsigned old = xb_add(&bar[XB_XSUB(b.x)], 1u);
        const unsigned gen = old / nloc;
        if (old + 1u == (gen + 1u) * nloc) {
            __builtin_amdgcn_fence(__ATOMIC_RELEASE, "agent");
            asm volatile("s_waitcnt vmcnt(0)" ::: "memory");
            const unsigned og = xb_add(&bar[XB_TOP], 1u);
            const unsigned tg = og / nx;
            if (og + 1u == (tg + 1u) * nx) xb_add(&bar[XB_TOPGEN], 1u);
            else XB_SPIN(xb_ld(&bar[XB_TOPGEN]) == tg, bar);
            __builtin_amdgcn_fence(__ATOMIC_ACQUIRE, "agent");
            xb_add(&bar[XB_XGEN(b.x)], 1u);
            asm volatile("s_waitcnt vmcnt(0)" ::: "memory");
        } else {
            XB_SPIN(xb_ld(&bar[XB_XGEN(b.x)]) == gen, bar);
            __builtin_amdgcn_fence(__ATOMIC_ACQUIRE, "agent");
            asm volatile("s_waitcnt vmcnt(0)" ::: "memory");
        }
    }
    __syncthreads();
}

#define GRID_SYNC() do { XcdBarrier xb_; { kparams_t ppx_ = (kparams_t)__builtin_amdgcn_kernarg_segment_ptr(); asm volatile("" : "+s"(ppx_)); xb_.bar = (unsigned*)(ppx_->ws + WS_CTR) + CW_BAR; } \
    xb_.x = xb_xcc_id(); xb_.st = (volatile __attribute__((address_space(3))) unsigned*)((lds_u8*)lds_raw_ + XB_ST_OFF); xcd_barrier(xb_); } while (0)
#ifndef ATTN_QUEUE
#define ATTN_QUEUE 1
#endif
#ifndef ATTN_FAST
#define ATTN_FAST 7
#endif
#ifndef FASTMASK
#define FASTMASK 63
#endif
#define GRID_SYNC_CG() do { asm volatile("s_waitcnt vmcnt(0) lgkmcnt(0)" ::: "memory"); grid.sync(); __builtin_amdgcn_fence(__ATOMIC_ACQUIRE, "agent"); asm volatile("s_waitcnt vmcnt(0)" ::: "memory"); } while (0)
constexpr int RING_BYTES = 131072, LDS_BYTES = 151552;
static_assert(TK_LDS_END <= QUEUE_SLOT_OFF && QUEUE_SLOT_OFF + 16 <= LDS_BYTES, "LDS map");
typedef const __attribute__((address_space(4))) Params* kparams_t;
__device__ __forceinline__ Params load_params(kparams_t pp) {
    Params p; p.x = pp->x; p.c = pp->c; p.w_ada = pp->w_ada; p.b_ada = pp->b_ada; p.g_pre_mix = pp->g_pre_mix; p.g_post_mix = pp->g_post_mix; p.w_in = pp->w_in; p.b_gate = pp->b_gate;
    p.w_proj_sb = pp->w_proj_sb; p.w_proj_mb = pp->w_proj_mb; p.w_proj_ds = pp->w_proj_ds; p.w_o = pp->w_o; p.g_pre_ffn = pp->g_pre_ffn; p.g_post_ffn = pp->g_post_ffn; p.w_up = pp->w_up; p.w_down = pp->w_down;
    p.out = pp->out; p.ws = pp->ws; p.mask = pp->mask; return p;
}
__device__ __forceinline__ bool phase_on(int k) { kparams_t pp = (kparams_t)__builtin_amdgcn_kernarg_segment_ptr(); asm volatile("" : "+s"(pp)); unsigned long long m = pp->mask; asm volatile("" : "+s"(m)); return (m >> k) & 1ull; }
#define PHASE_BEGIN Ctx cx; { int b_ = blockIdx.x, g_ = gridDim.x, w_ = wid; asm volatile("" : "+s"(b_), "+s"(g_), "+s"(w_)); cx.bid = b_; cx.nblk = g_; cx.wid = w_; } kparams_t pp_ = (kparams_t)__builtin_amdgcn_kernarg_segment_ptr(); asm volatile("" : "+s"(pp_)); const Params p = load_params(pp_); \
    unsigned char* ws_ = p.ws; bf16_t* R1 = (bf16_t*)(ws_ + WS_R1); bf16_t* R2 = (bf16_t*)(ws_ + WS_R2); bf16_t* R3 = (bf16_t*)(ws_ + WS_R3); unsigned char* wt = ws_ + WS_WT; (void)R1; (void)R2; (void)R3; (void)wt;
#define PHX(k) phase_on(k)
#define PH(k) phase_on((k) + 16 * l)
template <int l> __device__ __forceinline__ void layer_body(cg::grid_group& grid, float* lds, PG8_LAS unsigned char* lds3, int wid) {
        unsigned char* lds_raw_ = (unsigned char*)lds;
        if (PH(0)) {
            PHASE_BEGIN
            if constexpr ((FASTMASK >> 0) & 1) {
            pg8::Gemm g{R3, (const bf16_t*)(wt + WT_IN1), T, QKV_PITCH, DM, DM}; pg8::StaticOrder S; S.init(T, QKV_PITCH, cx.nblk, cx.bid);
            pg8::EpiBf16 E{R1, QKV_PITCH};
            pg8::gemm_phase<pg8::EpiBf16, pg8::StaticOrder, true, true>(lds3, g, S, E, cx.wid);
            } else {
                NGemm<1> g; g.s[0] = NSeg{R3, DM, p.w_in + (size_t)l * DM * D_IN, D_IN, DM}; g.M = T; g.N = NQ1;
                NEpi e{R1, QKV_PITCH, nullptr, nullptr};
                naive_gemm<1, 0>(lds, g, e, cx);
            }
        }
        GRID_SYNC();
#if ATTN_QUEUE
        if (PH(1)) { PHASE_BEGIN phase_zero_pad(p, cx); __syncthreads(); phase_attn_a(p, lds_raw_, l, cx);
#ifdef PROBE_DUP_A
            __syncthreads(); phase_attn_a(p, lds_raw_, l, cx, 1);
#endif
        }
#else
        if (PH(1)) { PHASE_BEGIN phase_kmean(p, cx); phase_dsa_topk(p, lds, cx); }
        if (PH(2)) { PHASE_BEGIN if constexpr (!(ATTN_FAST & 1)) phase_naive_attn<0>(p, cx); phase_zero_pad(p, cx); if constexpr (ATTN_FAST & 1) { __syncthreads(); phase_fast_attn<1>(p, lds_raw_, cx); } }
#endif
        GRID_SYNC();
#if ATTN_QUEUE
        if (PH(3)) { PHASE_BEGIN phase_attn_b(p, lds_raw_, l, cx);
#ifdef PROBE_DUP_B
            __syncthreads(); phase_attn_b(p, lds_raw_, l, cx, 1);
#endif
        }
#else
        if (PH(3)) { PHASE_BEGIN if constexpr (!(ATTN_FAST & 2)) phase_naive_attn<1>(p, cx); }
        if (PH(3)) { PHASE_BEGIN if constexpr (!(ATTN_FAST & 4)) phase_naive_attn<2>(p, cx); }
        if (PH(3)) { PHASE_BEGIN if constexpr ((ATTN_FAST & 6) != 0) phase_fast_attn<(ATTN_FAST & 6)>(p, lds_raw_, cx); }
#endif
        GRID_SYNC();
        if (PH(4)) {
            PHASE_BEGIN
            if constexpr ((FASTMASK >> 1) & 1) {
            pg8::Gemm g{R3, (const bf16_t*)(wt + WT_G), T, NGATE, DM, DM}; pg8::StaticOrder S; S.init(T, NGATE, cx.nblk, cx.bid);
            pg8::EpiSigmoid E{R1, NGATE, p.b_gate + l * NGATE};
            pg8::gemm_phase<pg8::EpiSigmoid, pg8::StaticOrder, true, true>(lds3, g, S, E, cx.wid);
            } else {
                NGemm<1> g; g.s[0] = NSeg{R3, DM, p.w_in + (size_t)l * DM * D_IN + NQ1, D_IN, DM}; g.M = T; g.N = NGATE;
                NEpi e{R1, NGATE, p.b_gate + l * NGATE, nullptr};
                naive_gemm<1, 1>(lds, g, e, cx);
            }
        }
        GRID_SYNC();
#pragma unroll
        for (int br = 0; br < 3; ++br) if (PH(5 + br)) {
            PHASE_BEGIN
            if constexpr ((FASTMASK >> 2) & 1) {
            pg8::Gemm g{R2 + br * 384, (const bf16_t*)(wt + WT_PROJ) + (size_t)br * 1024 * 384, T, DM, 384, OC_PITCH}; pg8::StaticOrder S; S.init(T, DM, cx.nblk, cx.bid);
            pg8::EpiGate E{R3, R1, br};
            pg8::gemm_phase<pg8::EpiGate, pg8::StaticOrder, true, true>(lds3, g, S, E, cx.wid);
            asm volatile("s_waitcnt vmcnt(0)" ::: "memory");
            __builtin_amdgcn_fence(__ATOMIC_ACQUIRE, "agent");
            asm volatile("s_waitcnt vmcnt(0)" ::: "memory");
            __syncthreads();
            } else {
                if (br == 0) {
                    NGemm<3> g;
                    g.s[0] = NSeg{R2 + CO_SB, OC_PITCH, p.w_proj_sb + (size_t)l * 384 * DM, DM, 384};
                    g.s[1] = NSeg{R2 + CO_MB, OC_PITCH, p.w_proj_mb + (size_t)l * 320 * DM, DM, 320};
                    g.s[2] = NSeg{R2 + CO_DS, OC_PITCH, p.w_proj_ds + (size_t)l * 320 * DM, DM, 320};
                    g.M = T; g.N = DM;
                    NEpi e{R3, DM, nullptr, R1};
                    naive_gemm<3, 2>(lds, g, e, cx);
                }
            }
        }
        GRID_SYNC();
        if (PH(8)) {
            PHASE_BEGIN
            if constexpr ((FASTMASK >> 3) & 1) {
            pg8::Gemm g{R3, (const bf16_t*)(wt + WT_O), T, DM, DM, DM}; pg8::StaticOrder S; S.init(T, DM, cx.nblk, cx.bid);
            pg8::EpiBf16 E{R2, DM};
            pg8::gemm_phase<pg8::EpiBf16, pg8::StaticOrder, true, true>(lds3, g, S, E, cx.wid);
            } else {
                NGemm<1> g; g.s[0] = NSeg{R3, DM, p.w_o + (size_t)l * DM * DM, DM, DM}; g.M = T; g.N = DM;
                NEpi e{R2, DM, nullptr, nullptr};
                naive_gemm<1, 0>(lds, g, e, cx);
            }
        }
        GRID_SYNC();
        if (PH(9)) { PHASE_BEGIN phase_postnorm(p, l == 0 ? p.x : p.out, p.g_post_mix + l * DM, l, 0, cx); }
        GRID_SYNC();
        if (PH(10)) {
            PHASE_BEGIN
            if constexpr ((FASTMASK >> 4) & 1) {
            pg8::Gemm g{R3, (const bf16_t*)(wt + WT_UP), T, 2 * DFF, DM, DM}; pg8::StaticOrder S; S.init(T, 2 * DFF, cx.nblk, cx.bid);
            pg8::EpiSwiglu E{R1, DFF};
            pg8::gemm_phase<pg8::EpiSwiglu, pg8::StaticOrder, true, true>(lds3, g, S, E, cx.wid);
            } else {
                const float* wu = p.w_up + (size_t)l * DM * 2 * DFF;
                NGemm<2> g; g.s[0] = NSeg{R3, DM, wu, 2 * DFF, DM}; g.s[1] = NSeg{R3, DM, wu + DFF, 2 * DFF, DM}; g.M = T; g.N = DFF;
                NEpi e{R1, DFF, nullptr, nullptr};
                naive_gemm<2, 3>(lds, g, e, cx);
            }
        }
        GRID_SYNC();
        if (PH(11)) {
            PHASE_BEGIN
            if constexpr ((FASTMASK >> 5) & 1) {
            pg8::Gemm g{R1, (const bf16_t*)(wt + WT_DOWN), T, DM, DFF, DFF}; pg8::StaticOrder S; S.init(T, DM, cx.nblk, cx.bid);
            pg8::EpiBf16 E{R2, DM};
            pg8::gemm_phase<pg8::EpiBf16, pg8::StaticOrder, true, true>(lds3, g, S, E, cx.wid);
            } else {
                NGemm<1> g; g.s[0] = NSeg{R1, DFF, p.w_down + (size_t)l * DFF * DM, DM, DFF}; g.M = T; g.N = DM;
                NEpi e{R2, DM, nullptr, nullptr};
                naive_gemm<1, 0>(lds, g, e, cx);
            }
        }
        GRID_SYNC();
        if (PH(12)) { PHASE_BEGIN phase_postnorm(p, p.out, p.g_post_ffn + l * DM, l, 1, cx); }
        if (l + 1 < DEPTH) { if (PH(13)) { PHASE_BEGIN __syncthreads(); phase_weights(p, l + 1, lds, cx); } }
        GRID_SYNC();
    }
__global__ void __launch_bounds__(NTHREADS, 2) mega_fwd(Params p_kernarg) {
    cg::grid_group grid = cg::this_grid();
    const int wid = __builtin_amdgcn_readfirstlane((int)threadIdx.x >> 6);
    extern __shared__ __attribute__((aligned(16))) unsigned char lds_raw[];
    float* lds = (float*)lds_raw;
    PG8_LAS unsigned char* lds3 = (PG8_LAS unsigned char*)lds_raw;
    unsigned char* lds_raw_ = lds_raw;
    if (wid == 0) { const int ln = lane_id_opaque(); if (ln < 4) ((__attribute__((address_space(3))) unsigned*)((lds_u8*)lds_raw + XB_ST_OFF))[ln] = 0u; }
    __syncthreads();
    if (PHX(60)) { PHASE_BEGIN if (cx.bid == 0) { const int t_ = cx.wid * 64 + lane_id_opaque(); unsigned* cw = (unsigned*)(p.ws + WS_CTR); if (t_ < 8) cw[64 * t_] = 0u; for (int i_ = t_; i_ < XCD_BAR_WORDS; i_ += NTHREADS) cw[CW_BAR + i_] = 0u; } phase_mod(p, lds, cx); __syncthreads(); }
    if (PHX(61)) { PHASE_BEGIN phase_weights(p, 0, lds, cx); }
    GRID_SYNC_CG();
    { PHASE_BEGIN (void)xcd_barrier_post((unsigned*)(p.ws + WS_CTR) + CW_BAR, (volatile __attribute__((address_space(3))) unsigned*)((lds_u8*)lds_raw + XB_ST_OFF)); }
    if (PHX(62)) { PHASE_BEGIN phase_prenorm(p, p.x, p.g_pre_mix, 0, 0, cx); }
    GRID_SYNC();
    layer_body<0>(grid, lds, lds3, wid);
    layer_body<1>(grid, lds, lds3, wid);
}

extern "C" void kernel_launch(void* const* d_in, const int* in_sizes, int n_in, void* d_out, int out_size, void* d_ws, size_t ws_size, hipStream_t stream) {
    static int grid_blocks = 0;
    if (grid_blocks == 0) {
        if (n_in != 16 || out_size != T * DM || ws_size < WS_END) { fprintf(stderr, "kernel_launch: unexpected sizes n_in %d out %d ws %zu\n", n_in, out_size, ws_size); grid_blocks = -1; return; }
        int dev = 0, cus = 0, per_cu = 0;
        (void)hipGetDevice(&dev);
        (void)hipDeviceGetAttribute(&cus, hipDeviceAttributeMultiprocessorCount, dev);
        if (hipFuncSetAttribute((const void*)mega_fwd, hipFuncAttributeMaxDynamicSharedMemorySize, LDS_BYTES) != hipSuccess) { fprintf(stderr, "kernel_launch: hipFuncSetAttribute failed\n"); grid_blocks = -1; return; }
        (void)hipOccupancyMaxActiveBlocksPerMultiprocessor(&per_cu, (const void*)mega_fwd, NTHREADS, LDS_BYTES);
        if (per_cu < 1) { fprintf(stderr, "kernel_launch: occupancy query says %d blocks per CU\n", per_cu); per_cu = 1; }
        if (per_cu > 1) per_cu = 1;
        grid_blocks = cus * per_cu;
        fprintf(stderr, "kernel_launch: cus %d per_cu %d grid %d ws %zu\n", cus, per_cu, grid_blocks, ws_size);
    }
    if (grid_blocks < 0) return;
    Params p{};
    p.x = (const float*)d_in[0]; p.c = (const float*)d_in[1]; p.w_ada = (const float*)d_in[2]; p.b_ada = (const float*)d_in[3];
    p.g_pre_mix = (const float*)d_in[4]; p.g_post_mix = (const float*)d_in[5]; p.w_in = (const float*)d_in[6]; p.b_gate = (const float*)d_in[7];
    p.w_proj_sb = (const float*)d_in[8]; p.w_proj_mb = (const float*)d_in[9]; p.w_proj_ds = (const float*)d_in[10]; p.w_o = (const float*)d_in[11];
    p.g_pre_ffn = (const float*)d_in[12]; p.g_post_ffn = (const float*)d_in[13]; p.w_up = (const float*)d_in[14]; p.w_down = (const float*)d_in[15];
    p.out = (float*)d_out; p.ws = (unsigned char*)d_ws; p.mask = ~0ull;
    void* args[] = {&p};
    hipError_t e = hipLaunchCooperativeKernel((const void*)mega_fwd, dim3(grid_blocks), dim3(NTHREADS), args, LDS_BYTES, stream);
    if (e != hipSuccess) fprintf(stderr, "cooperative launch failed: %s (grid %d)\n", hipGetErrorString(e), grid_blocks);
}
```

```cpp
#include <hip/hip_runtime.h>
#include <hip/hip_cooperative_groups.h>
#include <cstdio>
#include <cstdint>
namespace cg = cooperative_groups;

typedef float f32x4 __attribute__((ext_vector_type(4)));
typedef unsigned u32x4 __attribute__((ext_vector_type(4)));
typedef unsigned u32x2 __attribute__((ext_vector_type(2)));
typedef unsigned short bf16_t;

constexpr int BATCH = 8, SEQ = 2048, DM = 1024, T = BATCH * SEQ, DEPTH = 2;
constexpr int HD = 64, H_SB = 6, H_MB = 5, H_DS = 5;
constexpr int D_IN = 6728, NQ1 = 3656, QKV_PITCH = 3840, NGATE = 3072, DFF = 2816;
constexpr int OC_PITCH = 1152;
constexpr int CQ_SB = 0, CK_SB = 384, CV_SB = 768, CQ_MB = 1152, CK_MB = 1472, CV_MB = 1792, CQ_DS = 2112, CK_DS = 2432, CV_DS = 2752, CQ_IX = 3072, CK_IX = 3584, CW_IX = 3648;
constexpr int CO_SB = 0, CO_MB = 384, CO_DS = 768;
constexpr float RMS_EPS = 1e-6f;
constexpr int NTHREADS = 512, NWAVES = 8;
constexpr int QUEUE_SLOT_OFF = 151552 - 64, XB_ST_OFF = 151552 - 32;

constexpr size_t MiB = 1u << 20;
constexpr size_t WS_CTR = 0;
constexpr int CW_BAR = 4096;
constexpr size_t WS_MOD = 1 * MiB;
constexpr size_t WS_KMEAN = 1 * MiB + 512 * 1024;
constexpr size_t WS_MASK = 2 * MiB;
constexpr size_t WS_WT = 6 * MiB;
constexpr size_t WS_R3 = 42 * MiB;
constexpr size_t WS_R2 = 74 * MiB;
constexpr size_t WS_R1 = 110 * MiB;
constexpr size_t WS_END = 230 * MiB;

struct Params {
    const float* x; const float* c; const float* w_ada; const float* b_ada; const float* g_pre_mix; const float* g_post_mix;
    const float* w_in; const float* b_gate; const float* w_proj_sb; const float* w_proj_mb; const float* w_proj_ds; const float* w_o;
    const float* g_pre_ffn; const float* g_post_ffn; const float* w_up; const float* w_down;
    float* out; unsigned char* ws; unsigned long long mask;
};

struct Ctx { int bid, nblk, wid; };
__device__ __forceinline__ float bf2f(unsigned short b) { return __uint_as_float((unsigned)b << 16); }
__device__ __forceinline__ float bflo(unsigned w) { return __uint_as_float(w << 16); }
__device__ __forceinline__ float bfhi(unsigned w) { return __uint_as_float(w & 0xffff0000u); }
__device__ __forceinline__ unsigned f2bf(float f) { unsigned u = __float_as_uint(f); return (u + 0x7fffu + ((u >> 16) & 1u)) >> 16; }
__device__ __forceinline__ unsigned pk2(float lo, float hi) { return f2bf(lo) | (f2bf(hi) << 16); }
__device__ __forceinline__ float wave_sum(float v) {
#pragma unroll
    for (int o = 1; o < 64; o <<= 1) v += __shfl_xor(v, o);
    return v;
}
__device__ __forceinline__ int lane_id_opaque() { int l; asm volatile("v_mbcnt_lo_u32_b32 %0, -1, 0\n\tv_mbcnt_hi_u32_b32 %0, -1, %0" : "=v"(l)); return l; }
#define TIDX (wid * 64 + lane_id_opaque())
__device__ __forceinline__ float sigmoidf_(float v) { return 1.f / (1.f + __expf(-v)); }

__device__ __forceinline__ void phase_mod(const Params& p, float* lds, Ctx cx) { const int wid = cx.wid, BID = cx.bid, NBLK = cx.nblk; (void)wid; (void)BID; (void)NBLK;
    float* MOD = (float*)(p.ws + WS_MOD);
    const int tid = TIDX;
    float* cact = lds;
    float* red = lds + 8 * 1024;
    for (int i = tid; i < 8 * 1024; i += NTHREADS) { const float v = p.c[i]; cact[i] = v * sigmoidf_(v); }
    __syncthreads();
    for (int item = BID; item < 2 * 96; item += NBLK) {
        const int l = item / 96, ct = item % 96, kg = tid >> 6, col = ct * 64 + (tid & 63);
        const float* W = p.w_ada + (size_t)l * 1024 * 6144 + col;
        float acc[8];
#pragma unroll
        for (int b = 0; b < 8; ++b) acc[b] = 0.f;
        for (int k = kg; k < 1024; k += 8) {
            const float w = W[(size_t)k * 6144];
#pragma unroll
            for (int b = 0; b < 8; ++b) acc[b] += cact[b * 1024 + k] * w;
        }
#pragma unroll
        for (int b = 0; b < 8; ++b) red[(kg * 8 + b) * 64 + (tid & 63)] = acc[b];
        __syncthreads();
        {
            const int b = tid >> 6, cc = tid & 63;
            float s = 0.f;
#pragma unroll
            for (int g = 0; g < 8; ++g) s += red[(g * 8 + b) * 64 + cc];
            MOD[((size_t)l * 8 + b) * 6144 + ct * 64 + cc] = s + p.b_ada[l * 6144 + ct * 64 + cc];
        }
        __syncthreads();
    }
}

__device__ __forceinline__ void normmod_row(const f32x4 (&v)[4], float rstd, const float* g, const float* sc, const float* sh, bf16_t* orow, int lane) {
#pragma unroll
    for (int j = 0; j < 4; ++j) {
        const int c0 = 4 * lane + 256 * j;
        const f32x4 gg = *(const f32x4*)(g + c0), s1 = *(const f32x4*)(sc + c0), s0 = *(const f32x4*)(sh + c0);
        f32x4 o;
#pragma unroll
        for (int e = 0; e < 4; ++e) o[e] = v[j][e] * rstd * gg[e] * (1.f + s1[e]) + s0[e];
        u32x2 w; w.x = pk2(o[0], o[1]); w.y = pk2(o[2], o[3]);
        *(u32x2*)(orow + c0) = w;
    }
}
__device__ __forceinline__ void phase_prenorm(const Params& p, const float* xin, const float* g, int l, int which, Ctx cx) { const int wid = cx.wid, BID = cx.bid, NBLK = cx.nblk; (void)wid; (void)BID; (void)NBLK;
    const float* MOD = (const float*)(p.ws + WS_MOD) + (size_t)l * 8 * 6144;
    bf16_t* XN = (bf16_t*)(p.ws + WS_R3);
    const int lane = lane_id_opaque(), gw = BID * NWAVES + wid, NGW = NBLK * NWAVES;
    for (int m = gw; m < T; m += NGW) {
        const int b = m / SEQ;
        const f32x4* xr = (const f32x4*)(xin + (size_t)m * DM) + lane;
        f32x4 v[4]; float s = 0.f;
#pragma unroll
        for (int j = 0; j < 4; ++j) { v[j] = xr[64 * j]; s += (v[j][0] * v[j][0] + v[j][1] * v[j][1]) + (v[j][2] * v[j][2] + v[j][3] * v[j][3]); }
        const float rstd = rsqrtf(wave_sum(s) * (1.f / DM) + RMS_EPS);
        const float* mb = MOD + (size_t)b * 6144 + which * 3072;
        normmod_row(v, rstd, g, mb + 1024, mb, XN + (size_t)m * DM, lane);
    }
}
__device__ __forceinline__ void phase_postnorm(const Params& p, const float* xin, const float* gpost, int l, int which, Ctx cx) { const int wid = cx.wid, BID = cx.bid, NBLK = cx.nblk; (void)wid; (void)BID; (void)NBLK;
    const float* MODl = (const float*)(p.ws + WS_MOD) + (size_t)l * 8 * 6144;
    const bf16_t* Y = (const bf16_t*)(p.ws + WS_R2);
    bf16_t* XN = (bf16_t*)(p.ws + WS_R3);
    const int lane = lane_id_opaque(), gw = BID * NWAVES + wid, NGW = NBLK * NWAVES;
    const float* gnext = which == 0 ? p.g_pre_ffn + l * DM : (l + 1 < DEPTH ? p.g_pre_mix + (l + 1) * DM : nullptr);
    for (int m = gw; m < T; m += NGW) {
        const int b = m / SEQ;
        const float* gate = MODl + (size_t)b * 6144 + (which == 0 ? 2048 : 5120);
        f32x4 y[4]; float s = 0.f;
#pragma unroll
        for (int j = 0; j < 4; ++j) {
            const u32x2 w = *(const u32x2*)(Y + (size_t)m * DM + 4 * lane + 256 * j);
            y[j] = (f32x4){bflo(w.x), bfhi(w.x), bflo(w.y), bfhi(w.y)};
            s += (y[j][0] * y[j][0] + y[j][1] * y[j][1]) + (y[j][2] * y[j][2] + y[j][3] * y[j][3]);
        }
        const float rstd = rsqrtf(wave_sum(s) * (1.f / DM) + RMS_EPS);
        f32x4 v[4]; float s2 = 0.f;
#pragma unroll
        for (int j = 0; j < 4; ++j) {
            const int c0 = 4 * lane + 256 * j;
            const f32x4 xi = *(const f32x4*)(xin + (size_t)m * DM + c0), gp = *(const f32x4*)(gpost + c0), gt = *(const f32x4*)(gate + c0);
#pragma unroll
            for (int e = 0; e < 4; ++e) v[j][e] = xi[e] + gt[e] * (y[j][e] * rstd * gp[e]);
            *(f32x4*)(p.out + (size_t)m * DM + c0) = v[j];
            s2 += (v[j][0] * v[j][0] + v[j][1] * v[j][1]) + (v[j][2] * v[j][2] + v[j][3] * v[j][3]);
        }
        if (gnext) {
            const float rstd2 = rsqrtf(wave_sum(s2) * (1.f / DM) + RMS_EPS);
            const float* mb = which == 0 ? MODl + (size_t)b * 6144 + 3072 : MODl + (size_t)8 * 6144 + (size_t)b * 6144;
            normmod_row(v, rstd2, gnext, mb + 1024, mb, XN + (size_t)m * DM, lane);
        }
    }
}

struct NSeg { const bf16_t* A; int lda; const float* W; int ldw; int K; };
template <int NSEG> struct NGemm { NSeg s[NSEG]; int M, N; };
struct NEpi { bf16_t* C; int ldc; const float* bias; const bf16_t* gates; };
template <int NSEG, int EPI> __device__ __forceinline__ void naive_gemm(float* lds, const NGemm<NSEG>& g, const NEpi& e, Ctx cx) { const int wid = cx.wid, BID = cx.bid, NBLK = cx.nblk; (void)wid; (void)BID; (void)NBLK;
    float* As = lds;
    float* Bs = lds + 16 * 68;
    const int tid = TIDX, ty = tid >> 5, tx = tid & 31;
    const int tm = g.M / 64, tn = (g.N + 127) / 128;
    for (int item = BID; item < tm * tn; item += NBLK) {
        const int m0 = (item / tn) * 64, n0 = (item % tn) * 128;
        float acc[NSEG][4][4];
#pragma unroll
        for (int s = 0; s < NSEG; ++s)
#pragma unroll
            for (int i = 0; i < 4; ++i)
#pragma unroll
                for (int j = 0; j < 4; ++j) acc[s][i][j] = 0.f;
#pragma unroll
        for (int s = 0; s < NSEG; ++s) {
            const NSeg sg = g.s[s];
#pragma unroll 1
            for (int k0 = 0; k0 < sg.K; k0 += 16) {
                __syncthreads();
                {
                    const int r = tid >> 3, kq = tid & 7;
                    const unsigned w = *(const unsigned*)(sg.A + (size_t)(m0 + r) * sg.lda + k0 + kq * 2);
                    As[(kq * 2 + 0) * 68 + r] = bflo(w); As[(kq * 2 + 1) * 68 + r] = bfhi(w);
                    const int k = tid >> 5, nq = tid & 31, n = n0 + nq * 4;
                    f32x4 bv = (f32x4){0.f, 0.f, 0.f, 0.f};
                    if (n < g.N) bv = *(const f32x4*)(sg.W + (size_t)(k0 + k) * sg.ldw + n);
                    *(f32x4*)(Bs + k * 132 + nq * 4) = bv;
                }
                __syncthreads();
#pragma unroll 4
                for (int k = 0; k < 16; ++k) {
                    const f32x4 a0 = *(const f32x4*)(As + k * 68 + ty * 4), b = *(const f32x4*)(Bs + k * 132 + tx * 4);
#pragma unroll
                    for (int i = 0; i < 4; ++i)
#pragma unroll
                        for (int j = 0; j < 4; ++j) acc[s][i][j] += a0[i] * b[j];
                }
            }
        }
        const int col = n0 + tx * 4;
        if (col < g.N) {
#pragma unroll
            for (int i = 0; i < 4; ++i) {
                const int row = m0 + ty * 4 + i;
                float o[4];
                if (EPI == 0) {
#pragma unroll
                    for (int j = 0; j < 4; ++j) o[j] = acc[0][i][j];
                } else if (EPI == 1) {
#pragma unroll
                    for (int j = 0; j < 4; ++j) o[j] = sigmoidf_(acc[0][i][j] + e.bias[col + j]);
                } else if (EPI == 2) {
#pragma unroll
                    for (int j = 0; j < 4; ++j) o[j] = 0.f;
#pragma unroll
                    for (int s = 0; s < NSEG; ++s) {
                        const u32x2 gw = *(const u32x2*)(e.gates + (size_t)row * NGATE + s * 1024 + col);
                        o[0] += bflo(gw.x) * acc[s][i][0]; o[1] += bfhi(gw.x) * acc[s][i][1]; o[2] += bflo(gw.y) * acc[s][i][2]; o[3] += bfhi(gw.y) * acc[s][i][3];
                    }
                } else {
#pragma unroll
                    for (int j = 0; j < 4; ++j) { const float gt = acc[0][i][j]; o[j] = gt * sigmoidf_(gt) * acc[NSEG - 1][i][j]; }
                }
                u32x2 w; w.x = pk2(o[0], o[1]); w.y = pk2(o[2], o[3]);
                *(u32x2*)(e.C + (size_t)row * e.ldc + col) = w;
            }
        }
    }
}

__device__ __forceinline__ void phase_kmean(const Params& p, Ctx cx) { const int wid = cx.wid, BID = cx.bid, NBLK = cx.nblk; (void)wid; (void)BID; (void)NBLK;
    const bf16_t* QKV = (const bf16_t*)(p.ws + WS_R1);
    float* KM = (float*)(p.ws + WS_KMEAN);
    const int gt = BID * NTHREADS + TIDX, NT = NBLK * NTHREADS;
    for (int o = gt; o < 8 * 8 * 320; o += NT) {
        const int c = o % 320, n = (o / 320) % 8, b = o / (320 * 8);
        const bf16_t* kp = QKV + (size_t)(b * SEQ + n * 256) * QKV_PITCH + CK_MB + c;
        float s = 0.f;
        for (int r = 0; r < 256; ++r) s += bf2f(kp[(size_t)r * QKV_PITCH]);
        KM[o] = s * (1.f / 256.f);
    }
}

__device__ __forceinline__ unsigned ordkey(float f) { const unsigned u = __float_as_uint(f); return u ^ ((u >> 31) ? 0xffffffffu : 0x80000000u); }
__device__ __forceinline__ void phase_dsa_topk(const Params& p, float* lds, Ctx cx) { const int wid = cx.wid, BID = cx.bid, NBLK = cx.nblk; (void)wid; (void)BID; (void)NBLK;
    const bf16_t* QKV = (const bf16_t*)(p.ws + WS_R1);
    unsigned* MASK = (unsigned*)(p.ws + WS_MASK);
    const int lane = lane_id_opaque(), wave = wid, gw = BID * NWAVES + wave, NGW = NBLK * NWAVES;
    float* qs = lds + wave * 520;
    unsigned* skey = (unsigned*)(lds + 8 * 520) + wave * 2048;
    for (int m = gw; m < T; m += NGW) {
        const int b = m / SEQ, t = m % SEQ;
        const bf16_t* qrow = QKV + (size_t)m * QKV_PITCH;
        {
            const u32x4 w = *(const u32x4*)(qrow + CQ_IX + lane * 8);
            qs[lane * 8 + 0] = bflo(w.x); qs[lane * 8 + 1] = bfhi(w.x); qs[lane * 8 + 2] = bflo(w.y); qs[lane * 8 + 3] = bfhi(w.y);
            qs[lane * 8 + 4] = bflo(w.z); qs[lane * 8 + 5] = bfhi(w.z); qs[lane * 8 + 6] = bflo(w.w); qs[lane * 8 + 7] = bfhi(w.w);
            if (lane < 8) qs[512 + lane] = bf2f(qrow[CW_IX + lane]);
        }
        asm volatile("s_waitcnt lgkmcnt(0)" ::: "memory");
        __builtin_amdgcn_wave_barrier();
        const int ni = (t >> 6) + 1;
#pragma unroll 1
        for (int i = 0; i < ni; ++i) {
            const int s = i * 64 + lane;
            const u32x4* kp = (const u32x4*)(QKV + (size_t)(b * SEQ + s) * QKV_PITCH + CK_IX);
            u32x4 kw[8];
#pragma unroll
            for (int q = 0; q < 8; ++q) kw[q] = kp[q];
            float sc = 0.f;
#pragma unroll 1
            for (int h = 0; h < 8; ++h) {
                float lg = 0.f;
#pragma unroll
                for (int q = 0; q < 8; ++q) {
                    const f32x4 q0 = *(const f32x4*)(qs + h * 64 + q * 8), q1 = *(const f32x4*)(qs + h * 64 + q * 8 + 4);
                    lg += q0[0] * bflo(kw[q].x) + q0[1] * bfhi(kw[q].x) + q0[2] * bflo(kw[q].y) + q0[3] * bfhi(kw[q].y)
                        + q1[0] * bflo(kw[q].z) + q1[1] * bfhi(kw[q].z) + q1[2] * bflo(kw[q].w) + q1[3] * bfhi(kw[q].w);
                }
                sc += qs[512 + h] * fmaxf(lg, 0.f);
            }
            if (sc == 0.f) sc = 0.f;
            skey[s] = (s <= t) ? ordkey(sc) : 0u;
        }
        asm volatile("s_waitcnt lgkmcnt(0)" ::: "memory");
        __builtin_amdgcn_wave_barrier();
        unsigned key[32];
#pragma unroll
        for (int i = 0; i < 32; ++i) key[i] = (i < ni) ? skey[i * 64 + lane] : 0u;
        unsigned w = 0u;
        if (t + 1 <= 256) {
#pragma unroll
            for (int i = 0; i < 32; ++i) { const unsigned long long sb = __ballot(key[i] != 0u); if ((lane >> 1) == i) w = (lane & 1) ? (unsigned)(sb >> 32) : (unsigned)sb; }
        } else {
            unsigned Tk = 0u;
#pragma unroll 1
            for (int bit = 31; bit >= 0; --bit) {
                const unsigned cand = Tk | (1u << bit);
                int cnt = 0;
#pragma unroll
                for (int i = 0; i < 32; ++i) cnt += __popcll(__ballot(key[i] >= cand));
                if (cnt >= 256) Tk = cand;
            }
            int cgt = 0;
#pragma unroll
            for (int i = 0; i < 32; ++i) cgt += __popcll(__ballot(key[i] > Tk));
            int need = 256 - cgt;
#pragma unroll
            for (int i = 0; i < 32; ++i) {
                const unsigned long long gtb = __ballot(key[i] > Tk), eqb = __ballot(key[i] == Tk);
                unsigned long long take = 0ull;
                const int ne = __popcll(eqb);
                if (need > 0 && ne > 0) {
                    if (ne <= need) { take = eqb; need -= ne; }
                    else {
                        unsigned long long rem = eqb;
                        for (int q = 0; q < need; ++q) { const unsigned long long low = rem & (~rem + 1ull); take |= low; rem ^= low; }
                        need = 0;
                    }
                }
                const unsigned long long sb = gtb | take;
                if ((lane >> 1) == i) w = (lane & 1) ? (unsigned)(sb >> 32) : (unsigned)sb;
            }
        }
        MASK[(size_t)m * 64 + lane] = w;
        __builtin_amdgcn_wave_barrier();
    }
}

template <int MODE> __device__ __forceinline__ void naive_attn_item(const Params& p, int b, int h, int qc, int lane) {
    const bf16_t* QKV = (const bf16_t*)(p.ws + WS_R1);
    bf16_t* OC = (bf16_t*)(p.ws + WS_R2);
    constexpr int cq = MODE == 0 ? CQ_SB : MODE == 1 ? CQ_MB : CQ_DS, ck = MODE == 0 ? CK_SB : MODE == 1 ? CK_MB : CK_DS, cv = MODE == 0 ? CV_SB : MODE == 1 ? CV_MB : CV_DS;
    constexpr int co = MODE == 0 ? CO_SB : MODE == 1 ? CO_MB : CO_DS;
    const int t = qc * 64 + lane; const size_t row = (size_t)b * SEQ + t;
    float q[64], acc[64];
    {
        const u32x4* qp = (const u32x4*)(QKV + row * QKV_PITCH + cq + h * 64);
#pragma unroll
        for (int i = 0; i < 8; ++i) { const u32x4 w = qp[i];
            q[i * 8 + 0] = bflo(w.x); q[i * 8 + 1] = bfhi(w.x); q[i * 8 + 2] = bflo(w.y); q[i * 8 + 3] = bfhi(w.y);
            q[i * 8 + 4] = bflo(w.z); q[i * 8 + 5] = bfhi(w.z); q[i * 8 + 6] = bflo(w.w); q[i * 8 + 7] = bfhi(w.w); }
    }
#pragma unroll
    for (int d = 0; d < 64; ++d) acc[d] = 0.f;
    const bf16_t* Kb = QKV + (size_t)b * SEQ * QKV_PITCH + ck + h * 64;
    const bf16_t* Vb = QKV + (size_t)b * SEQ * QKV_PITCH + cv + h * 64;
    const int tmax = qc * 64 + 63;
    float outscale = 1.f;
    if (MODE == 0) {
        float R = 0.f;
        for (int s = tmax - 1; s >= 0; --s) {
            const u32x4* kp = (const u32x4*)(Kb + (size_t)s * QKV_PITCH);
            float z = 0.f;
#pragma unroll
            for (int i = 0; i < 8; ++i) { const u32x4 w = kp[i];
                z += q[i * 8 + 0] * bflo(w.x) + q[i * 8 + 1] * bfhi(w.x) + q[i * 8 + 2] * bflo(w.y) + q[i * 8 + 3] * bfhi(w.y)
                   + q[i * 8 + 4] * bflo(w.z) + q[i * 8 + 5] * bfhi(w.z) + q[i * 8 + 6] * bflo(w.w) + q[i * 8 + 7] * bfhi(w.w); }
            z *= 0.125f;
            const float u = -(fmaxf(z, 0.f) + log1pf(__expf(-fabsf(z))));
            const bool act = s < t;
            const float a = act ? __expf(z + u + R) : 0.f;
            if (act) R += u;
            const u32x4* vp = (const u32x4*)(Vb + (size_t)s * QKV_PITCH);
#pragma unroll
            for (int i = 0; i < 8; ++i) { const u32x4 w = vp[i];
                acc[i * 8 + 0] += a * bflo(w.x); acc[i * 8 + 1] += a * bfhi(w.x); acc[i * 8 + 2] += a * bflo(w.y); acc[i * 8 + 3] += a * bfhi(w.y);
                acc[i * 8 + 4] += a * bflo(w.z); acc[i * 8 + 5] += a * bfhi(w.z); acc[i * 8 + 6] += a * bflo(w.w); acc[i * 8 + 7] += a * bfhi(w.w); }
        }
    } else {
        const float slope = exp2f(-0.8f * (float)(MODE == 1 ? (2 * h + 1) : (2 * h + 2)));
        const int own = t >> 8;
        unsigned selm = 0u;
        if (MODE == 1) {
            const float* KM = (const float*)(p.ws + WS_KMEAN);
            float gate[8];
#pragma unroll
            for (int n = 0; n < 8; ++n) {
                gate[n] = -1e30f;
                if (n < own) {
                    const float* km = KM + (((size_t)b * 8 + n) * 5 + h) * 64;
                    float gsum = 0.f;
#pragma unroll
                    for (int d = 0; d < 64; ++d) gsum += q[d] * km[d];
                    gate[n] = gsum;
                }
            }
#pragma unroll
            for (int r = 0; r < 3; ++r) {
                float best = -3e38f; int bi = -1;
#pragma unroll
                for (int n = 0; n < 8; ++n) if (!((selm >> n) & 1u) && gate[n] > best) { best = gate[n]; bi = n; }
                if (bi >= 0) selm |= 1u << bi;
            }
            selm &= (1u << own) - 1u;
        }
        const unsigned* MASK = (const unsigned*)(p.ws + WS_MASK) + row * 64;
        float mx = -3e38f, l = 0.f;
        unsigned mw = 0u;
        for (int s = 0; s <= tmax; ++s) {
            bool allowed;
            if (MODE == 1) {
                const int n = s >> 8;
                allowed = (n < own) ? ((selm >> n) & 1u) : (s <= t);
            } else {
                if ((s & 31) == 0) mw = MASK[s >> 5];
                allowed = (mw >> (s & 31)) & 1u;
            }
            if (!__any(allowed)) continue;
            const u32x4* kp = (const u32x4*)(Kb + (size_t)s * QKV_PITCH);
            float z = 0.f;
#pragma unroll
            for (int i = 0; i < 8; ++i) { const u32x4 w = kp[i];
                z += q[i * 8 + 0] * bflo(w.x) + q[i * 8 + 1] * bfhi(w.x) + q[i * 8 + 2] * bflo(w.y) + q[i * 8 + 3] * bfhi(w.y)
                   + q[i * 8 + 4] * bflo(w.z) + q[i * 8 + 5] * bfhi(w.z) + q[i * 8 + 6] * bflo(w.w) + q[i * 8 + 7] * bfhi(w.w); }
            const float sc = z * 0.125f - slope * (float)(t - s);
            const float mn = allowed ? fmaxf(mx, sc) : mx;
            const float alpha = __expf(mx - mn);
            const float pp = allowed ? __expf(sc - mn) : 0.f;
            mx = mn; l = l * alpha + pp;
            const u32x4* vp = (const u32x4*)(Vb + (size_t)s * QKV_PITCH);
#pragma unroll
            for (int i = 0; i < 8; ++i) { const u32x4 w = vp[i];
                acc[i * 8 + 0] = acc[i * 8 + 0] * alpha + pp * bflo(w.x); acc[i * 8 + 1] = acc[i * 8 + 1] * alpha + pp * bfhi(w.x);
                acc[i * 8 + 2] = acc[i * 8 + 2] * alpha + pp * bflo(w.y); acc[i * 8 + 3] = acc[i * 8 + 3] * alpha + pp * bfhi(w.y);
                acc[i * 8 + 4] = acc[i * 8 + 4] * alpha + pp * bflo(w.z); acc[i * 8 + 5] = acc[i * 8 + 5] * alpha + pp * bfhi(w.z);
                acc[i * 8 + 6] = acc[i * 8 + 6] * alpha + pp * bflo(w.w); acc[i * 8 + 7] = acc[i * 8 + 7] * alpha + pp * bfhi(w.w); }
        }
        outscale = 1.f / l;
    }
    u32x4* op = (u32x4*)(OC + row * OC_PITCH + co + h * 64);
#pragma unroll
    for (int i = 0; i < 8; ++i) { u32x4 w;
        w.x = pk2(acc[i * 8 + 0] * outscale, acc[i * 8 + 1] * outscale); w.y = pk2(acc[i * 8 + 2] * outscale, acc[i * 8 + 3] * outscale);
        w.z = pk2(acc[i * 8 + 4] * outscale, acc[i * 8 + 5] * outscale); w.w = pk2(acc[i * 8 + 6] * outscale, acc[i * 8 + 7] * outscale);
        op[i] = w; }
}
template <int MODE> __device__ __forceinline__ void phase_naive_attn(const Params& p, Ctx cx) { const int wid = cx.wid, BID = cx.bid, NBLK = cx.nblk; (void)wid; (void)BID; (void)NBLK;
    constexpr int NH = MODE == 0 ? H_SB : 5;
    const int lane = lane_id_opaque(), gw = BID * NWAVES + wid, NGW = NBLK * NWAVES;
    const int nitems = BATCH * NH * 32;
    for (int it = gw; it < nitems; it += NGW) {
        const int qc = 31 - it / (BATCH * NH), bh = it % (BATCH * NH);
        naive_attn_item<MODE>(p, bh / NH, bh % NH, qc, lane);
    }
}
typedef float f32x2g_t __attribute__((ext_vector_type(2))); typedef __bf16 bf16x2g_t __attribute__((ext_vector_type(2)));
__device__ __forceinline__ unsigned cvt_pk(float lo, float hi) { f32x2g_t v = {lo, hi}; bf16x2g_t b = __builtin_convertvector(v, bf16x2g_t); return __builtin_bit_cast(unsigned, b); }
typedef short bf16x8_t __attribute__((ext_vector_type(8)));
typedef float f32x16_t __attribute__((ext_vector_type(16)));
typedef __attribute__((address_space(3))) unsigned char lds_u8;
constexpr int AT_PITCH = 144, AT_KBYTES = 64 * AT_PITCH, AT_BUF = 2 * AT_KBYTES;
constexpr float AT_C1 = 0.125f * 1.4426950408889634f;
__device__ __forceinline__ float fexp2(float x) { return __builtin_amdgcn_exp2f(x); }
__device__ __forceinline__ float flog2(float x) { return __builtin_amdgcn_logf(x); }

__device__ __forceinline__ void swap32(float x, float& lo, float& hi) {
    auto rr = __builtin_amdgcn_permlane32_swap(__float_as_uint(x), __float_as_uint(x), false, false);
    lo = __uint_as_float(rr[0]); hi = __uint_as_float(rr[1]);
}
__device__ __forceinline__ bf16x8_t pack8(const float (&P)[16], int o) {
    u32x4 w; w.x = cvt_pk(P[o], P[o + 1]); w.y = cvt_pk(P[o + 2], P[o + 3]); w.z = cvt_pk(P[o + 4], P[o + 5]); w.w = cvt_pk(P[o + 6], P[o + 7]);
    return __builtin_bit_cast(bf16x8_t, w);
}
template <bool MASKED> __device__ __forceinline__ void sb_sub(const f32x16_t& S, int nv, float (&beta)[16], float (&ex)[16], float& tot) {
    float r[16];
#pragma unroll
    for (int i = 0; i < 16; ++i) {
        const float e = fexp2(S[i] * AT_C1);
        float ri = __builtin_amdgcn_rcpf(1.f + e), bi = 1.f - ri;
        if (MASKED) { const bool v = i < nv; ri = v ? ri : 1.f; bi = v ? bi : 0.f; }
        r[i] = ri; beta[i] = bi;
    }
    float run = 1.f;
#pragma unroll
    for (int i = 15; i >= 0; --i) { ex[i] = run; run *= r[i]; }
    tot = run;
}
template <bool MASKED> __device__ __forceinline__ float sm_sub(const f32x16_t& S, const float (&Bi)[16], unsigned vm, float (&t)[16]) {
    float mx = -1e30f;
#pragma unroll
    for (int i = 0; i < 16; ++i) { float ti = S[i] * AT_C1 + Bi[i]; if (MASKED) ti = ((vm >> i) & 1u) ? ti : -1e30f; t[i] = ti; mx = fmaxf(mx, ti); }
    return mx;
}

template <int MODE> __device__ __forceinline__ void attn_unit(const bf16_t* __restrict__ QKV, bf16_t* __restrict__ OC, const float* __restrict__ KM, const unsigned* __restrict__ MASK,
                                                              int b, int h, int qb, lds_u8* lds, int wid, int lane) {
    constexpr int cq = MODE == 0 ? CQ_SB : MODE == 1 ? CQ_MB : CQ_DS, ck = MODE == 0 ? CK_SB : MODE == 1 ? CK_MB : CK_DS, cv = MODE == 0 ? CV_SB : MODE == 1 ? CV_MB : CV_DS;
    constexpr int co = MODE == 0 ? CO_SB : MODE == 1 ? CO_MB : CO_DS;
    const int c = lane & 31, hh = lane >> 5, tid = wid * 64 + lane;
    const int q0 = qb * 256, tq = q0 + 32 * wid + c;
    const size_t rowq = (size_t)b * SEQ + tq;
    bf16x8_t qf[4];
#pragma unroll
    for (int ds = 0; ds < 4; ++ds) qf[ds] = *(const bf16x8_t*)(QKV + rowq * QKV_PITCH + cq + h * 64 + ds * 16 + hh * 8);
    float slope2 = 0.f; unsigned selm = 0u;
    if (MODE != 0) slope2 = exp2f(-0.8f * (float)(MODE == 1 ? (2 * h + 1) : (2 * h + 2))) * 1.4426950408889634f;
    if (MODE == 1) {
        float gate[8];
#pragma unroll
        for (int n = 0; n < 8; ++n) {
            gate[n] = -1e30f;
            if (n < qb) {
                const float* km = KM + (((size_t)b * 8 + n) * 5 + h) * 64 + hh * 8;
                float gs = 0.f;
#pragma unroll
                for (int ds = 0; ds < 4; ++ds) {
                    const f32x4 k0 = *(const f32x4*)(km + ds * 16), k1 = *(const f32x4*)(km + ds * 16 + 4);
                    const bf16x8_t qv = qf[ds];
                    gs += bf2f((unsigned short)qv[0]) * k0[0] + bf2f((unsigned short)qv[1]) * k0[1] + bf2f((unsigned short)qv[2]) * k0[2] + bf2f((unsigned short)qv[3]) * k0[3]
                        + bf2f((unsigned short)qv[4]) * k1[0] + bf2f((unsigned short)qv[5]) * k1[1] + bf2f((unsigned short)qv[6]) * k1[2] + bf2f((unsigned short)qv[7]) * k1[3];
                }
                gs += __shfl_xor(gs, 32);
                gate[n] = gs;
            }
        }
#pragma unroll
        for (int r = 0; r < 3; ++r) {
            float best = -3e38f; int bi = -1;
#pragma unroll
            for (int n = 0; n < 8; ++n) if (!((selm >> n) & 1u) && gate[n] > best) { best = gate[n]; bi = n; }
            if (bi >= 0) selm |= 1u << bi;
        }
        selm &= (1u << qb) - 1u;
    }
    float Bi[16];
#pragma unroll
    for (int i = 0; i < 16; ++i) Bi[i] = slope2 * (float)i;
    f32x16_t o0, o1;
#pragma unroll
    for (int i = 0; i < 16; ++i) { o0[i] = 0.f; o1[i] = 0.f; }
    float m = -3000.f, l = 0.f, R = 1.f;
    const int jmax = 4 * qb + 3, qmin = q0 + 32 * wid, jw = (qmin + 31) >> 6;
    const bool isv = tid < 256;
    const int vchunk = (tid >> 5) & 7, vrp = tid & 31, krow = (tid & 255) >> 2, kcp = tid & 3;
    const bf16_t* gsrc0; const bf16_t* gsrc1;
    if (isv) { gsrc0 = QKV + ((size_t)b * SEQ + 2 * vrp) * QKV_PITCH + cv + h * 64 + vchunk * 8; gsrc1 = gsrc0 + QKV_PITCH; }
    else { gsrc0 = QKV + ((size_t)b * SEQ + krow) * QKV_PITCH + ck + h * 64 + kcp * 16; gsrc1 = gsrc0 + 8; }
    const int rho = c, kperm = 16 * ((rho >> 2) & 1) + (rho & 3) + 4 * (rho >> 3);
    const int kfoff = kperm * AT_PITCH + hh * 16;
    const int vfoff = AT_KBYTES + c * AT_PITCH + hh * 32;
    const unsigned* mrow = MASK + rowq * 64;
    u32x4 st0, st1; u32x2 mwn = (u32x2){0u, 0u}, mwc = (u32x2){0u, 0u};
#define AT_LOAD(j) do { st0 = *(const u32x4*)(gsrc0 + (size_t)(j) * 64 * QKV_PITCH); st1 = *(const u32x4*)(gsrc1 + (size_t)(j) * 64 * QKV_PITCH); if (MODE == 2) mwn = *(const u32x2*)(mrow + 2 * (j)); } while (0)
#define AT_STORE(bufi) do { lds_u8* bb = lds + (bufi) * AT_BUF; \
        if (isv) { lds_u8* vb = bb + AT_KBYTES + (vchunk * 8) * AT_PITCH + vrp * 4; \
            *(__attribute__((address_space(3))) unsigned*)(vb + 0 * AT_PITCH) = (st0.x & 0xffffu) | (st1.x << 16); *(__attribute__((address_space(3))) unsigned*)(vb + 1 * AT_PITCH) = (st0.x >> 16) | (st1.x & 0xffff0000u); \
            *(__attribute__((address_space(3))) unsigned*)(vb + 2 * AT_PITCH) = (st0.y & 0xffffu) | (st1.y << 16); *(__attribute__((address_space(3))) unsigned*)(vb + 3 * AT_PITCH) = (st0.y >> 16) | (st1.y & 0xffff0000u); \
            *(__attribute__((address_space(3))) unsigned*)(vb + 4 * AT_PITCH) = (st0.z & 0xffffu) | (st1.z << 16); *(__attribute__((address_space(3))) unsigned*)(vb + 5 * AT_PITCH) = (st0.z >> 16) | (st1.z & 0xffff0000u); \
            *(__attribute__((address_space(3))) unsigned*)(vb + 6 * AT_PITCH) = (st0.w & 0xffffu) | (st1.w << 16); *(__attribute__((address_space(3))) unsigned*)(vb + 7 * AT_PITCH) = (st0.w >> 16) | (st1.w & 0xffff0000u); } \
        else { lds_u8* kb_ = bb + krow * AT_PITCH + kcp * 32; *(__attribute__((address_space(3))) u32x4*)(kb_) = st0; *(__attribute__((address_space(3))) u32x4*)(kb_ + 16) = st1; } } while (0)
    AT_LOAD(jmax); AT_STORE(0); mwc = mwn;
    __syncthreads();
    for (int j = jmax; j >= 0; --j) {
        const int bufi = (jmax - j) & 1;
        if (j > 0) AT_LOAD(j - 1);
        if (j <= jw) {
            const lds_u8* bb = lds + bufi * AT_BUF;
            f32x16_t SA, SB_;
#pragma unroll
            for (int i = 0; i < 16; ++i) { SA[i] = 0.f; SB_[i] = 0.f; }
#pragma unroll
            for (int ds = 0; ds < 4; ++ds) {
                const bf16x8_t kfa = *(const __attribute__((address_space(3))) bf16x8_t*)(bb + kfoff + 32 * AT_PITCH + ds * 32);
                const bf16x8_t kfb = *(const __attribute__((address_space(3))) bf16x8_t*)(bb + kfoff + ds * 32);
                SA = __builtin_amdgcn_mfma_f32_32x32x16_bf16(kfa, qf[ds], SA, 0, 0, 0);
                SB_ = __builtin_amdgcn_mfma_f32_32x32x16_bf16(kfb, qf[ds], SB_, 0, 0, 0);
            }
            const int k0a = 64 * j + 32 + 16 * hh, k0b = 64 * j + 16 * hh;
            const bool mt = (64 * j + 63 >= qmin);
            float PA[16], PB[16];
            if (MODE == 0) {
                float exa[16], exb[16], tota, totb;
                if (mt) { sb_sub<true>(SA, tq - k0a, PA, exa, tota); sb_sub<true>(SB_, tq - k0b, PB, exb, totb); }
                else { sb_sub<false>(SA, 16, PA, exa, tota); sb_sub<false>(SB_, 16, PB, exb, totb); }
                float alo, ahi, blo, bhi;
                swap32(tota, alo, ahi); swap32(totb, blo, bhi);
                const float basea = R * (hh == 0 ? ahi : 1.f), Ra = R * (alo * ahi), baseb = Ra * (hh == 0 ? bhi : 1.f);
                R = Ra * (blo * bhi);
#pragma unroll
                for (int i = 0; i < 16; ++i) { PA[i] = PA[i] * (exa[i] * basea); PB[i] = PB[i] * (exb[i] * baseb); }
            } else {
                float biasa = slope2 * (float)(k0a - tq), biasb = slope2 * (float)(k0b - tq);
                float mxa, mxb;
                if (MODE == 2) {
                    mxa = sm_sub<true>(SA, Bi, (mwc.y >> (16 * hh)) & 0xffffu, PA); mxb = sm_sub<true>(SB_, Bi, (mwc.x >> (16 * hh)) & 0xffffu, PB);
                } else if (mt) {
                    int na = tq - k0a + 1, nb = tq - k0b + 1; na = na < 0 ? 0 : (na > 16 ? 16 : na); nb = nb < 0 ? 0 : (nb > 16 ? 16 : nb);
                    mxa = sm_sub<true>(SA, Bi, (1u << na) - 1u, PA); mxb = sm_sub<true>(SB_, Bi, (1u << nb) - 1u, PB);
                } else {
                    if (j < 4 * qb && !((selm >> (j >> 2)) & 1u)) { biasa = -1e30f; biasb = -1e30f; }
                    mxa = sm_sub<false>(SA, Bi, 0u, PA); mxb = sm_sub<false>(SB_, Bi, 0u, PB);
                }
                float mloc = fmaxf(mxa + biasa, mxb + biasb), mlo, mhi;
                swap32(mloc, mlo, mhi);
                const float mnew = fmaxf(m, fmaxf(mlo, mhi));
                if (__ballot(mnew > m) != 0ull) {
                    const float alpha = fexp2(m - mnew);
#pragma unroll
                    for (int i = 0; i < 16; ++i) { o0[i] *= alpha; o1[i] *= alpha; }
                    l *= alpha;
                }
                m = mnew;
                const float ca = biasa - mnew, cb = biasb - mnew;
                float la = 0.f, lb = 0.f;
#pragma unroll
                for (int i = 0; i < 16; ++i) { const float pa = fexp2(PA[i] + ca), pb = fexp2(PB[i] + cb); la += pa; lb += pb; PA[i] = pa; PB[i] = pb; }
                l += la + lb;
            }
            {
                const bf16x8_t pa0 = pack8(PA, 0), pa1 = pack8(PA, 8), pb0 = pack8(PB, 0), pb1 = pack8(PB, 8);
                const bf16x8_t va00 = *(const __attribute__((address_space(3))) bf16x8_t*)(bb + vfoff + 64);
                const bf16x8_t va01 = *(const __attribute__((address_space(3))) bf16x8_t*)(bb + vfoff + 64 + 16);
                const bf16x8_t va10 = *(const __attribute__((address_space(3))) bf16x8_t*)(bb + vfoff + 32 * AT_PITCH + 64);
                const bf16x8_t va11 = *(const __attribute__((address_space(3))) bf16x8_t*)(bb + vfoff + 32 * AT_PITCH + 64 + 16);
                const bf16x8_t vb00 = *(const __attribute__((address_space(3))) bf16x8_t*)(bb + vfoff);
                const bf16x8_t vb01 = *(const __attribute__((address_space(3))) bf16x8_t*)(bb + vfoff + 16);
                const bf16x8_t vb10 = *(const __attribute__((address_space(3))) bf16x8_t*)(bb + vfoff + 32 * AT_PITCH);
                const bf16x8_t vb11 = *(const __attribute__((address_space(3))) bf16x8_t*)(bb + vfoff + 32 * AT_PITCH + 16);
                o0 = __builtin_amdgcn_mfma_f32_32x32x16_bf16(va00, pa0, o0, 0, 0, 0);
                o1 = __builtin_amdgcn_mfma_f32_32x32x16_bf16(va10, pa0, o1, 0, 0, 0);
                o0 = __builtin_amdgcn_mfma_f32_32x32x16_bf16(va01, pa1, o0, 0, 0, 0);
                o1 = __builtin_amdgcn_mfma_f32_32x32x16_bf16(va11, pa1, o1, 0, 0, 0);
                o0 = __builtin_amdgcn_mfma_f32_32x32x16_bf16(vb00, pb0, o0, 0, 0, 0);
                o1 = __builtin_amdgcn_mfma_f32_32x32x16_bf16(vb10, pb0, o1, 0, 0, 0);
                o0 = __builtin_amdgcn_mfma_f32_32x32x16_bf16(vb01, pb1, o0, 0, 0, 0);
                o1 = __builtin_amdgcn_mfma_f32_32x32x16_bf16(vb11, pb1, o1, 0, 0, 0);
            }
        }
        if (j > 0) AT_STORE(bufi ^ 1);
        mwc = mwn;
        __syncthreads();
    }
#undef AT_LOAD
#undef AT_STORE
    float sc = 1.f;
    if (MODE != 0) { float llo, lhi; swap32(l, llo, lhi); sc = 1.f / (llo + lhi); }
    bf16_t* orow = OC + rowq * OC_PITCH + co + h * 64 + 4 * hh;
#pragma unroll
    for (int g = 0; g < 4; ++g) {
        u32x2 w; w.x = cvt_pk(o0[4 * g] * sc, o0[4 * g + 1] * sc); w.y = cvt_pk(o0[4 * g + 2] * sc, o0[4 * g + 3] * sc);
        *(u32x2*)(orow + 8 * g) = w;
        u32x2 w2; w2.x = cvt_pk(o1[4 * g] * sc, o1[4 * g + 1] * sc); w2.y = cvt_pk(o1[4 * g + 2] * sc, o1[4 * g + 3] * sc);
        *(u32x2*)(orow + 32 + 8 * g) = w2;
    }
}
template <int MODEMASK> __device__ __forceinline__ void phase_fast_attn(const Params& p, unsigned char* lds_raw, Ctx cx) {
    const bf16_t* QKV = (const bf16_t*)(p.ws + WS_R1); bf16_t* OC = (bf16_t*)(p.ws + WS_R2);
    const float* KM = (const float*)(p.ws + WS_KMEAN); const unsigned* MASK = (const unsigned*)(p.ws + WS_MASK);
    lds_u8* lds = (lds_u8*)lds_raw;
    const int lane = lane_id_opaque();
    constexpr int NBH = ((MODEMASK & 1) ? BATCH * H_SB : 0) + ((MODEMASK & 2) ? BATCH * H_MB : 0) + ((MODEMASK & 4) ? BATCH * H_DS : 0);
    for (int u = cx.bid; u < NBH * 8; u += cx.nblk) {
        const int qb = 7 - u / NBH; int r = u % NBH;
        if (MODEMASK & 1) { if (r < BATCH * H_SB) { attn_unit<0>(QKV, OC, KM, MASK, r / H_SB, r % H_SB, qb, lds, cx.wid, lane); continue; } r -= BATCH * H_SB; }
        if (MODEMASK & 2) { if (r < BATCH * H_MB) { attn_unit<1>(QKV, OC, KM, MASK, r / H_MB, r % H_MB, qb, lds, cx.wid, lane); continue; } r -= BATCH * H_MB; }
        if (MODEMASK & 4) { attn_unit<2>(QKV, OC, KM, MASK, r / H_DS, r % H_DS, qb, lds, cx.wid, lane); }
    }
}

typedef float f32x4_t __attribute__((ext_vector_type(4)));
constexpr int TK_QPITCH = 1040, TK_SKPITCH = 8208, TK_SK_OFF = 16 * TK_QPITCH;
constexpr int TK_LDS_END = TK_SK_OFF + 16 * TK_SKPITCH;
#define TK_FOR_GROUPS(...) do { _Pragma("unroll") for (int i0_ = 0; i0_ < 32; i0_ += 8) { if (i0_ < ni) { _Pragma("unroll") for (int i1_ = 0; i1_ < 8; ++i1_) { const int i = i0_ + i1_; __VA_ARGS__ } } } } while (0)
__device__ __forceinline__ void topk_select_row(const unsigned (&key)[32], int t, int ni, unsigned* mrow, int lane) {
    unsigned w = 0u;
    if (t + 1 <= 256) {
        TK_FOR_GROUPS({ const unsigned long long sb = __ballot(key[i] != 0u); if ((lane >> 1) == i) w = (lane & 1) ? (unsigned)(sb >> 32) : (unsigned)sb; });
    } else {
        unsigned Tk = 0u; bool exact = false;
#pragma unroll 1
        for (int bit = 31; bit >= 0; --bit) {
            const unsigned cand = Tk | (1u << bit);
            int cnt = 0;
            TK_FOR_GROUPS({ cnt += __popcll(__ballot(key[i] >= cand)); });
            if (cnt >= 256) { Tk = cand; if (cnt == 256) { exact = true; break; } }
        }
        if (exact) {
            TK_FOR_GROUPS({ const unsigned long long sb = __ballot(key[i] >= Tk); if ((lane >> 1) == i) w = (lane & 1) ? (unsigned)(sb >> 32) : (unsigned)sb; });
        } else {
            int cgt = 0;
            TK_FOR_GROUPS({ cgt += __popcll(__ballot(key[i] > Tk)); });
            int need = 256 - cgt;
            TK_FOR_GROUPS({
                const unsigned long long gtb = __ballot(key[i] > Tk), eqb = __ballot(key[i] == Tk);
                unsigned long long take = 0ull;
                const int ne = __popcll(eqb);
                if (need > 0 && ne > 0) {
                    if (ne <= need) { take = eqb; need -= ne; }
                    else { unsigned long long rem = eqb; for (int q = 0; q < need; ++q) { const unsigned long long low = rem & (~rem + 1ull); take |= low; rem ^= low; } need = 0; }
                }
                const unsigned long long sb = gtb | take;
                if ((lane >> 1) == i) w = (lane & 1) ? (unsigned)(sb >> 32) : (unsigned)sb;
            });
        }
    }
    mrow[lane] = w;
}
__device__ __forceinline__ void topk_unit(const bf16_t* __restrict__ QKV, unsigned* __restrict__ MASK, int b, int g, lds_u8* lds, int wid, int lane) {
    const int t0 = 16 * g; const size_t r0 = (size_t)b * SEQ + t0;
    if (t0 + 15 < 256) {
#pragma unroll
        for (int qq = 0; qq < 2; ++qq) { const int q = 2 * wid + qq, t = t0 + q, lo = 32 * lane;
            const unsigned w = (lo + 31 <= t) ? 0xffffffffu : (lo > t ? 0u : ((1u << (t - lo + 1)) - 1u));
            MASK[(r0 + q) * 64 + lane] = w; }
        return;
    }
    const int qn = lane & 15, kg = lane >> 4;
    bf16x8_t bq[8][2];
#pragma unroll
    for (int hd = 0; hd < 8; ++hd)
#pragma unroll
        for (int ks = 0; ks < 2; ++ks) bq[hd][ks] = *(const bf16x8_t*)(QKV + (r0 + qn) * QKV_PITCH + CQ_IX + hd * 64 + ks * 32 + 8 * kg);
    float wq[8];
    { const u32x4 w = *(const u32x4*)(QKV + (r0 + qn) * QKV_PITCH + CW_IX);
      wq[0] = bflo(w.x); wq[1] = bfhi(w.x); wq[2] = bflo(w.y); wq[3] = bfhi(w.y); wq[4] = bflo(w.z); wq[5] = bfhi(w.z); wq[6] = bflo(w.w); wq[7] = bfhi(w.w); }
    const int ntiles = g + 1, ntr = (ntiles + 3) & ~3;
    const int tq = t0 + qn;
    const bf16_t* kbase = QKV + ((size_t)b * SEQ + qn) * QKV_PITCH + CK_IX + 8 * kg;
    bf16x8_t a0n, a1n;
    { const int kt0 = wid < ntiles ? wid : 0; a0n = *(const bf16x8_t*)(kbase + (size_t)(16 * kt0) * QKV_PITCH); a1n = *(const bf16x8_t*)(kbase + (size_t)(16 * kt0) * QKV_PITCH + 32); }
#pragma unroll 1
    for (int kt = wid; kt < ntr; kt += 8) {
        const bf16x8_t a0 = a0n, a1 = a1n;
        { const int ktn = (kt + 8 < ntiles) ? kt + 8 : (kt < ntiles ? kt : 0); a0n = *(const bf16x8_t*)(kbase + (size_t)(16 * ktn) * QKV_PITCH); a1n = *(const bf16x8_t*)(kbase + (size_t)(16 * ktn) * QKV_PITCH + 32); }
        u32x4 outw = (u32x4){0u, 0u, 0u, 0u};
        if (kt < ntiles) {
            f32x4_t sc = (f32x4_t){0.f, 0.f, 0.f, 0.f};
#pragma unroll
            for (int hd = 0; hd < 8; ++hd) {
                f32x4_t acc = (f32x4_t){0.f, 0.f, 0.f, 0.f};
                acc = __builtin_amdgcn_mfma_f32_16x16x32_bf16(a0, bq[hd][0], acc, 0, 0, 0);
                acc = __builtin_amdgcn_mfma_f32_16x16x32_bf16(a1, bq[hd][1], acc, 0, 0, 0);
#pragma unroll
                for (int r = 0; r < 4; ++r) sc[r] += wq[hd] * fmaxf(acc[r], 0.f);
            }
            unsigned ok[4];
#pragma unroll
            for (int r = 0; r < 4; ++r) { float s = sc[r]; if (s == 0.f) s = 0.f; ok[r] = (16 * kt + 4 * kg + r <= tq) ? ordkey(s) : 0u; }
            outw = (u32x4){ok[0], ok[1], ok[2], ok[3]};
        }
        *(__attribute__((address_space(3))) u32x4*)(lds + TK_SK_OFF + qn * TK_SKPITCH + (16 * kt + 4 * kg) * 4) = outw;
    }
    __syncthreads();
#pragma unroll 1
    for (int qq = 0; qq < 2; ++qq) {
        const int q = 2 * wid + qq, t = t0 + q, ni = (t >> 6) + 1;
        unsigned key[32];
#pragma unroll
        for (int i = 0; i < 32; ++i) key[i] = (i < ni) ? *(const __attribute__((address_space(3))) unsigned*)(lds + TK_SK_OFF + q * TK_SKPITCH + (i * 64 + lane) * 4) : 0u;
        topk_select_row(key, t, ni, MASK + (r0 + q) * 64, lane);
    }
    __syncthreads();
}
__device__ __forceinline__ void kmean_item(const bf16_t* __restrict__ QKV, float* __restrict__ KM, int item, lds_u8* lds, int wid, int lane) {
    const int h = item % 5, n = (item / 5) % 8, b = item / 40, tid = wid * 64 + lane, c8 = tid & 7, rg = tid >> 3;
    const bf16_t* kp = QKV + ((size_t)b * SEQ + n * 256 + rg) * QKV_PITCH + CK_MB + h * 64 + c8 * 8;
    float a[8];
#pragma unroll
    for (int e = 0; e < 8; ++e) a[e] = 0.f;
#pragma unroll
    for (int r = 0; r < 4; ++r) { const u32x4 w = *(const u32x4*)(kp + (size_t)(64 * r) * QKV_PITCH);
        a[0] += bflo(w.x); a[1] += bfhi(w.x); a[2] += bflo(w.y); a[3] += bfhi(w.y); a[4] += bflo(w.z); a[5] += bfhi(w.z); a[6] += bflo(w.w); a[7] += bfhi(w.w); }
    __attribute__((address_space(3))) float* red = (__attribute__((address_space(3))) float*)lds;
#pragma unroll
    for (int e = 0; e < 8; ++e) red[rg * 65 + c8 * 8 + e] = a[e];
    __syncthreads();
    if (tid < 64) { float s = 0.f;
#pragma unroll 8
        for (int r = 0; r < 64; ++r) s += red[r * 65 + tid];
        KM[(size_t)item * 64 + tid] = s * (1.f / 256.f); }
    __syncthreads();
}
__device__ __forceinline__ int queue_pop(unsigned* ctr, lds_u8* lds, int tid) {
    __attribute__((address_space(3))) volatile int* slot = (__attribute__((address_space(3))) volatile int*)(lds + QUEUE_SLOT_OFF);
    if (tid == 0) *slot = (int)__hip_atomic_fetch_add(ctr, 1u, __ATOMIC_RELAXED, __HIP_MEMORY_SCOPE_AGENT);
    __syncthreads();
    const int u = *slot;
    __syncthreads();
    return u;
}
__device__ __forceinline__ void phase_attn_a(const Params& p, unsigned char* lds_raw, int l, Ctx cx, int rep = 0) {
    const bf16_t* QKV = (const bf16_t*)(p.ws + WS_R1); bf16_t* OC = (bf16_t*)(p.ws + WS_R2);
    float* KM = (float*)(p.ws + WS_KMEAN); unsigned* MASK = (unsigned*)(p.ws + WS_MASK);
    unsigned* ctr = (unsigned*)(p.ws + WS_CTR) + 64 * (2 * l + 4 * rep);
    lds_u8* lds = (lds_u8*)lds_raw;
    const int lane = lane_id_opaque(), tid = cx.wid * 64 + lane;
    constexpr int N_SB = BATCH * H_SB * 8, N_TK = BATCH * 128, N_KM = 320;
    for (;;) {
        int u = queue_pop(ctr, lds, tid);
        if (u >= N_SB + N_TK + N_KM) break;
        if (u < N_SB) { const int qb = 7 - u / (BATCH * H_SB), r = u % (BATCH * H_SB); attn_unit<0>(QKV, OC, KM, MASK, r / H_SB, r % H_SB, qb, lds, cx.wid, lane); continue; }
        u -= N_SB;
        if (u < N_TK) { const int g = 127 - u / BATCH, b = u % BATCH; topk_unit(QKV, MASK, b, g, lds, cx.wid, lane); continue; }
        u -= N_TK;
        kmean_item(QKV, KM, u, lds, cx.wid, lane);
    }
}
__device__ __forceinline__ void phase_attn_b(const Params& p, unsigned char* lds_raw, int l, Ctx cx, int rep = 0) {
    const bf16_t* QKV = (const bf16_t*)(p.ws + WS_R1); bf16_t* OC = (bf16_t*)(p.ws + WS_R2);
    const float* KM = (const float*)(p.ws + WS_KMEAN); const unsigned* MASK = (const unsigned*)(p.ws + WS_MASK);
    unsigned* ctr = (unsigned*)(p.ws + WS_CTR) + 64 * (2 * l + 1 + 4 * rep);
    lds_u8* lds = (lds_u8*)lds_raw;
    const int lane = lane_id_opaque(), tid = cx.wid * 64 + lane;
    constexpr int NBH = BATCH * (H_MB + H_DS);
    for (;;) {
        const int u = queue_pop(ctr, lds, tid);
        if (u >= NBH * 8) break;
        const int qb = 7 - u / NBH; int r = u % NBH;
        if (r < BATCH * H_MB) { attn_unit<1>(QKV, OC, KM, MASK, r / H_MB, r % H_MB, qb, lds, cx.wid, lane); continue; }
        r -= BATCH * H_MB;
        attn_unit<2>(QKV, OC, KM, MASK, r / H_DS, r % H_DS, qb, lds, cx.wid, lane);
    }
}

__device__ __forceinline__ void phase_zero_pad(const Params& p, Ctx cx) { const int wid = cx.wid, BID = cx.bid, NBLK = cx.nblk; (void)wid; (void)BID; (void)NBLK;
    bf16_t* OC = (bf16_t*)(p.ws + WS_R2);
    const int gt = BID * NTHREADS + TIDX, NT = NBLK * NTHREADS;
    for (int i = gt; i < T * 16; i += NT) {
        const int row = i >> 4, q = i & 15, col = (q < 8 ? 704 : 1088 - 64) + q * 8;
        *(u32x4*)(OC + (size_t)row * OC_PITCH + col) = (u32x4){0u, 0u, 0u, 0u};
    }
}

namespace pg8 {
#define PG8_LAS __attribute__((address_space(3)))
typedef unsigned short bf16_t;
typedef short bf16x8 __attribute__((ext_vector_type(8)));
typedef float f32x4 __attribute__((ext_vector_type(4)));
typedef unsigned u32x4 __attribute__((ext_vector_type(4)));
constexpr int BM = 256, BK = 64, HALF = 128, HTB = HALF * BK * 2  , STAGE_BYTES = 8 * HTB, NXCD = 8, WGM = 8;

__host__ __device__ __forceinline__ int lds_byte(int r, int c) { const int st = (r >> 4) * 2 + (c >> 5), rr = r & 15, cc = c & 31, ob = rr * 64 + cc * 2; return st * 1024 + (ob ^ (((ob >> 9) & 1) << 5)); }
__host__ __device__ __forceinline__ void stage_rc(int b, int& R, int& C) { const int st = b / 1024, sb = b % 1024, swz = sb ^ (((sb >> 9) & 1) << 5); R = (st >> 1) * 16 + swz / 64; C = (st & 1) * 32 + (swz % 64) / 2; }
__host__ __device__ __forceinline__ int perm32(int rho) { const int n = rho >> 4, i = rho & 15; return 8 * (i >> 2) + 4 * n + (i & 3); }

struct Unit { int pm, pn; };
struct Gemm { const bf16_t* A; const bf16_t* Bt; int M, N, K, lda; };

struct StaticOrder {
    int nM, nN, nwg, G, c;
    __host__ __device__ void init(int M, int N, int G_, int c_) { nM = M / BM; nN = N / BM; nwg = nM * nN; G = G_; c = c_; }
    __host__ __device__ bool next(int i, Unit& u) const {
        const long L = (long)i * G + c; if (L >= nwg) return false;
        int wgid = (int)L; { const int q = nwg / NXCD, r = nwg % NXCD, xcd = wgid % NXCD, off = wgid / NXCD; wgid = (xcd < r ? xcd * (q + 1) : r * (q + 1) + (xcd - r) * q) + off; }
        const int nig = WGM * nN, gid = wgid / nig, fm = gid * WGM, gsz = (nM - fm) < WGM ? (nM - fm) : WGM;
        u.pm = fm + ((wgid % nig) % gsz); u.pn = (wgid % nig) / gsz; return true;
    }
    __device__ __forceinline__ void a_ready(const Unit&) const {}
    __device__ __forceinline__ void done(const Unit&) const {}
};


typedef float f32x2_t __attribute__((ext_vector_type(2))); typedef __bf16 bf16x2_t __attribute__((ext_vector_type(2)));
__device__ __forceinline__ unsigned cvt_pk_bf16(float lo, float hi) { f32x2_t v = {lo, hi}; bf16x2_t b = __builtin_convertvector(v, bf16x2_t); return __builtin_bit_cast(unsigned, b); }
struct EpiBf16 {
    static constexpr bool PERM = true, AFTER_DRAIN = false;
    bf16_t* O; int ldc;
    __device__ __forceinline__ void operator()(const f32x4 (&acc)[2][2][4][2], const Unit& u, int wr, int wc, int fr, int fq) const {
        const int row0 = u.pm * BM + wr * 64 + fr, col0 = u.pn * BM + wc * 32 + 8 * fq;
#pragma unroll
        for (int ai = 0; ai < 2; ++ai)
#pragma unroll
            for (int m = 0; m < 4; ++m) { bf16_t* rowp = O + (size_t)(row0 + ai * HALF + m * 16) * ldc + col0;
#pragma unroll
                for (int bj = 0; bj < 2; ++bj) { const f32x4 v0 = acc[ai][bj][m][0], v1 = acc[ai][bj][m][1];
                    u32x4 w; w.x = cvt_pk_bf16(v0[0], v0[1]); w.y = cvt_pk_bf16(v0[2], v0[3]); w.z = cvt_pk_bf16(v1[0], v1[1]); w.w = cvt_pk_bf16(v1[2], v1[3]);
                    *(u32x4*)(rowp + bj * HALF) = w; } }
    }
};

__device__ __forceinline__ float fast_sigmoid(float v) { return __builtin_amdgcn_rcpf(1.f + __builtin_amdgcn_exp2f(-1.4426950408889634f * v)); }
struct EpiSigmoid {
    static constexpr bool PERM = true, AFTER_DRAIN = false;
    bf16_t* O; int ldc; const float* bias;
    __device__ __forceinline__ void operator()(const f32x4 (&acc)[2][2][4][2], const Unit& u, int wr, int wc, int fr, int fq) const {
        const int row0 = u.pm * BM + wr * 64 + fr, col0 = u.pn * BM + wc * 32 + 8 * fq;
        f32x4 bv[2][2];
#pragma unroll
        for (int bj = 0; bj < 2; ++bj)
#pragma unroll
            for (int n = 0; n < 2; ++n) bv[bj][n] = *(const f32x4*)(bias + col0 + bj * HALF + 4 * n);
#pragma unroll
        for (int ai = 0; ai < 2; ++ai)
#pragma unroll
            for (int m = 0; m < 4; ++m) { bf16_t* rowp = O + (size_t)(row0 + ai * HALF + m * 16) * ldc + col0;
#pragma unroll
                for (int bj = 0; bj < 2; ++bj) { const f32x4 v0 = acc[ai][bj][m][0] + bv[bj][0], v1 = acc[ai][bj][m][1] + bv[bj][1];
                    u32x4 w; w.x = cvt_pk_bf16(fast_sigmoid(v0[0]), fast_sigmoid(v0[1])); w.y = cvt_pk_bf16(fast_sigmoid(v0[2]), fast_sigmoid(v0[3]));
                    w.z = cvt_pk_bf16(fast_sigmoid(v1[0]), fast_sigmoid(v1[1])); w.w = cvt_pk_bf16(fast_sigmoid(v1[2]), fast_sigmoid(v1[3]));
                    *(u32x4*)(rowp + bj * HALF) = w; } }
    }
};
struct EpiGate {
    static constexpr bool PERM = true, AFTER_DRAIN = false;
    bf16_t* O; const bf16_t* gates; int br;
    __device__ __forceinline__ void operator()(const f32x4 (&acc)[2][2][4][2], const Unit& u, int wr, int wc, int fr, int fq) const {
        const int row0 = u.pm * BM + wr * 64 + fr, col0 = u.pn * BM + wc * 32 + 8 * fq;
#pragma unroll
        for (int ai = 0; ai < 2; ++ai)
#pragma unroll
            for (int m = 0; m < 4; ++m) { const size_t row = (size_t)(row0 + ai * HALF + m * 16);
#pragma unroll
                for (int bj = 0; bj < 2; ++bj) {
                    const u32x4 gw = *(const u32x4*)(gates + row * 3072 + br * 1024 + col0 + bj * HALF);
                    u32x4 ow = (u32x4){0u, 0u, 0u, 0u};
                    if (br > 0) ow = *(const u32x4*)(O + row * 1024 + col0 + bj * HALF);
                    const f32x4 v0 = acc[ai][bj][m][0], v1 = acc[ai][bj][m][1];
                    u32x4 w;
                    w.x = cvt_pk_bf16(__uint_as_float(ow.x << 16) + __uint_as_float(gw.x << 16) * v0[0], __uint_as_float(ow.x & 0xffff0000u) + __uint_as_float(gw.x & 0xffff0000u) * v0[1]);
                    w.y = cvt_pk_bf16(__uint_as_float(ow.y << 16) + __uint_as_float(gw.y << 16) * v0[2], __uint_as_float(ow.y & 0xffff0000u) + __uint_as_float(gw.y & 0xffff0000u) * v0[3]);
                    w.z = cvt_pk_bf16(__uint_as_float(ow.z << 16) + __uint_as_float(gw.z << 16) * v1[0], __uint_as_float(ow.z & 0xffff0000u) + __uint_as_float(gw.z & 0xffff0000u) * v1[1]);
                    w.w = cvt_pk_bf16(__uint_as_float(ow.w << 16) + __uint_as_float(gw.w << 16) * v1[2], __uint_as_float(ow.w & 0xffff0000u) + __uint_as_float(gw.w & 0xffff0000u) * v1[3]);
                    *(u32x4*)(O + row * 1024 + col0 + bj * HALF) = w; } }
    }
};
struct EpiSwiglu {
    static constexpr bool PERM = true, AFTER_DRAIN = false;
    bf16_t* O; int ldc;
    __device__ __forceinline__ void operator()(const f32x4 (&acc)[2][2][4][2], const Unit& u, int wr, int wc, int fr, int fq) const {
        const int row0 = u.pm * BM + wr * 64 + fr, col0 = u.pn * HALF + wc * 32 + 8 * fq;
#pragma unroll
        for (int ai = 0; ai < 2; ++ai)
#pragma unroll
            for (int m = 0; m < 4; ++m) { bf16_t* rowp = O + (size_t)(row0 + ai * HALF + m * 16) * ldc + col0;
                float o[8];
#pragma unroll
                for (int n = 0; n < 2; ++n)
#pragma unroll
                    for (int e = 0; e < 4; ++e) { const float gt = acc[ai][0][m][n][e]; o[n * 4 + e] = gt * fast_sigmoid(gt) * acc[ai][1][m][n][e]; }
                u32x4 w; w.x = cvt_pk_bf16(o[0], o[1]); w.y = cvt_pk_bf16(o[2], o[3]); w.z = cvt_pk_bf16(o[4], o[5]); w.w = cvt_pk_bf16(o[6], o[7]);
                *(u32x4*)rowp = w; }
    }
};

template <class Epi, class Sched, bool ALIGN_EPI = false, bool SP2 = false>
__device__ __forceinline__ void gemm_phase(PG8_LAS unsigned char* lds, const Gemm g, const Sched& S, const Epi& E, int wid_in) {
    const int wid = wid_in, lane = lane_id_opaque(), tid = wid * 64 + lane, wr = wid >> 2, wc = wid & 3, fr = lane & 15, fq = lane >> 4;
    const int K = g.K, nt = K / BK;
    unsigned voffA[2], voffB[2];
#pragma unroll
    for (int i = 0; i < 2; ++i) { int R, C; stage_rc(tid * 16 + i * 8192, R, C); const int Rb = Epi::PERM ? ((R & ~31) + perm32(R & 31)) : R;
        voffA[i] = (unsigned)(R * g.lda + C) * 2u; voffB[i] = (unsigned)(Rb * K + C) * 2u; }
    const size_t kstep = (size_t)(BK * 2);
    const size_t hstepA = (size_t)HALF * g.lda * 2, hstepB = (size_t)HALF * K * 2;
    const size_t tstepA = 2 * hstepA, tstepB = 2 * hstepB;
    const unsigned ldsw = (unsigned)wid * 1024u;
    const int aoff = lds_byte(wr * 64 + fr, fq * 8), boff = lds_byte(wc * 32 + fr, fq * 8);
#define PG8_SA(b, h) (((b) * 2 + (h)) * HTB)
#define PG8_SB(b, h) ((4 + (b) * 2 + (h)) * HTB)
#define PG8_STAGE(bufoff, gbase, voff) do { _Pragma("unroll") for (int _i = 0; _i < 2; ++_i) \
        __builtin_amdgcn_global_load_lds((const unsigned*)((const char*)(gbase) + (voff)[_i]), (PG8_LAS unsigned*)(lds + (bufoff) + ldsw + _i * 8192), 16, 0, 0); } while (0)
#define PG8_LDA(dst, b, h) do { _Pragma("unroll") for (int m = 0; m < 4; ++m) _Pragma("unroll") for (int k = 0; k < 2; ++k) dst[m][k] = *(const PG8_LAS bf16x8*)(lds + PG8_SA(b, h) + aoff + m * 2048 + k * 1024); } while (0)
#define PG8_LDB(dst, b, h) do { _Pragma("unroll") for (int n = 0; n < 2; ++n) _Pragma("unroll") for (int k = 0; k < 2; ++k) dst[n][k] = *(const PG8_LAS bf16x8*)(lds + PG8_SB(b, h) + boff + n * 2048 + k * 1024); } while (0)
#define PG8_MMA(ai, bj, At, Bt) do { __builtin_amdgcn_s_setprio(1); _Pragma("unroll") for (int m = 0; m < 4; ++m) _Pragma("unroll") for (int n = 0; n < 2; ++n) _Pragma("unroll") for (int k = 0; k < 2; ++k) \
        acc[ai][bj][m][n] = __builtin_amdgcn_mfma_f32_16x16x32_bf16(Bt[n][k], At[m][k], acc[ai][bj][m][n], 0, 0, 0); __builtin_amdgcn_s_setprio(0); } while (0)
#define PG8_WAIT_V(n) asm volatile("s_waitcnt vmcnt(" #n ")" ::: "memory")
#define PG8_WAIT_L(n) asm volatile("s_waitcnt lgkmcnt(" #n ")" ::: "memory")
#define PG8_BAR __builtin_amdgcn_s_barrier()
#define PG8_SCHED __builtin_amdgcn_sched_barrier(0)
    Unit cur, nxt; int ui = 0;
    if (!S.next(0, cur)) return;
    f32x4 acc[2][2][4][2];
#pragma unroll
    for (int a = 0; a < 2; ++a)
#pragma unroll
        for (int b = 0; b < 2; ++b)
#pragma unroll
            for (int m = 0; m < 4; ++m)
#pragma unroll
                for (int n = 0; n < 2; ++n) acc[a][b][m][n] = (f32x4){0.f, 0.f, 0.f, 0.f};
    bf16x8 At[4][2], B0[2][2], B1[2][2];
    const char* cA = (const char*)g.A + (size_t)cur.pm * tstepA; const char* cB = (const char*)g.Bt + (size_t)cur.pn * tstepB;
    S.a_ready(cur);
    if constexpr (SP2) {
        PG8_STAGE(PG8_SB(0, 0), cB, voffB); PG8_STAGE(PG8_SB(0, 1), cB + hstepB, voffB); PG8_STAGE(PG8_SA(0, 0), cA, voffA); PG8_STAGE(PG8_SA(0, 1), cA + hstepA, voffA);
        if (wr == 1) PG8_BAR;
        PG8_WAIT_V(2); PG8_BAR;
        PG8_STAGE(PG8_SB(1, 0), cB + kstep, voffB); PG8_STAGE(PG8_SA(1, 0), cA + kstep, voffA); PG8_STAGE(PG8_SB(1, 1), cB + hstepB + kstep, voffB);
        PG8_WAIT_V(6); PG8_BAR;
    } else {
        PG8_STAGE(PG8_SB(0, 0), cB, voffB); PG8_STAGE(PG8_SA(0, 0), cA, voffA); PG8_STAGE(PG8_SB(0, 1), cB + hstepB, voffB); PG8_STAGE(PG8_SA(0, 1), cA + hstepA, voffA);
        if (wr == 1) PG8_BAR;
        PG8_WAIT_V(4); PG8_BAR;
        PG8_STAGE(PG8_SB(1, 0), cB + kstep, voffB); PG8_STAGE(PG8_SA(1, 0), cA + kstep, voffA); PG8_STAGE(PG8_SB(1, 1), cB + hstepB + kstep, voffB);
        PG8_WAIT_V(6); PG8_BAR;
    }
    for (;;) {
        const bool has_next = S.next(ui + 1, nxt);
        const char* nA = has_next ? (const char*)g.A + (size_t)nxt.pm * tstepA : cA; const char* nB = has_next ? (const char*)g.Bt + (size_t)nxt.pn * tstepB : cB;
        for (int t = 0; t < nt; t += 2) {
            const bool last = (t == nt - 2);
            const char* a1 = cA + (size_t)(t + 1) * kstep;
            const char* a2 = last ? nA : cA + (size_t)(t + 2) * kstep; const char* b2 = last ? nB : cB + (size_t)(t + 2) * kstep;
            const char* a3 = a2 + kstep; const char* b3 = b2 + kstep;
            if (last && has_next) S.a_ready(nxt);
            if constexpr (SP2) {
            PG8_LDB(B0, 0, 0); PG8_LDB(B1, 0, 1); PG8_SCHED; PG8_LDA(At, 0, 0); PG8_STAGE(PG8_SA(1, 1), a1 + hstepA, voffA);
            PG8_WAIT_V(8); PG8_WAIT_L(0); PG8_BAR; PG8_MMA(0, 0, At, B0); PG8_MMA(0, 1, At, B1); PG8_BAR; PG8_SCHED;
            PG8_LDA(At, 0, 1); PG8_STAGE(PG8_SB(0, 0), b2, voffB); PG8_STAGE(PG8_SB(0, 1), b2 + hstepB, voffB); PG8_STAGE(PG8_SA(0, 0), a2, voffA);
            PG8_WAIT_V(8); PG8_WAIT_L(0); PG8_BAR; PG8_MMA(1, 0, At, B0); PG8_MMA(1, 1, At, B1); PG8_BAR; PG8_SCHED;
            PG8_LDB(B0, 1, 0); PG8_LDB(B1, 1, 1); PG8_SCHED; PG8_LDA(At, 1, 0); PG8_STAGE(PG8_SA(0, 1), a2 + hstepA, voffA);
            PG8_WAIT_V(8); PG8_WAIT_L(0); PG8_BAR; PG8_MMA(0, 0, At, B0); PG8_MMA(0, 1, At, B1); PG8_BAR; PG8_SCHED;
            PG8_LDA(At, 1, 1); PG8_STAGE(PG8_SB(1, 0), b3, voffB); PG8_STAGE(PG8_SB(1, 1), b3 + hstepB, voffB); PG8_STAGE(PG8_SA(1, 0), a3, voffA);
            PG8_WAIT_V(8); PG8_WAIT_L(0); PG8_BAR; PG8_MMA(1, 0, At, B0); PG8_MMA(1, 1, At, B1); PG8_BAR; PG8_SCHED;
            } else {
            PG8_LDB(B0, 0, 0); PG8_SCHED; PG8_LDA(At, 0, 0); PG8_STAGE(PG8_SA(1, 1), a1 + hstepA, voffA);
            PG8_WAIT_L(8); PG8_BAR; PG8_WAIT_L(0); PG8_MMA(0, 0, At, B0); PG8_BAR; PG8_SCHED;
            PG8_LDB(B1, 0, 1); PG8_STAGE(PG8_SB(0, 0), b2, voffB);
            PG8_BAR; PG8_WAIT_L(0); PG8_MMA(0, 1, At, B1); PG8_BAR;
            PG8_LDA(At, 0, 1); PG8_STAGE(PG8_SA(0, 0), a2, voffA);
            PG8_BAR; PG8_WAIT_L(0); PG8_MMA(1, 0, At, B0); PG8_BAR; PG8_SCHED;
            PG8_STAGE(PG8_SB(0, 1), b2 + hstepB, voffB);
            PG8_WAIT_V(6); PG8_BAR; PG8_MMA(1, 1, At, B1); PG8_BAR;
            PG8_LDB(B0, 1, 0); PG8_SCHED; PG8_LDA(At, 1, 0); PG8_STAGE(PG8_SA(0, 1), a2 + hstepA, voffA);
            PG8_WAIT_L(8); PG8_BAR; PG8_WAIT_L(0); PG8_MMA(0, 0, At, B0); PG8_BAR; PG8_SCHED;
            PG8_LDB(B1, 1, 1); PG8_STAGE(PG8_SB(1, 0), b3, voffB);
            PG8_BAR; PG8_WAIT_L(0); PG8_MMA(0, 1, At, B1); PG8_BAR;
            PG8_LDA(At, 1, 1); PG8_STAGE(PG8_SA(1, 0), a3, voffA);
            PG8_BAR; PG8_WAIT_L(0); PG8_MMA(1, 0, At, B0); PG8_BAR; PG8_SCHED;
            PG8_STAGE(PG8_SB(1, 1), b3 + hstepB, voffB);
            PG8_WAIT_V(6); PG8_BAR; PG8_MMA(1, 1, At, B1); PG8_BAR;
            }
        }
        if constexpr (ALIGN_EPI) { if (wr == 0) PG8_BAR; }
        if constexpr (!Epi::AFTER_DRAIN) { const int le_ = lane_id_opaque(); E(acc, cur, wr, wc, le_ & 15, le_ >> 4); S.done(cur); }
        if (!has_next) break;
#pragma unroll
        for (int a = 0; a < 2; ++a)
#pragma unroll
            for (int b = 0; b < 2; ++b)
#pragma unroll
                for (int m = 0; m < 4; ++m)
#pragma unroll
                    for (int n = 0; n < 2; ++n) acc[a][b][m][n] = (f32x4){0.f, 0.f, 0.f, 0.f};
        cur = nxt; cA = nA; cB = nB; ++ui;
        if constexpr (ALIGN_EPI) { if (wr == 1) PG8_BAR; }
    }
    PG8_WAIT_V(0);
    if constexpr (!ALIGN_EPI) { if (wr == 0) PG8_BAR; }
    PG8_BAR;
    if constexpr (Epi::AFTER_DRAIN) { E.fused(acc, cur, wr, wc, fr, fq, lds, wid, lane); S.done(cur); }
#undef PG8_SA
#undef PG8_SB
#undef PG8_STAGE
#undef PG8_LDA
#undef PG8_LDB
#undef PG8_MMA
#undef PG8_WAIT_V
#undef PG8_WAIT_L
#undef PG8_BAR
#undef PG8_SCHED
}
}


constexpr size_t WT_IN1 = 0;
constexpr size_t WT_G = WT_IN1 + (size_t)3840 * 1024 * 2;
constexpr size_t WT_PROJ = WT_G + (size_t)3072 * 1024 * 2;
constexpr size_t WT_O = WT_PROJ + (size_t)3 * 1024 * 384 * 2;
constexpr size_t WT_UP = WT_O + (size_t)1024 * 1024 * 2;
constexpr size_t WT_DOWN = WT_UP + (size_t)5632 * 1024 * 2;
constexpr size_t WT_END = WT_DOWN + (size_t)1024 * 2816 * 2;
static_assert(WS_WT + WT_END <= WS_R3, "weight copies fit");

__device__ __forceinline__ void tr_item(const float* W, int ldw, int col0, int Kv, int Nv, bf16_t* WT, int ldk, int k0, int n0, int drow0, float* scr, int lane) {
    const int nn = lane & 31; const bool nok = (n0 + nn) < Nv;
#pragma unroll 8
    for (int i = 0; i < 32; ++i) { const int kk = 2 * i + (lane >> 5);
        float v = 0.f; if (nok && (k0 + kk) < Kv) v = W[(size_t)(k0 + kk) * ldw + col0 + n0 + nn];
        scr[kk * 33 + nn] = v; }
    asm volatile("s_waitcnt lgkmcnt(0)" ::: "memory");
    const int c = lane & 7;
#pragma unroll
    for (int j = 0; j < 4; ++j) { const int n = (lane >> 3) + 8 * j; const float* s = scr + (8 * c) * 33 + n;
        u32x4 o; o.x = pk2(s[0 * 33], s[1 * 33]); o.y = pk2(s[2 * 33], s[3 * 33]); o.z = pk2(s[4 * 33], s[5 * 33]); o.w = pk2(s[6 * 33], s[7 * 33]);
        *(u32x4*)(WT + (size_t)(drow0 + n) * ldk + k0 + 8 * c) = o; }
    asm volatile("s_waitcnt lgkmcnt(0)" ::: "memory");
}
__device__ __forceinline__ void phase_weights(const Params& p, int l, float* lds, Ctx cx) { const int wid = cx.wid, BID = cx.bid, NBLK = cx.nblk; (void)wid; (void)BID; (void)NBLK;
    const int lane = lane_id_opaque(), wave = wid, gw = BID * NWAVES + wave, NGW = NBLK * NWAVES;
    float* scr = lds + wave * (64 * 33);
    unsigned char* wt = p.ws + WS_WT;
    constexpr int I_IN1 = 16 * 120, I_G = 16 * 96, I_P = 6 * 32, I_O = 16 * 32, I_UP = 16 * 176, I_DN = 44 * 32;
    constexpr int NITEMS = I_IN1 + I_G + 3 * I_P + I_O + I_UP + I_DN;
    const float* w_in = p.w_in + (size_t)l * DM * D_IN;
    for (int it = gw; it < NITEMS; it += NGW) {
        int r = it;
        if (r < I_IN1) { const int kb = r / 120, nb = r % 120; tr_item(w_in, D_IN, 0, 1024, NQ1, (bf16_t*)(wt + WT_IN1), 1024, kb * 64, nb * 32, nb * 32, scr, lane); continue; } r -= I_IN1;
        if (r < I_G) { const int kb = r / 96, nb = r % 96; tr_item(w_in, D_IN, NQ1, 1024, NGATE, (bf16_t*)(wt + WT_G), 1024, kb * 64, nb * 32, nb * 32, scr, lane); continue; } r -= I_G;
        if (r < 3 * I_P) { const int br = r / I_P, q = r % I_P, kb = q / 32, nb = q % 32;
            const float* W = br == 0 ? p.w_proj_sb + (size_t)l * 384 * DM : br == 1 ? p.w_proj_mb + (size_t)l * 320 * DM : p.w_proj_ds + (size_t)l * 320 * DM;
            tr_item(W, DM, 0, br == 0 ? 384 : 320, DM, (bf16_t*)(wt + WT_PROJ) + (size_t)br * 1024 * 384, 384, kb * 64, nb * 32, nb * 32, scr, lane); continue; } r -= 3 * I_P;
        if (r < I_O) { const int kb = r / 32, nb = r % 32; tr_item(p.w_o + (size_t)l * DM * DM, DM, 0, 1024, DM, (bf16_t*)(wt + WT_O), 1024, kb * 64, nb * 32, nb * 32, scr, lane); continue; } r -= I_O;
        if (r < I_UP) { const int kb = r / 176, nb = r % 176, n0 = nb * 32, bj = n0 / DFF, rr = n0 % DFF, drow0 = 256 * (rr / 128) + 128 * bj + (rr % 128);
            tr_item(p.w_up + (size_t)l * DM * 2 * DFF, 2 * DFF, 0, 1024, 2 * DFF, (bf16_t*)(wt + WT_UP), 1024, kb * 64, n0, drow0, scr, lane); continue; } r -= I_UP;
        { const int kb = r / 32, nb = r % 32; tr_item(p.w_down + (size_t)l * DFF * DM, DM, 0, DFF, DM, (bf16_t*)(wt + WT_DOWN), DFF, kb * 64, nb * 32, nb * 32, scr, lane); }
    }
}

#define XB_TMO      128
#define XB_XCNT(j)  (256  + 64 * (j))
#define XB_XSUB(j)  (1280 + 64 * (j))
#define XB_XGEN(j)  (2304 + 64 * (j))
#define XB_TOP      3328
#define XB_TOPGEN   3392
#define XCD_BAR_WORDS 3456
#define XB_SPIN_CAP (1u << 18)

__device__ __forceinline__ unsigned xb_ld(unsigned* p)              { return __hip_atomic_load(p, __ATOMIC_RELAXED, __HIP_MEMORY_SCOPE_AGENT); }
__device__ __forceinline__ unsigned xb_add(unsigned* p, unsigned v) { return __hip_atomic_fetch_add(p, v, __ATOMIC_RELAXED, __HIP_MEMORY_SCOPE_AGENT); }
__device__ __forceinline__ unsigned xb_xcc_id() { return (unsigned)__builtin_amdgcn_s_getreg((3 << 11) | 20) & 0xFu; }
#define XB_SPIN(cond, bar) do { unsigned _sp = 0; while (cond) { __builtin_amdgcn_s_sleep(1); \
    if ((++_sp & 255u) == 0u) { if (xb_ld(&(bar)[XB_TMO])) break; if (_sp > XB_SPIN_CAP) { atomicAdd(&(bar)[XB_TMO], 1u); break; } } } } while (0)

struct XcdBarrier {
    unsigned* bar; unsigned x;
    volatile __attribute__((address_space(3))) unsigned* st;
};

__device__ __forceinline__ XcdBarrier xcd_barrier_post(unsigned* bar, volatile __attribute__((address_space(3))) unsigned* st) {
    XcdBarrier b; b.bar = bar; b.x = xb_xcc_id(); b.st = st;
    if (threadIdx.x == 0) (void)xb_add(&bar[XB_XCNT(b.x)], 1u);
    return b;
}
__device__ __forceinline__ void xcd_barrier_complete(unsigned* bar, unsigned x, unsigned& nloc, unsigned& nx) {
    const unsigned G = gridDim.x * gridDim.y * gridDim.z;
    unsigned sum, cnt, mine, sp = 0u;
    for (;;) {
        sum = 0u; cnt = 0u; mine = 0u;
#pragma unroll
        for (unsigned j = 0; j < 16; ++j) { const unsigned c = xb_ld(&bar[XB_XCNT(j)]); sum += c; cnt += (c > 0u) ? 1u : 0u; mine = (j == x) ? c : mine; }
        if (sum == G) break;
        __builtin_amdgcn_s_sleep(1);
        if ((++sp & 255u) == 0u) { if (xb_ld(&bar[XB_TMO])) break; if (sp > XB_SPIN_CAP) { atomicAdd(&bar[XB_TMO], 1u); break; } }
    }
    nloc = mine > 0u ? mine : 1u; nx = cnt > 0u ? cnt : 1u;
}

__device__ __forceinline__ void xcd_barrier(const XcdBarrier& b) {
    asm volatile("s_waitcnt vmcnt(0)" ::: "memory");
    __syncthreads();
    if (threadIdx.x == 0) {
        unsigned* bar = b.bar;
        __builtin_amdgcn_s_waitcnt(0);
        unsigned nloc = b.st[0], nx = b.st[1];
        if (nloc == 0u) { xcd_barrier_complete(bar, b.x, nloc, nx); b.st[0] = nloc; b.st[1] = nx; }
        const unsigned old = xb_add(&bar[XB_XSUB(b.x)], 1u);
        const unsigned gen = old / nloc;
        if (old + 1u == (gen + 1u) * nloc) {
            __builtin_amdgcn_fence(__ATOMIC_RELEASE, "agent");
            asm volatile("s_waitcnt vmcnt(0)" ::: "memory");
            const unsigned og = xb_add(&bar[XB_TOP], 1u);
            const unsigned tg = og / nx;
            if (og + 1u == (tg + 1u) * nx) xb_add(&bar[XB_TOPGEN], 1u);
            else XB_SPIN(xb_ld(&bar[XB_TOPGEN]) == tg, bar);
            __builtin_amdgcn_fence(__ATOMIC_ACQUIRE, "agent");
            xb_add(&bar[XB_XGEN(b.x)], 1u);
            asm volatile("s_waitcnt vmcnt(0)" ::: "memory");
        } else {
            XB_SPIN(xb_ld(&bar[XB_XGEN(b.x)]) == gen, bar);
            __builtin_amdgcn_fence(__ATOMIC_ACQUIRE, "agent");
            asm volatile("s_waitcnt vmcnt(0)" ::: "memory");
        }
    }
    __syncthreads();
}

#define GRID_SYNC() do { XcdBarrier xb_; { kparams_t ppx_ = (kparams_t)__builtin_amdgcn_kernarg_segment_ptr(); asm volatile("" : "+s"(ppx_)); xb_.bar = (unsigned*)(ppx_->ws + WS_CTR) + CW_BAR; } \
    xb_.x = xb_xcc_id(); xb_.st = (volatile __attribute__((address_space(3))) unsigned*)((lds_u8*)lds_raw_ + XB_ST_OFF); xcd_barrier(xb_); } while (0)
#ifndef ATTN_QUEUE
#define ATTN_QUEUE 1
#endif
#ifndef ATTN_FAST
#define ATTN_FAST 7
#endif
#ifndef FASTMASK
#define FASTMASK 63
#endif
#define GRID_SYNC_CG() do { asm volatile("s_waitcnt vmcnt(0) lgkmcnt(0)" ::: "memory"); grid.sync(); __builtin_amdgcn_fence(__ATOMIC_ACQUIRE, "agent"); asm volatile("s_waitcnt vmcnt(0)" ::: "memory"); } while (0)
constexpr int RING_BYTES = 131072, LDS_BYTES = 151552;
static_assert(TK_LDS_END <= QUEUE_SLOT_OFF && QUEUE_SLOT_OFF + 16 <= LDS_BYTES, "LDS map");
typedef const __attribute__((address_space(4))) Params* kparams_t;
__device__ __forceinline__ Params load_params(kparams_t pp) {
    Params p; p.x = pp->x; p.c = pp->c; p.w_ada = pp->w_ada; p.b_ada = pp->b_ada; p.g_pre_mix = pp->g_pre_mix; p.g_post_mix = pp->g_post_mix; p.w_in = pp->w_in; p.b_gate = pp->b_gate;
    p.w_proj_sb = pp->w_proj_sb; p.w_proj_mb = pp->w_proj_mb; p.w_proj_ds = pp->w_proj_ds; p.w_o = pp->w_o; p.g_pre_ffn = pp->g_pre_ffn; p.g_post_ffn = pp->g_post_ffn; p.w_up = pp->w_up; p.w_down = pp->w_down;
    p.out = pp->out; p.ws = pp->ws; p.mask = pp->mask; return p;
}
__device__ __forceinline__ bool phase_on(int k) { kparams_t pp = (kparams_t)__builtin_amdgcn_kernarg_segment_ptr(); asm volatile("" : "+s"(pp)); unsigned long long m = pp->mask; asm volatile("" : "+s"(m)); return (m >> k) & 1ull; }
#define PHASE_BEGIN Ctx cx; { int b_ = blockIdx.x, g_ = gridDim.x, w_ = wid; asm volatile("" : "+s"(b_), "+s"(g_), "+s"(w_)); cx.bid = b_; cx.nblk = g_; cx.wid = w_; } kparams_t pp_ = (kparams_t)__builtin_amdgcn_kernarg_segment_ptr(); asm volatile("" : "+s"(pp_)); const Params p = load_params(pp_); \
    unsigned char* ws_ = p.ws; bf16_t* R1 = (bf16_t*)(ws_ + WS_R1); bf16_t* R2 = (bf16_t*)(ws_ + WS_R2); bf16_t* R3 = (bf16_t*)(ws_ + WS_R3); unsigned char* wt = ws_ + WS_WT; (void)R1; (void)R2; (void)R3; (void)wt;
#define PHX(k) phase_on(k)
#define PH(k) phase_on((k) + 16 * l)
template <int l> __device__ __forceinline__ void layer_body(cg::grid_group& grid, float* lds, PG8_LAS unsigned char* lds3, int wid) {
        unsigned char* lds_raw_ = (unsigned char*)lds;
        if (PH(0)) {
            PHASE_BEGIN
            if constexpr ((FASTMASK >> 0) & 1) {
            pg8::Gemm g{R3, (const bf16_t*)(wt + WT_IN1), T, QKV_PITCH, DM, DM}; pg8::StaticOrder S; S.init(T, QKV_PITCH, cx.nblk, cx.bid);
            pg8::EpiBf16 E{R1, QKV_PITCH};
            pg8::gemm_phase<pg8::EpiBf16, pg8::StaticOrder, true, true>(lds3, g, S, E, cx.wid);
            } else {
                NGemm<1> g; g.s[0] = NSeg{R3, DM, p.w_in + (size_t)l * DM * D_IN, D_IN, DM}; g.M = T; g.N = NQ1;
                NEpi e{R1, QKV_PITCH, nullptr, nullptr};
                naive_gemm<1, 0>(lds, g, e, cx);
            }
        }
        GRID_SYNC();
#if ATTN_QUEUE
        if (PH(1)) { PHASE_BEGIN phase_zero_pad(p, cx); __syncthreads(); phase_attn_a(p, lds_raw_, l, cx);
#ifdef PROBE_DUP_A
            __syncthreads(); phase_attn_a(p, lds_raw_, l, cx, 1);
#endif
        }
#else
        if (PH(1)) { PHASE_BEGIN phase_kmean(p, cx); phase_dsa_topk(p, lds, cx); }
        if (PH(2)) { PHASE_BEGIN if constexpr (!(ATTN_FAST & 1)) phase_naive_attn<0>(p, cx); phase_zero_pad(p, cx); if constexpr (ATTN_FAST & 1) { __syncthreads(); phase_fast_attn<1>(p, lds_raw_, cx); } }
#endif
        GRID_SYNC();
#if ATTN_QUEUE
        if (PH(3)) { PHASE_BEGIN phase_attn_b(p, lds_raw_, l, cx);
#ifdef PROBE_DUP_B
            __syncthreads(); phase_attn_b(p, lds_raw_, l, cx, 1);
#endif
        }
#else
        if (PH(3)) { PHASE_BEGIN if constexpr (!(ATTN_FAST & 2)) phase_naive_attn<1>(p, cx); }
        if (PH(3)) { PHASE_BEGIN if constexpr (!(ATTN_FAST & 4)) phase_naive_attn<2>(p, cx); }
        if (PH(3)) { PHASE_BEGIN if constexpr ((ATTN_FAST & 6) != 0) phase_fast_attn<(ATTN_FAST & 6)>(p, lds_raw_, cx); }
#endif
        GRID_SYNC();
        if (PH(4)) {
            PHASE_BEGIN
            if constexpr ((FASTMASK >> 1) & 1) {
            pg8::Gemm g{R3, (const bf16_t*)(wt + WT_G), T, NGATE, DM, DM}; pg8::StaticOrder S; S.init(T, NGATE, cx.nblk, cx.bid);
            pg8::EpiSigmoid E{R1, NGATE, p.b_gate + l * NGATE};
            pg8::gemm_phase<pg8::EpiSigmoid, pg8::StaticOrder, true, true>(lds3, g, S, E, cx.wid);
            } else {
                NGemm<1> g; g.s[0] = NSeg{R3, DM, p.w_in + (size_t)l * DM * D_IN + NQ1, D_IN, DM}; g.M = T; g.N = NGATE;
                NEpi e{R1, NGATE, p.b_gate + l * NGATE, nullptr};
                naive_gemm<1, 1>(lds, g, e, cx);
            }
        }
        GRID_SYNC();
#pragma unroll
        for (int br = 0; br < 3; ++br) if (PH(5 + br)) {
            PHASE_BEGIN
            if constexpr ((FASTMASK >> 2) & 1) {
            pg8::Gemm g{R2 + br * 384, (const bf16_t*)(wt + WT_PROJ) + (size_t)br * 1024 * 384, T, DM, 384, OC_PITCH}; pg8::StaticOrder S; S.init(T, DM, cx.nblk, cx.bid);
            pg8::EpiGate E{R3, R1, br};
            pg8::gemm_phase<pg8::EpiGate, pg8::StaticOrder, true, true>(lds3, g, S, E, cx.wid);
            asm volatile("s_waitcnt vmcnt(0)" ::: "memory");
            __builtin_amdgcn_fence(__ATOMIC_ACQUIRE, "agent");
            asm volatile("s_waitcnt vmcnt(0)" ::: "memory");
            __syncthreads();
            } else {
                if (br == 0) {
                    NGemm<3> g;
                    g.s[0] = NSeg{R2 + CO_SB, OC_PITCH, p.w_proj_sb + (size_t)l * 384 * DM, DM, 384};
                    g.s[1] = NSeg{R2 + CO_MB, OC_PITCH, p.w_proj_mb + (size_t)l * 320 * DM, DM, 320};
                    g.s[2] = NSeg{R2 + CO_DS, OC_PITCH, p.w_proj_ds + (size_t)l * 320 * DM, DM, 320};
                    g.M = T; g.N = DM;
                    NEpi e{R3, DM, nullptr, R1};
                    naive_gemm<3, 2>(lds, g, e, cx);
                }
            }
        }
        GRID_SYNC();
        if (PH(8)) {
            PHASE_BEGIN
            if constexpr ((FASTMASK >> 3) & 1) {
            pg8::Gemm g{R3, (const bf16_t*)(wt + WT_O), T, DM, DM, DM}; pg8::StaticOrder S; S.init(T, DM, cx.nblk, cx.bid);
            pg8::EpiBf16 E{R2, DM};
            pg8::gemm_phase<pg8::EpiBf16, pg8::StaticOrder, true, true>(lds3, g, S, E, cx.wid);
            } else {
                NGemm<1> g; g.s[0] = NSeg{R3, DM, p.w_o + (size_t)l * DM * DM, DM, DM}; g.M = T; g.N = DM;
                NEpi e{R2, DM, nullptr, nullptr};
                naive_gemm<1, 0>(lds, g, e, cx);
            }
        }
        GRID_SYNC();
        if (PH(9)) { PHASE_BEGIN phase_postnorm(p, l == 0 ? p.x : p.out, p.g_post_mix + l * DM, l, 0, cx); }
        GRID_SYNC();
        if (PH(10)) {
            PHASE_BEGIN
            if constexpr ((FASTMASK >> 4) & 1) {
            pg8::Gemm g{R3, (const bf16_t*)(wt + WT_UP), T, 2 * DFF, DM, DM}; pg8::StaticOrder S; S.init(T, 2 * DFF, cx.nblk, cx.bid);
            pg8::EpiSwiglu E{R1, DFF};
            pg8::gemm_phase<pg8::EpiSwiglu, pg8::StaticOrder, true, true>(lds3, g, S, E, cx.wid);
            } else {
                const float* wu = p.w_up + (size_t)l * DM * 2 * DFF;
                NGemm<2> g; g.s[0] = NSeg{R3, DM, wu, 2 * DFF, DM}; g.s[1] = NSeg{R3, DM, wu + DFF, 2 * DFF, DM}; g.M = T; g.N = DFF;
                NEpi e{R1, DFF, nullptr, nullptr};
                naive_gemm<2, 3>(lds, g, e, cx);
            }
        }
        GRID_SYNC();
        if (PH(11)) {
            PHASE_BEGIN
            if constexpr ((FASTMASK >> 5) & 1) {
            pg8::Gemm g{R1, (const bf16_t*)(wt + WT_DOWN), T, DM, DFF, DFF}; pg8::StaticOrder S; S.init(T, DM, cx.nblk, cx.bid);
            pg8::EpiBf16 E{R2, DM};
            pg8::gemm_phase<pg8::EpiBf16, pg8::StaticOrder, true, true>(lds3, g, S, E, cx.wid);
            } else {
                NGemm<1> g; g.s[0] = NSeg{R1, DFF, p.w_down + (size_t)l * DFF * DM, DM, DFF}; g.M = T; g.N = DM;
                NEpi e{R2, DM, nullptr, nullptr};
                naive_gemm<1, 0>(lds, g, e, cx);
            }
        }
        GRID_SYNC();
        if (PH(12)) { PHASE_BEGIN phase_postnorm(p, p.out, p.g_post_ffn + l * DM, l, 1, cx); }
        if (l + 1 < DEPTH) { if (PH(13)) { PHASE_BEGIN __syncthreads(); phase_weights(p, l + 1, lds, cx); } }
        GRID_SYNC();
    }
__global__ void __launch_bounds__(NTHREADS, 2) mega_fwd(Params p_kernarg) {
    cg::grid_group grid = cg::this_grid();
    const int wid = __builtin_amdgcn_readfirstlane((int)threadIdx.x >> 6);
    extern __shared__ __attribute__((aligned(16))) unsigned char lds_raw[];
    float* lds = (float*)lds_raw;
    PG8_LAS unsigned char* lds3 = (PG8_LAS unsigned char*)lds_raw;
    unsigned char* lds_raw_ = lds_raw;
    if (wid == 0) { const int ln = lane_id_opaque(); if (ln < 4) ((__attribute__((address_space(3))) unsigned*)((lds_u8*)lds_raw + XB_ST_OFF))[ln] = 0u; }
    __syncthreads();
    if (PHX(60)) { PHASE_BEGIN if (cx.bid == 0) { const int t_ = cx.wid * 64 + lane_id_opaque(); unsigned* cw = (unsigned*)(p.ws + WS_CTR); if (t_ < 8) cw[64 * t_] = 0u; for (int i_ = t_; i_ < XCD_BAR_WORDS; i_ += NTHREADS) cw[CW_BAR + i_] = 0u; } phase_mod(p, lds, cx); __syncthreads(); }
    if (PHX(61)) { PHASE_BEGIN phase_weights(p, 0, lds, cx); }
    GRID_SYNC_CG();
    { PHASE_BEGIN (void)xcd_barrier_post((unsigned*)(p.ws + WS_CTR) + CW_BAR, (volatile __attribute__((address_space(3))) unsigned*)((lds_u8*)lds_raw + XB_ST_OFF)); }
    if (PHX(62)) { PHASE_BEGIN phase_prenorm(p, p.x, p.g_pre_mix, 0, 0, cx); }
    GRID_SYNC();
    layer_body<0>(grid, lds, lds3, wid);
    layer_body<1>(grid, lds, lds3, wid);
}

extern "C" void kernel_launch(void* const* d_in, const int* in_sizes, int n_in, void* d_out, int out_size, void* d_ws, size_t ws_size, hipStream_t stream) {
    static int grid_blocks = 0;
    if (grid_blocks == 0) {
        if (n_in != 16 || out_size != T * DM || ws_size < WS_END) { fprintf(stderr, "kernel_launch: unexpected sizes n_in %d out %d ws %zu\n", n_in, out_size, ws_size); grid_blocks = -1; return; }
        int dev = 0, cus = 0, per_cu = 0;
        (void)hipGetDevice(&dev);
        (void)hipDeviceGetAttribute(&cus, hipDeviceAttributeMultiprocessorCount, dev);
        if (hipFuncSetAttribute((const void*)mega_fwd, hipFuncAttributeMaxDynamicSharedMemorySize, LDS_BYTES) != hipSuccess) { fprintf(stderr, "kernel_launch: hipFuncSetAttribute failed\n"); grid_blocks = -1; return; }
        (void)hipOccupancyMaxActiveBlocksPerMultiprocessor(&per_cu, (const void*)mega_fwd, NTHREADS, LDS_BYTES);
        if (per_cu < 1) { fprintf(stderr, "kernel_launch: occupancy query says %d blocks per CU\n", per_cu); per_cu = 1; }
        if (per_cu > 1) per_cu = 1;
        grid_blocks = cus * per_cu;
        fprintf(stderr, "kernel_launch: cus %d per_cu %d grid %d ws %zu\n", cus, per_cu, grid_blocks, ws_size);
    }
    if (grid_blocks < 0) return;
    Params p{};
    p.x = (const float*)d_in[0]; p.c = (const float*)d_in[1]; p.w_ada = (const float*)d_in[2]; p.b_ada = (const float*)d_in[3];
    p.g_pre_mix = (const float*)d_in[4]; p.g_post_mix = (const float*)d_in[5]; p.w_in = (const float*)d_in[6]; p.b_gate = (const float*)d_in[7];
    p.w_proj_sb = (const float*)d_in[8]; p.w_proj_mb = (const float*)d_in[9]; p.w_proj_ds = (const float*)d_in[10]; p.w_o = (const float*)d_in[11];
    p.g_pre_ffn = (const float*)d_in[12]; p.g_post_ffn = (const float*)d_in[13]; p.w_up = (const float*)d_in[14]; p.w_down = (const float*)d_in[15];
    p.out = (float*)d_out; p.ws = (unsigned char*)d_ws; p.mask = ~0ull;
    void* args[] = {&p};
    hipError_t e = hipLaunchCooperativeKernel((const void*)mega_fwd, dim3(grid_blocks), dim3(NTHREADS), args, LDS_BYTES, stream);
    if (e != hipSuccess) fprintf(stderr, "cooperative launch failed: %s (grid %d)\n", hipGetErrorString(e), grid_blocks);
}
```
